# Optimizing an MI355X kernel written in HIP

```python
import math
import jax, jax.numpy as jnp
from jax import lax
import numpy as np

D_MODEL = 4096
BATCH = 1
SEQ = 8192
DEPTH = 1

N_META = 16
BLOCK = 128
META_CHUNK = BLOCK
N_PAD = META_CHUNK - N_META

N_HEADS = 32
N_KV_HEADS = 4
HEAD_DIM = 64
WINDOW = 128
ATTN_WIDTH = N_HEADS * HEAD_DIM
KV_WIDTH = N_KV_HEADS * HEAD_DIM

SSM_WIDTH = 1024
SSM_GROUP = 16
N_SSM_GROUPS = SSM_WIDTH // SSM_GROUP
SSM_STATE = 64
DT_MIN = 1e-3
DT_MAX = 1e-1

N_EXPERTS = 64
TOP_K = 8
N_EXPERT_GROUPS = 8
TOPK_GROUPS = 4
EXPERT_DIM = 512
SHARED_DIM = 512
ROUTED_SCALE = 2.5
ROUTER_BIAS_SCALE = 0.01
MOE_BLOCK = 128

IN_WIDTH = ATTN_WIDTH + 2 * KV_WIDTH + SSM_WIDTH + 2 * D_MODEL
SPLIT_POINTS = (ATTN_WIDTH,
                ATTN_WIDTH + KV_WIDTH,
                ATTN_WIDTH + 2 * KV_WIDTH,
                ATTN_WIDTH + 2 * KV_WIDTH + SSM_WIDTH,
                ATTN_WIDTH + 2 * KV_WIDTH + SSM_WIDTH + D_MODEL)

DEEPNORM_ALPHA = (2 * DEPTH) ** 0.25
DEEPNORM_BETA = (8 * DEPTH) ** -0.25
LN_EPS = 1e-5
NEG_INF = -1e30

kernel_name = 'hybrid_swa_s5_moe_deepnorm_meta'


def layer_norm(x, g, b):
    xf = x.astype(jnp.float32)
    mu = xf.mean(-1, keepdims=True)
    var = jnp.square(xf - mu).mean(-1, keepdims=True)
    y = (xf - mu) * lax.rsqrt(var + LN_EPS) * g.astype(jnp.float32) + b.astype(jnp.float32)
    return y.astype(x.dtype)


def sliding_window_attention(q, k, v, sinks):
    B, L = q.shape[:2]
    nb = L // BLOCK
    g = N_HEADS // N_KV_HEADS
    qb = q.reshape(B, nb, BLOCK, N_KV_HEADS, g, HEAD_DIM)
    kb = k.reshape(B, nb, BLOCK, N_KV_HEADS, HEAD_DIM)
    vb = v.reshape(B, nb, BLOCK, N_KV_HEADS, HEAD_DIM)

    def with_prev(t):
        prev = jnp.concatenate([jnp.zeros_like(t[:, :1]), t[:, :-1]], axis=1)
        return jnp.concatenate([prev, t], axis=2)

    kband, vband = with_prev(kb), with_prev(vb)
    k_meta = k[:, N_PAD:META_CHUNK]
    v_meta = v[:, N_PAD:META_CHUNK]
    scale = HEAD_DIM ** -0.5
    s_band = jnp.einsum('bnqkgd,bnckd->bnkgqc', qb, kband, preferred_element_type=jnp.float32) * scale
    s_meta = jnp.einsum('bnqkgd,bmkd->bnkgqm', qb, k_meta, preferred_element_type=jnp.float32) * scale

    qpos = jnp.arange(nb)[:, None] * BLOCK + jnp.arange(BLOCK)[None, :]
    kpos = (jnp.arange(nb)[:, None] - 1) * BLOCK + jnp.arange(2 * BLOCK)[None, :]
    dist = qpos[:, :, None] - kpos[:, None, :]
    band_ok = (dist >= 0) & (dist < WINDOW) & (kpos[:, None, :] >= META_CHUNK)
    mpos = N_PAD + jnp.arange(N_META)
    meta_ok = mpos[None, None, :] <= qpos[:, :, None]
    s_band = jnp.where(band_ok[None, :, None, None], s_band, NEG_INF)
    s_meta = jnp.where(meta_ok[None, :, None, None], s_meta, NEG_INF)
    sink = jnp.broadcast_to(
        sinks.astype(jnp.float32).reshape(N_KV_HEADS, g)[None, None, :, :, None, None],
        s_band.shape[:-1] + (1,))
    p = jax.nn.softmax(jnp.concatenate([s_band, s_meta, sink], axis=-1), axis=-1)
    p_band = p[..., :2 * BLOCK].astype(v.dtype)
    p_meta = p[..., 2 * BLOCK:2 * BLOCK + N_META].astype(v.dtype)
    out = (jnp.einsum('bnkgqc,bnckd->bnqkgd', p_band, vband)
           + jnp.einsum('bnkgqm,bmkd->bnqkgd', p_meta, v_meta))
    return out.reshape(B, L, ATTN_WIDTH)


def _complex_scan_combine(c1, c2):
    a1r, a1i, b1r, b1i = c1
    a2r, a2i, b2r, b2i = c2
    ar = a2r * a1r - a2i * a1i
    ai = a2r * a1i + a2i * a1r
    br = a2r * b1r - a2i * b1i + b2r
    bi = a2r * b1i + a2i * b1r + b2i
    return (ar, ai, br, bi)


def s5_ssm(u, valid, lam_re, lam_im, log_dt, b_re, b_im, c_re, c_im, d_skip):
    B, L = u.shape[:2]
    uf = jnp.where(valid[None, :, None], u.astype(jnp.float32), 0.0)
    uf = uf.reshape(B, L, N_SSM_GROUPS, SSM_GROUP)
    dt = jnp.exp(log_dt.astype(jnp.float32))[:, None]
    lr = lam_re.astype(jnp.float32)
    li = lam_im.astype(jnp.float32)
    mag = jnp.exp(dt * lr)
    abar_re = mag * jnp.cos(dt * li)
    abar_im = mag * jnp.sin(dt * li)
    den = lr * lr + li * li
    num_re = abar_re - 1.0
    coef_re = (num_re * lr + abar_im * li) / den
    coef_im = (abar_im * lr - num_re * li) / den
    br, bi = b_re.astype(jnp.float32), b_im.astype(jnp.float32)
    bbar_re = coef_re[..., None] * br - coef_im[..., None] * bi
    bbar_im = coef_re[..., None] * bi + coef_im[..., None] * br
    bu_re = jnp.einsum('blgh,gph->blgp', uf, bbar_re)
    bu_im = jnp.einsum('blgh,gph->blgp', uf, bbar_im)
    a_re = jnp.broadcast_to(abar_re[None, None], bu_re.shape)
    a_im = jnp.broadcast_to(abar_im[None, None], bu_re.shape)
    _, _, x_re, x_im = lax.associative_scan(_complex_scan_combine, (a_re, a_im, bu_re, bu_im), axis=1)
    y = (jnp.einsum('blgp,ghp->blgh', x_re, c_re.astype(jnp.float32))
         - jnp.einsum('blgp,ghp->blgh', x_im, c_im.astype(jnp.float32))
         + d_skip.astype(jnp.float32).reshape(N_SSM_GROUPS, SSM_GROUP) * uf)
    return y.reshape(B, L, SSM_WIDTH).astype(u.dtype)


def route(h, w_router, router_bias):
    T = h.shape[0]
    scores = jax.nn.sigmoid(jnp.einsum('td,de->te', h, w_router, preferred_element_type=jnp.float32))
    sel = scores + router_bias.astype(jnp.float32)
    grp = sel.reshape(T, N_EXPERT_GROUPS, N_EXPERTS // N_EXPERT_GROUPS)
    grp_score = lax.top_k(grp, 2)[0].sum(-1)
    _, top_groups = lax.top_k(grp_score, TOPK_GROUPS)
    group_mask = jax.nn.one_hot(top_groups, N_EXPERT_GROUPS).sum(-2) > 0
    expert_mask = jnp.repeat(group_mask, N_EXPERTS // N_EXPERT_GROUPS, axis=-1)
    _, idx = lax.top_k(jnp.where(expert_mask, sel, NEG_INF), TOP_K)
    w = jnp.take_along_axis(scores, idx, axis=-1)
    w = w / w.sum(-1, keepdims=True) * ROUTED_SCALE
    return idx, w


def routed_experts(h, idx, wts, w1, w3, w2):
    T, D = h.shape
    n_assign = T * TOP_K
    n_blocks = -(-n_assign // MOE_BLOCK) + N_EXPERTS
    n_rows = n_blocks * MOE_BLOCK
    e_flat = idx.reshape(-1)
    tok_flat = jnp.repeat(jnp.arange(T, dtype=jnp.int32), TOP_K)
    w_flat = wts.reshape(-1)
    onehot = jax.nn.one_hot(e_flat, N_EXPERTS, dtype=jnp.int32)
    rank = jnp.take_along_axis(jnp.cumsum(onehot, axis=0), e_flat[:, None], axis=1)[:, 0] - 1
    counts = onehot.sum(0)
    padded = (counts + MOE_BLOCK - 1) // MOE_BLOCK * MOE_BLOCK
    ends = jnp.cumsum(padded)
    starts = ends - padded
    dest = starts[e_flat] + rank
    row_tok = jnp.zeros((n_rows,), jnp.int32).at[dest].set(tok_flat)
    row_w = jnp.zeros((n_rows,), w_flat.dtype).at[dest].set(w_flat)
    block_expert = jnp.minimum(
        jnp.searchsorted(ends, jnp.arange(n_blocks, dtype=ends.dtype) * MOE_BLOCK, side='right'),
        N_EXPERTS - 1)

    def expert_block(args):
        toks, e = args
        xb = h[toks]
        return (jax.nn.silu(xb @ w1[e]) * (xb @ w3[e])) @ w2[e]

    yb = lax.map(expert_block, (row_tok.reshape(n_blocks, MOE_BLOCK), block_expert)).reshape(n_rows, D)
    return jax.ops.segment_sum(yb * row_w[:, None].astype(yb.dtype), row_tok, num_segments=T)


def setup_inputs(seed: int = 0) -> dict:
    key = jax.random.key(seed)
    ks = iter(jax.random.split(key, 32))

    def nrm(shape, scale):
        return jax.random.normal(next(ks), shape, jnp.float32) * scale

    n_idx = jnp.arange(SSM_STATE, dtype=jnp.float32)
    return {
        'x': nrm((BATCH, SEQ, D_MODEL), 1.0),
        'meta_tokens': nrm((N_META, D_MODEL), 1.0),
        'ln0_g': 1.0 + nrm((D_MODEL,), 0.01),
        'ln0_b': nrm((D_MODEL,), 0.01),
        'w_in': nrm((DEPTH, D_MODEL, IN_WIDTH), D_MODEL ** -0.5),
        'attn_sinks': nrm((DEPTH, N_HEADS), 0.5),
        'w_attn_o': nrm((DEPTH, ATTN_WIDTH, D_MODEL), ATTN_WIDTH ** -0.5),
        'ssm_lam_re': -0.5 + nrm((DEPTH, N_SSM_GROUPS, SSM_STATE), 0.01),
        'ssm_lam_im': jnp.pi * n_idx + nrm((DEPTH, N_SSM_GROUPS, SSM_STATE), 0.01),
        'ssm_log_dt': jax.random.uniform(next(ks), (DEPTH, N_SSM_GROUPS), jnp.float32,
                                         minval=math.log(DT_MIN), maxval=math.log(DT_MAX)),
        'ssm_b_re': nrm((DEPTH, N_SSM_GROUPS, SSM_STATE, SSM_GROUP), (2 * SSM_GROUP) ** -0.5),
        'ssm_b_im': nrm((DEPTH, N_SSM_GROUPS, SSM_STATE, SSM_GROUP), (2 * SSM_GROUP) ** -0.5),
        'ssm_c_re': nrm((DEPTH, N_SSM_GROUPS, SSM_GROUP, SSM_STATE), (2 * SSM_STATE) ** -0.5),
        'ssm_c_im': nrm((DEPTH, N_SSM_GROUPS, SSM_GROUP, SSM_STATE), (2 * SSM_STATE) ** -0.5),
        'ssm_d': nrm((DEPTH, SSM_WIDTH), 1.0),
        'w_glu': nrm((DEPTH, SSM_WIDTH, SSM_WIDTH), SSM_WIDTH ** -0.5),
        'w_ssm_o': nrm((DEPTH, SSM_WIDTH, D_MODEL), SSM_WIDTH ** -0.5),
        'w_out': nrm((DEPTH, D_MODEL, D_MODEL), D_MODEL ** -0.5 * DEEPNORM_BETA),
        'ln1_g': 1.0 + nrm((DEPTH, D_MODEL), 0.01),
        'ln1_b': nrm((DEPTH, D_MODEL), 0.01),
        'w_router': nrm((DEPTH, D_MODEL, N_EXPERTS), D_MODEL ** -0.5),
        'router_bias': nrm((DEPTH, N_EXPERTS), ROUTER_BIAS_SCALE),
        'expert_w1': nrm((DEPTH, N_EXPERTS, D_MODEL, EXPERT_DIM), D_MODEL ** -0.5),
        'expert_w3': nrm((DEPTH, N_EXPERTS, D_MODEL, EXPERT_DIM), D_MODEL ** -0.5),
        'expert_w2': nrm((DEPTH, N_EXPERTS, EXPERT_DIM, D_MODEL), EXPERT_DIM ** -0.5 * DEEPNORM_BETA),
        'shared_w1': nrm((DEPTH, D_MODEL, SHARED_DIM), D_MODEL ** -0.5),
        'shared_w3': nrm((DEPTH, D_MODEL, SHARED_DIM), D_MODEL ** -0.5),
        'shared_w2': nrm((DEPTH, SHARED_DIM, D_MODEL), SHARED_DIM ** -0.5 * DEEPNORM_BETA),
        'ln2_g': 1.0 + nrm((DEPTH, D_MODEL), 0.01),
        'ln2_b': nrm((DEPTH, D_MODEL), 0.01),
    }


def reference(x, meta_tokens, ln0_g, ln0_b, w_in, attn_sinks, w_attn_o,
              ssm_lam_re, ssm_lam_im, ssm_log_dt, ssm_b_re, ssm_b_im, ssm_c_re, ssm_c_im, ssm_d,
              w_glu, w_ssm_o, w_out, ln1_g, ln1_b, w_router, router_bias,
              expert_w1, expert_w3, expert_w2, shared_w1, shared_w3, shared_w2, ln2_g, ln2_b):
    B = x.shape[0]
    pad = jnp.zeros((B, N_PAD, D_MODEL), x.dtype)
    meta = jnp.broadcast_to(meta_tokens.astype(x.dtype)[None], (B, N_META, D_MODEL))
    h = layer_norm(jnp.concatenate([pad, meta, x], axis=1), ln0_g, ln0_b)
    L = h.shape[1]
    valid = jnp.arange(L) >= N_PAD

    for l in range(DEPTH):
        z = h @ w_in[l]
        q, k, v, u, gate_a, gate_s = jnp.split(z, SPLIT_POINTS, axis=-1)
        attn = sliding_window_attention(q.reshape(B, L, N_HEADS, HEAD_DIM),
                                        k.reshape(B, L, N_KV_HEADS, HEAD_DIM),
                                        v.reshape(B, L, N_KV_HEADS, HEAD_DIM),
                                        attn_sinks[l])
        attn_d = attn @ w_attn_o[l]
        y = s5_ssm(u, valid, ssm_lam_re[l], ssm_lam_im[l], ssm_log_dt[l],
                   ssm_b_re[l], ssm_b_im[l], ssm_c_re[l], ssm_c_im[l], ssm_d[l])
        y = jax.nn.gelu(y, approximate=False)
        y = y * jax.nn.sigmoid(y @ w_glu[l])
        ssm_dd = y @ w_ssm_o[l]
        mix = jax.nn.sigmoid(gate_a) * attn_d + jax.nn.sigmoid(gate_s) * ssm_dd
        h = layer_norm(DEEPNORM_ALPHA * h + mix @ w_out[l], ln1_g[l], ln1_b[l])

        ht = h.reshape(B * L, D_MODEL)
        idx, wts = route(ht, w_router[l], router_bias[l])
        shared = (jax.nn.silu(ht @ shared_w1[l]) * (ht @ shared_w3[l])) @ shared_w2[l]
        routed = routed_experts(ht, idx, wts, expert_w1[l], expert_w3[l], expert_w2[l])
        moe = (shared + routed).reshape(B, L, D_MODEL)
        h = layer_norm(DEEPNORM_ALPHA * h + moe, ln2_g[l], ln2_b[l])

    return h[:, META_CHUNK:]
```

```cpp
#include <hip/hip_runtime.h>
#include <cstdio>
#include <cstdint>

#define LAS __attribute__((address_space(3)))
#define GAS __attribute__((address_space(1)))
typedef unsigned short bf16_t;
typedef short bf16x8 __attribute__((ext_vector_type(8)));
typedef float f32x4 __attribute__((ext_vector_type(4)));
typedef float f32x2 __attribute__((ext_vector_type(2)));
typedef unsigned u32x4 __attribute__((ext_vector_type(4)));
typedef unsigned u32x2 __attribute__((ext_vector_type(2)));
typedef GAS unsigned gu32;

#ifndef MK_ONE_LAUNCH
#define MK_ONE_LAUNCH 1
#endif

constexpr int T_TOK = 8192, DM = 4096, NMETA = 16, ROWS_Z = 8448, KVROWS = 8208;
constexpr int NZ = 11776, AW = 2048, KVW = 256, SW = 1024;
constexpr int NE = 64, TOPK = 8, EDIM = 512;
constexpr float ALPHA = 1.189207115002721f;
constexpr float LN_EPS = 1e-5f;
constexpr float LOG2E = 1.4426950408889634f;
constexpr float QSCALE = 0.125f * LOG2E;
constexpr int MAXTILES = 320;
constexpr int NPHASE = 14;
constexpr int CVT_P8_PER = 120, CVT_P4_PER = 28, CVT_P8_TILES = 96 * CVT_P8_PER, CVT_P4_TILES = 128 * CVT_P4_PER, CVT_P1_TILES = 3 * NE * 64 * 8 - CVT_P8_TILES - CVT_P4_TILES;

constexpr size_t MiB = 1u << 20;
constexpr size_t WS_CTL = 0, CTL_ZERO_BYTES = 32768;
constexpr size_t WS_TOPI = 1 * MiB, WS_TOPW = WS_TOPI + 256 * 1024, WS_POS = WS_TOPW + 256 * 1024;
constexpr size_t WS_ROWTOK = 2 * MiB, WS_TILEE = 2 * MiB + 512 * 1024, WS_UTAB = WS_TILEE + 8192  , WS_STATS0 = 2 * MiB + 768 * 1024;
constexpr size_t WS_SSME = 3 * MiB, WS_LOGITS = 4 * MiB;
constexpr size_t WS_H1F = 8 * MiB, WS_H1B = 136 * MiB, WS_H1LO = 200 * MiB, WS_ACT = 264 * MiB, WS_ACTS = 344 * MiB;
constexpr size_t WS_WE2 = 352 * MiB, WS_WS2 = 608 * MiB, WS_WS13 = 612 * MiB;
constexpr size_t WS_WE13 = 640 * MiB, WS_WIN = 1152 * MiB, WS_WAO = 1244 * MiB, WS_WGLU = 1260 * MiB, WS_WSO = 1262 * MiB, WS_WOUT = 1270 * MiB;
constexpr size_t WS_H0B = 1302 * MiB, WS_QB = 1368 * MiB, WS_KB = 1400 * MiB, WS_VB = 1405 * MiB, WS_UG = 1410 * MiB;
constexpr size_t WS_GA = 1427 * MiB, WS_GS = 1491 * MiB, WS_ATT = 1555 * MiB, WS_Y1 = 1587 * MiB, WS_Y2 = 1603 * MiB, WS_MIX = 1619 * MiB;
constexpr size_t WS_END = 1683 * MiB;
constexpr size_t WS_WING = WS_WIN + 16 * MiB;
constexpr size_t WS_H0Q = WS_ACT + 40 * MiB;
constexpr size_t WS_YB = 640 * MiB;
static_assert(WS_YB + (size_t)MAXTILES * 256 * DM * 2 <= WS_H0B, "YB overlay");
constexpr int CW_TMO = 0, CW_CODE = 1, CW_NTILES = 64, CW_CNT = 128  , CW_BAR = 4096;

constexpr int RING_BYTES = 131072, LDS_BYTES = 147456, MISC_OFF = LDS_BYTES - 256, LUT_OFF = LDS_BYTES - 1024;

#define RLX_AGENT __ATOMIC_RELAXED, __HIP_MEMORY_SCOPE_AGENT
#define LDS_WAIT() asm volatile("s_waitcnt lgkmcnt(0)" ::: "memory")
#define VM_WAIT() asm volatile("s_waitcnt vmcnt(0)" ::: "memory")
__device__ __forceinline__ unsigned f2bf(float f) { unsigned u = __builtin_bit_cast(unsigned, f); return (u + 0x7fffu + ((u >> 16) & 1u)) >> 16; }
typedef __bf16 bf16x2_t __attribute__((ext_vector_type(2)));
__device__ __forceinline__ unsigned pk2(float lo, float hi) { f32x2 v = {lo, hi}; bf16x2_t b = __builtin_convertvector(v, bf16x2_t); return __builtin_bit_cast(unsigned, b); }
__device__ __forceinline__ float bf_lo(unsigned w) { return __builtin_bit_cast(float, w << 16); }
__device__ __forceinline__ float bf_hi(unsigned w) { return __builtin_bit_cast(float, w & 0xffff0000u); }
__device__ __forceinline__ float bf2f(bf16_t h) { return __builtin_bit_cast(float, ((unsigned)h) << 16); }
__device__ __forceinline__ float fast_sigmoid(float x) { return __builtin_amdgcn_rcpf(1.0f + __builtin_amdgcn_exp2f(-x * LOG2E)); }
__device__ __forceinline__ float wave_sum(float v) {
#pragma unroll
    for (int o = 1; o < 64; o <<= 1) v += __shfl_xor(v, o);
    return v;
}
__device__ __forceinline__ float wave_max(float v) {
#pragma unroll
    for (int o = 1; o < 64; o <<= 1) v = fmaxf(v, __shfl_xor(v, o));
    return v;
}

#define XB_TMO      128
#define XB_XCNT(j)  (256  + 64 * (j))
#define XB_XSUB(j)  (1280 + 64 * (j))
#define XB_XGEN(j)  (2304 + 64 * (j))
#define XB_TOP      3328
#define XB_TOPGEN   3392
#define XCD_BAR_WORDS 3456
#define XB_SPIN_CAP (1u << 18)
__device__ __forceinline__ unsigned xb_ld(unsigned* p)              { return __hip_atomic_load(p, __ATOMIC_RELAXED, __HIP_MEMORY_SCOPE_AGENT); }
__device__ __forceinline__ unsigned xb_add(unsigned* p, unsigned v) { return __hip_atomic_fetch_add(p, v, __ATOMIC_RELAXED, __HIP_MEMORY_SCOPE_AGENT); }
__device__ __forceinline__ unsigned xb_xcc_id() { return (unsigned)__builtin_amdgcn_s_getreg((3 << 11) | 20) & 0xFu; }
#define XB_SPIN(cond, bar) do { unsigned _sp = 0; while (cond) { __builtin_amdgcn_s_sleep(1); \
    if ((++_sp & 255u) == 0u) { if (xb_ld(&(bar)[XB_TMO])) break; if (_sp > XB_SPIN_CAP) { atomicAdd(&(bar)[XB_TMO], 1u); break; } } } } while (0)
struct XcdBarrier { unsigned* bar; unsigned x; volatile LAS unsigned* st; };
__device__ __forceinline__ XcdBarrier xcd_barrier_post(unsigned* bar, volatile LAS unsigned* st) {
    XcdBarrier b; b.bar = bar; b.x = xb_xcc_id(); b.st = st;
    if (threadIdx.x == 0) (void)xb_add(&bar[XB_XCNT(b.x)], 1u);
    return b;
}
__device__ __forceinline__ void xcd_barrier_complete(unsigned* bar, unsigned x, unsigned& nloc, unsigned& nx) {
    const unsigned G = gridDim.x * gridDim.y * gridDim.z;
    unsigned sum, cnt, mine, sp = 0u;
    for (;;) {
        sum = 0u; cnt = 0u; mine = 0u;
#pragma unroll
        for (unsigned j = 0; j < 16; ++j) { const unsigned c = xb_ld(&bar[XB_XCNT(j)]); sum += c; cnt += (c > 0u) ? 1u : 0u; mine = (j == x) ? c : mine; }
        if (sum == G) break;
        __builtin_amdgcn_s_sleep(1);
        if ((++sp & 255u) == 0u) { if (xb_ld(&bar[XB_TMO])) break; if (sp > XB_SPIN_CAP) { atomicAdd(&bar[XB_TMO], 1u); break; } }
    }
    nloc = mine > 0u ? mine : 1u; nx = cnt > 0u ? cnt : 1u;
}
__device__ __forceinline__ void xcd_barrier(const XcdBarrier& b) {
    asm volatile("s_waitcnt vmcnt(0)" ::: "memory");
    __syncthreads();
    if (threadIdx.x == 0) {
        unsigned* bar = b.bar;
        __builtin_amdgcn_s_waitcnt(0);
        unsigned nloc = b.st[0], nx = b.st[1];
        if (nloc == 0u) { xcd_barrier_complete(bar, b.x, nloc, nx); b.st[0] = nloc; b.st[1] = nx; }
        const unsigned old = xb_add(&bar[XB_XSUB(b.x)], 1u);
        const unsigned gen = old / nloc;
        if (old + 1u == (gen + 1u) * nloc) {
            __builtin_amdgcn_fence(__ATOMIC_RELEASE, "agent");
            asm volatile("s_waitcnt vmcnt(0)" ::: "memory");
            const unsigned og = xb_add(&bar[XB_TOP], 1u);
            const unsigned tg = og / nx;
            if (og + 1u == (tg + 1u) * nx) xb_add(&bar[XB_TOPGEN], 1u);
            else XB_SPIN(xb_ld(&bar[XB_TOPGEN]) == tg, bar);
            __builtin_amdgcn_fence(__ATOMIC_ACQUIRE, "agent");
            xb_add(&bar[XB_XGEN(b.x)], 1u);
            asm volatile("s_waitcnt vmcnt(0)" ::: "memory");
        } else {
            XB_SPIN(xb_ld(&bar[XB_XGEN(b.x)]) == gen, bar);
            __builtin_amdgcn_fence(__ATOMIC_ACQUIRE, "agent");
            asm volatile("s_waitcnt vmcnt(0)" ::: "memory");
        }
    }
    __syncthreads();
}

namespace pg8 {
constexpr int BM = 256, BK = 64, HALF = 128, HTB = HALF * BK * 2, NXCD = 8, WGM = 8;
__device__ __forceinline__ int lds_byte(int r, int c) { const int st = (r >> 4) * 2 + (c >> 5), rr = r & 15, cc = c & 31, ob = rr * 64 + cc * 2; return st * 1024 + (ob ^ (((ob >> 9) & 1) << 5)); }
__device__ __forceinline__ void stage_rc(int b, int& R, int& C) { const int st = b / 1024, sb = b % 1024, swz = sb ^ (((sb >> 9) & 1) << 5); R = (st >> 1) * 16 + swz / 64; C = (st & 1) * 32 + (swz % 64) / 2; }
__device__ __forceinline__ int perm32(int rho) { const int n = rho >> 4, i = rho & 15; return 8 * (i >> 2) + 4 * n + (i & 3); }
struct Unit { int pm, pn, e; };
__device__ __forceinline__ unsigned cvt_pk_bf16(float lo, float hi) { f32x2 v = {lo, hi}; bf16x2_t b = __builtin_convertvector(v, bf16x2_t); return __builtin_bit_cast(unsigned, b); }

__device__ __forceinline__ void tile_of(int L, int nM, int nN, int& pm, int& pn) {
    const int nwg = nM * nN; int wgid = L;
    { const int q = nwg / NXCD, r = nwg % NXCD, xcd = wgid % NXCD, off = wgid / NXCD; wgid = (xcd < r ? xcd * (q + 1) : r * (q + 1) + (xcd - r) * q) + off; }
    const int nig = WGM * nN, gid = wgid / nig, fm = gid * WGM, gsz = (nM - fm) < WGM ? (nM - fm) : WGM;
    pm = fm + ((wgid % nig) % gsz); pn = (wgid % nig) / gsz;
}
struct DenseSched {
    const char* A; const char* Bt; int K, nM, nN, G, c, xpm, xpn0, xn, i0 = 0, i1 = 0x7fffffff;
    __device__ __forceinline__ bool next(int i, Unit& u) const {
        if (i + i0 >= i1) return false;
        const int L = (i + i0) * G + c, nwg = nM * nN;
        if (L >= nwg) { const int x = L - nwg; if (x < xn) { u.pm = xpm; u.pn = xpn0 + x; u.e = 0; return true; } return false; }
        tile_of(L, nM, nN, u.pm, u.pn); u.e = 0; return true;
    }
    __device__ __forceinline__ int arow(const Unit& u, int r) const { return u.pm * BM + r; }
    __device__ __forceinline__ const char* abase(const Unit&) const { return A; }
    __device__ __forceinline__ const char* bbase(const Unit& u) const { return Bt + (size_t)u.pn * BM * K * 2; }
};
struct MoeSched {
    const char* A; const char* Bt; int K; const int* rowlist; const int* tile_e; int nN; size_t bstride; int nunits, G, c;
    __device__ __forceinline__ bool next(int i, Unit& u) const {
        const int L = i * G + c; if (L >= nunits) return false;
        const int q = nunits / NXCD, r = nunits % NXCD, xcd = L % NXCD, off = L / NXCD;
        const int wgid = (xcd < r ? xcd * (q + 1) : r * (q + 1) + (xcd - r) * q) + off;
        u.pm = wgid / nN; u.pn = wgid % nN;
        u.e = __builtin_amdgcn_readfirstlane((int)__hip_atomic_load((const unsigned*)tile_e + u.pm, RLX_AGENT));
        return true;
    }
    __device__ __forceinline__ int arow(const Unit& u, int r) const { return rowlist ? rowlist[u.pm * BM + r] : u.pm * BM + r; }
    __device__ __forceinline__ const char* abase(const Unit&) const { return A; }
    __device__ __forceinline__ const char* bbase(const Unit& u) const { return Bt + (size_t)u.e * bstride + (size_t)u.pn * BM * K * 2; }
};

struct MoeTabSched {
    const char* A; const char* Bt; int K; const LAS int* lut; size_t bstride; int nunits, G, c;
    __device__ __forceinline__ bool next(int i, Unit& u) const {
        if (i * G + c >= nunits) return false;
        const int v = __builtin_amdgcn_readfirstlane(lut[i]);
        u.pm = v & 0xffff; u.pn = (v >> 16) & 0xff; u.e = (v >> 24) & 0xff; return true;
    }
    __device__ __forceinline__ int arow(const Unit& u, int r) const { return u.pm * BM + r; }
    __device__ __forceinline__ const char* abase(const Unit&) const { return A; }
    __device__ __forceinline__ const char* bbase(const Unit& u) const { return Bt + (size_t)u.e * bstride + (size_t)u.pn * BM * K * 2; }
};
__device__ __forceinline__ int xcd_remap(int L, int nunits) { const int q = nunits / NXCD, r = nunits % NXCD, xcd = L % NXCD, off = L / NXCD; return (xcd < r ? xcd * (q + 1) : r * (q + 1) + (xcd - r) * q) + off; }

typedef int v8i __attribute__((ext_vector_type(8)));
typedef int v4i __attribute__((ext_vector_type(4)));
template <class E, class = void> struct epi_wide { static constexpr int v = 0; };
template <class E> struct epi_wide<E, decltype((void)E::WIDE)> { static constexpr int v = E::WIDE; };
template <bool FP8> struct Frag;
template <> struct Frag<false> { bf16x8 bh[2]; };
template <> struct Frag<true> { v8i q; };
template <class Epi, class Sched, bool FP8 = false>
__device__ __forceinline__ void gemm_phase(LAS unsigned char* lds, const int tid, const int K, const int lda, const Sched& S, const Epi& E) {
    const int wid = __builtin_amdgcn_readfirstlane(tid >> 6), lane = tid & 63, wr = wid >> 2, wc = wid & 3, fr = lane & 15, fq = lane >> 4;
    int nt = K / BK; asm volatile("" : "+s"(nt));
    int sc1 = 0x7f7f7f7f, scw = 0x79797979; asm volatile("" : "+v"(sc1), "+v"(scw));
    int Rr[2]; unsigned Cb[2], voffB[2];
    constexpr int WIDE = epi_wide<Epi>::v;
#pragma unroll
    for (int i = 0; i < 2; ++i) { int R, C; stage_rc(tid * 16 + i * 8192, R, C);
        const int Rb = WIDE == 1 ? (64 * (R >> 5) + 16 * ((R >> 2) & 3) + 4 * ((R >> 4) & 1) + (R & 3)) : WIDE == 2 ? (64 * (R >> 5) + 8 * ((R >> 2) & 3) + 4 * ((R >> 4) & 1) + (R & 3))
                     : Epi::PERM ? ((R & ~31) + perm32(R & 31)) : R;
        Rr[i] = R; Cb[i] = (unsigned)C * 2u; voffB[i] = (unsigned)(Rb * K + C) * 2u; }
    const unsigned lda2 = (unsigned)lda * 2u;
    const size_t kstep = (size_t)(BK * 2);
    const size_t hstepB = (size_t)(WIDE == 1 ? 8 : WIDE == 2 ? 32 : HALF) * K * 2;
    const unsigned ldsw = (unsigned)wid * 1024u;
    const int aoff = lds_byte(wr * 64 + fr, fq * 8), boff = lds_byte(wc * 32 + fr, fq * 8);
    const LAS unsigned char* pA = lds + aoff; const LAS unsigned char* pB = lds + 65536 + boff;
#define PG8_SA(b, h) (((b) * 2 + (h)) * HTB)
#define PG8_SB(b, h) ((4 + (b) * 2 + (h)) * HTB)
#define PG8_STAGE(bufoff, gbase, voff) do { _Pragma("unroll") for (int _i = 0; _i < 2; ++_i) \
        __builtin_amdgcn_global_load_lds((const unsigned*)((const char*)(gbase) + (voff)[_i]), (LAS unsigned*)(lds + (bufoff) + ldsw + _i * 8192), 16, 0, 0); } while (0)
#define PG8_LD32(p, off) __builtin_shufflevector(*(const LAS v4i*)((p) + (off)), *(const LAS v4i*)((p) + (off) + 1024), 0, 1, 2, 3, 4, 5, 6, 7)
#define PG8_LDA(dst, b, h) do { _Pragma("unroll") for (int m = 0; m < 4; ++m) { if constexpr (FP8) dst[m].q = PG8_LD32(pA, PG8_SA(b, h) + m * 2048); \
        else { dst[m].bh[0] = *(const LAS bf16x8*)(pA + PG8_SA(b, h) + m * 2048); dst[m].bh[1] = *(const LAS bf16x8*)(pA + PG8_SA(b, h) + m * 2048 + 1024); } } } while (0)
#define PG8_LDB(dst, b, h) do { _Pragma("unroll") for (int n = 0; n < 2; ++n) { if constexpr (FP8) dst[n].q = PG8_LD32(pB, PG8_SB(b, h) - 65536 + n * 2048); \
        else { dst[n].bh[0] = *(const LAS bf16x8*)(pB + PG8_SB(b, h) - 65536 + n * 2048); dst[n].bh[1] = *(const LAS bf16x8*)(pB + PG8_SB(b, h) - 65536 + n * 2048 + 1024); } } } while (0)
#define PG8_MMA(ai, bj, At, Bt) do { __builtin_amdgcn_s_setprio(1); _Pragma("unroll") for (int m = 0; m < 4; ++m) _Pragma("unroll") for (int n = 0; n < 2; ++n) { \
        if constexpr (FP8) asm volatile("v_mfma_scale_f32_16x16x128_f8f6f4 %0, %1, %2, %0, %3, %4 op_sel_hi:[0,0,0]" : "+v"(acc[ai][bj][m][n]) : "v"(Bt[n].q), "v"(At[m].q), "v"(scw), "v"(sc1)); \
        else { acc[ai][bj][m][n] = __builtin_amdgcn_mfma_f32_16x16x32_bf16(Bt[n].bh[0], At[m].bh[0], acc[ai][bj][m][n], 0, 0, 0); acc[ai][bj][m][n] = __builtin_amdgcn_mfma_f32_16x16x32_bf16(Bt[n].bh[1], At[m].bh[1], acc[ai][bj][m][n], 0, 0, 0); } } \
        __builtin_amdgcn_s_setprio(0); } while (0)
#define PG8_MMAZ(ai, bj, At, Bt) do { __builtin_amdgcn_s_setprio(1); _Pragma("unroll") for (int m = 0; m < 4; ++m) _Pragma("unroll") for (int n = 0; n < 2; ++n) \
        asm volatile("v_mfma_scale_f32_16x16x128_f8f6f4 %0, %1, %2, 0, %3, %4 op_sel_hi:[0,0,0]" : "+v"(acc[ai][bj][m][n]) : "v"(Bt[n].q), "v"(At[m].q), "v"(scw), "v"(sc1)); \
        __builtin_amdgcn_s_setprio(0); } while (0)
#define PG8_WAIT_V(n) asm volatile("s_waitcnt vmcnt(" #n ")" ::: "memory")
#define PG8_WAIT_V8E(c) do { if (Epi::NST > 0 && (c)) asm volatile("s_waitcnt vmcnt(%0)" :: "n"(8 + Epi::NST) : "memory"); else PG8_WAIT_V(8); } while (0)
#define PG8_WAIT_L(n) asm volatile("s_waitcnt lgkmcnt(" #n ")" ::: "memory")
#define PG8_BAR __builtin_amdgcn_s_barrier()
#define PG8_SCHED __builtin_amdgcn_sched_barrier(0)
    Unit cur, nxt; int ui = 0;
    if (!S.next(0, cur)) return;
    f32x4 acc[2][2][4][2];
#pragma unroll
    for (int a = 0; a < 2; ++a)
#pragma unroll
        for (int b = 0; b < 2; ++b)
#pragma unroll
            for (int m = 0; m < 4; ++m)
#pragma unroll
                for (int n = 0; n < 2; ++n) acc[a][b][m][n] = (f32x4){0.f, 0.f, 0.f, 0.f};
    Frag<FP8> At[4], B0[2], B1[2];
    const char* cA = S.abase(cur); const char* cB = S.bbase(cur);
    unsigned ofA0[2], ofA1[2];
#pragma unroll
    for (int i = 0; i < 2; ++i) { ofA0[i] = (unsigned)S.arow(cur, Rr[i]) * lda2 + Cb[i]; ofA1[i] = (unsigned)S.arow(cur, HALF + Rr[i]) * lda2 + Cb[i]; }
    PG8_STAGE(PG8_SB(0, 0), cB, voffB); PG8_STAGE(PG8_SB(0, 1), cB + hstepB, voffB); PG8_STAGE(PG8_SA(0, 0), cA, ofA0); PG8_STAGE(PG8_SA(0, 1), cA, ofA1);
    if (wr == 1) PG8_BAR;
    PG8_WAIT_V(2); PG8_BAR;
    PG8_STAGE(PG8_SB(1, 0), cB + kstep, voffB); PG8_STAGE(PG8_SA(1, 0), cA + kstep, ofA0); PG8_STAGE(PG8_SB(1, 1), cB + hstepB + kstep, voffB);
    PG8_WAIT_V(6); PG8_BAR;
    for (;;) {
        const bool has_next = S.next(ui + 1, nxt);
        const char* nA = has_next ? S.abase(nxt) : cA; const char* nB = has_next ? S.bbase(nxt) : cB;
        unsigned ofN0[2], ofN1[2];
#pragma unroll
        for (int i = 0; i < 2; ++i) { ofN0[i] = has_next ? (unsigned)S.arow(nxt, Rr[i]) * lda2 + Cb[i] : ofA0[i]; ofN1[i] = has_next ? (unsigned)S.arow(nxt, HALF + Rr[i]) * lda2 + Cb[i] : ofA1[i]; }
        for (int t = 0; t < nt; t += 2) {
            const bool last = (t == nt - 2);
            const char* a1 = cA + (size_t)(t + 1) * kstep;
            const char* a2 = last ? nA : cA + (size_t)(t + 2) * kstep; const char* b2 = last ? nB : cB + (size_t)(t + 2) * kstep;
            const char* a3 = a2 + kstep; const char* b3 = b2 + kstep;
            unsigned o20[2], o21[2];
#pragma unroll
            for (int i = 0; i < 2; ++i) { o20[i] = last ? ofN0[i] : ofA0[i]; o21[i] = last ? ofN1[i] : ofA1[i]; }
            const bool after_epi = (t == 0) && (ui > 0);
            PG8_LDB(B0, 0, 0); PG8_LDB(B1, 0, 1); PG8_SCHED; PG8_LDA(At, 0, 0); PG8_STAGE(PG8_SA(1, 1), a1, ofA1);
            PG8_WAIT_V8E(after_epi); PG8_WAIT_L(0); PG8_BAR;
            if constexpr (FP8) { if (t == 0) { PG8_MMAZ(0, 0, At, B0); PG8_MMAZ(0, 1, At, B1); } else { PG8_MMA(0, 0, At, B0); PG8_MMA(0, 1, At, B1); } } else { PG8_MMA(0, 0, At, B0); PG8_MMA(0, 1, At, B1); }
            PG8_BAR; PG8_SCHED;
            PG8_LDA(At, 0, 1); PG8_STAGE(PG8_SB(0, 0), b2, voffB); PG8_STAGE(PG8_SB(0, 1), b2 + hstepB, voffB); PG8_STAGE(PG8_SA(0, 0), a2, o20);
            PG8_WAIT_V8E(after_epi); PG8_WAIT_L(0); PG8_BAR;
            if constexpr (FP8) { if (t == 0) { PG8_MMAZ(1, 0, At, B0); PG8_MMAZ(1, 1, At, B1); } else { PG8_MMA(1, 0, At, B0); PG8_MMA(1, 1, At, B1); } } else { PG8_MMA(1, 0, At, B0); PG8_MMA(1, 1, At, B1); }
            PG8_BAR; PG8_SCHED;
            PG8_LDB(B0, 1, 0); PG8_LDB(B1, 1, 1); PG8_SCHED; PG8_LDA(At, 1, 0); PG8_STAGE(PG8_SA(0, 1), a2, o21);
            PG8_WAIT_V(8); PG8_WAIT_L(0); PG8_BAR; PG8_MMA(0, 0, At, B0); PG8_MMA(0, 1, At, B1); PG8_BAR; PG8_SCHED;
            PG8_LDA(At, 1, 1); PG8_STAGE(PG8_SB(1, 0), b3, voffB); PG8_STAGE(PG8_SB(1, 1), b3 + hstepB, voffB); PG8_STAGE(PG8_SA(1, 0), a3, o20);
            PG8_WAIT_V(8); PG8_WAIT_L(0); PG8_BAR; PG8_MMA(1, 0, At, B0); PG8_MMA(1, 1, At, B1); PG8_BAR; PG8_SCHED;
        }
        if (wr == 0) PG8_BAR;
        if constexpr (FP8) asm volatile("s_nop 15\n\ts_nop 15" ::: "memory");
        E(acc, cur, wr, wc, fr, fq);
        if (!has_next) break;
        if constexpr (!FP8) {
#pragma unroll
        for (int a = 0; a < 2; ++a)
#pragma unroll
            for (int b = 0; b < 2; ++b)
#pragma unroll
                for (int m = 0; m < 4; ++m)
#pragma unroll
                    for (int n = 0; n < 2; ++n) acc[a][b][m][n] = (f32x4){0.f, 0.f, 0.f, 0.f};
        }
        cur = nxt; cA = nA; cB = nB; ++ui;
#pragma unroll
        for (int i = 0; i < 2; ++i) { ofA0[i] = ofN0[i]; ofA1[i] = ofN1[i]; }
        if (wr == 1) PG8_BAR;
    }
    PG8_WAIT_V(0);
    PG8_BAR;
#undef PG8_SA
#undef PG8_SB
#undef PG8_STAGE
#undef PG8_LDA
#undef PG8_LD32
#undef PG8_LDB
#undef PG8_MMA
#undef PG8_MMAZ
#undef PG8_WAIT_V
#undef PG8_WAIT_V8E
#undef PG8_WAIT_L
#undef PG8_BAR
#undef PG8_SCHED
}

#define EPI_LOOP_ROWS for (int ai = 0; ai < 2; ++ai) _Pragma("unroll") for (int m = 0; m < 4; ++m)
__device__ __forceinline__ u32x4 pack8(const f32x4& v0, const f32x4& v1) { u32x4 w; w.x = cvt_pk_bf16(v0[0], v0[1]); w.y = cvt_pk_bf16(v0[2], v0[3]); w.z = cvt_pk_bf16(v1[0], v1[1]); w.w = cvt_pk_bf16(v1[2], v1[3]); return w; }
__device__ __forceinline__ void unpack8(const u32x4& w, f32x4& v0, f32x4& v1) { v0 = (f32x4){bf_lo(w.x), bf_hi(w.x), bf_lo(w.y), bf_hi(w.y)}; v1 = (f32x4){bf_lo(w.z), bf_hi(w.z), bf_lo(w.w), bf_hi(w.w)}; }
__device__ __forceinline__ unsigned pack4_fp8(const f32x4& v) { int w = __builtin_amdgcn_cvt_pk_fp8_f32(v[0], v[1], 0, false); w = __builtin_amdgcn_cvt_pk_fp8_f32(v[2], v[3], w, true); return (unsigned)w; }
__device__ __forceinline__ f32x4 sig4(const f32x4& v) { return (f32x4){fast_sigmoid(v[0]), fast_sigmoid(v[1]), fast_sigmoid(v[2]), fast_sigmoid(v[3])}; }

struct EpiZ {
    static constexpr bool PERM = true; static constexpr int NST = 0;
    bf16_t *Kb, *Vb, *Ug;
    __device__ __forceinline__ void operator()(const f32x4 (&acc)[2][2][4][2], const Unit& u, int wr, int wc, int fr, int fq) const {
        const int pn = u.pn;
#pragma unroll
        EPI_LOOP_ROWS {
            const int r = u.pm * BM + ai * HALF + wr * 64 + m * 16 + fr;
            if (r < KVROWS) { const int sp = r < T_TOK ? r + NMETA : r - T_TOK;
#pragma unroll
              for (int bj = 0; bj < 2; ++bj) {
                const int cl = bj * HALF + wc * 32 + 8 * fq;
                const f32x4 v0 = acc[ai][bj][m][0], v1 = acc[ai][bj][m][1];
                if (pn == 0) *(u32x4*)(Kb + (size_t)sp * KVW + cl) = pack8(v0, v1);
                else if (pn == 1) { bf16_t* vp = Vb + (size_t)cl * KVROWS + sp;
#pragma unroll
                    for (int j = 0; j < 4; ++j) { vp[(size_t)j * KVROWS] = (bf16_t)f2bf(v0[j]); vp[(size_t)(4 + j) * KVROWS] = (bf16_t)f2bf(v1[j]); } }
                else { const int col = (pn - 2) * BM + cl;
                    *(u32x4*)(Ug + ((size_t)(col >> 4) * KVROWS + sp) * 16 + (col & 15)) = pack8(v0, v1); }
              } }
        }
    }
};
struct EpiGate {
    static constexpr bool PERM = true; static constexpr int NST = 0; static constexpr int WIDE = 2;
    bf16_t *Q, *Ga, *Gs;
    __device__ __forceinline__ void operator()(const f32x4 (&acc)[2][2][4][2], const Unit& u, int wr, int wc, int fr, int fq) const {
        const int row0 = u.pm * BM + wr * 64 + fr, cl = wc * 64 + 8 * fq;
        if (u.pn < 8) {
            bf16_t* base = Q + (size_t)row0 * AW + u.pn * BM + cl;
#pragma unroll
            EPI_LOOP_ROWS {
#pragma unroll
                for (int bj = 0; bj < 2; ++bj) *(u32x4*)(base + (size_t)(ai * HALF + m * 16) * AW + bj * 32) = pack8(acc[ai][bj][m][0] * QSCALE, acc[ai][bj][m][1] * QSCALE); }
        } else {
            bf16_t* base = (u.pn < 24 ? Ga : Gs) + (size_t)row0 * DM + ((u.pn - 8) & 15) * BM + cl;
#pragma unroll
            EPI_LOOP_ROWS {
#pragma unroll
                for (int bj = 0; bj < 2; ++bj) __builtin_nontemporal_store(pack8(sig4(acc[ai][bj][m][0]), sig4(acc[ai][bj][m][1])), (u32x4*)(base + (size_t)(ai * HALF + m * 16) * DM + bj * 32)); }
        }
    }
};
struct EpiGlu {
    static constexpr bool PERM = true; static constexpr int NST = 0;
    const bf16_t* Y1; unsigned char* Y2;
    __device__ __forceinline__ void operator()(const f32x4 (&acc)[2][2][4][2], const Unit& u, int wr, int wc, int fr, int fq) const {
#pragma unroll
        EPI_LOOP_ROWS { const size_t r = (size_t)u.pm * BM + ai * HALF + wr * 64 + m * 16 + fr;
#pragma unroll
            for (int bj = 0; bj < 2; ++bj) { const size_t off = r * SW + u.pn * BM + bj * HALF + wc * 32 + 8 * fq;
                f32x4 y0, y1; unpack8(*(const u32x4*)(Y1 + off), y0, y1);
                *(u32x2*)(Y2 + off) = (u32x2){pack4_fp8(y0 * sig4(acc[ai][bj][m][0])), pack4_fp8(y1 * sig4(acc[ai][bj][m][1]))}; } }
    }
};
template <bool ADD> struct EpiMix {
    static constexpr bool PERM = true; static constexpr int NST = 0; static constexpr int WIDE = ADD ? 1 : 2;
    const bf16_t* Gt; bf16_t* Mix; unsigned char* MixQ;
    __device__ __forceinline__ void operator()(const f32x4 (&acc)[2][2][4][2], const Unit& u, int wr, int wc, int fr, int fq) const {
#pragma unroll
        EPI_LOOP_ROWS { const size_t r = (size_t)u.pm * BM + ai * HALF + wr * 64 + m * 16 + fr;
            const size_t off0 = r * DM + u.pn * BM + wc * 64 + (ADD ? 16 : 8) * fq; unsigned q[4];
#pragma unroll
            for (int bj = 0; bj < 2; ++bj) { const size_t off = off0 + bj * (ADD ? 8 : 32);
                f32x4 g0, g1; unpack8(*(const u32x4*)(Gt + off), g0, g1);
                f32x4 o0 = g0 * acc[ai][bj][m][0], o1 = g1 * acc[ai][bj][m][1];
                if (ADD) { f32x4 p0, p1; unpack8(*(const u32x4*)(Mix + off), p0, p1); o0 += p0; o1 += p1; q[2 * bj] = pack4_fp8(o0); q[2 * bj + 1] = pack4_fp8(o1); }
                else *(u32x4*)(Mix + off) = pack8(o0, o1); }
            if (ADD) *(u32x4*)(MixQ + off0) = (u32x4){q[0], q[1], q[2], q[3]};
        }
    }
};
struct EpiWout {
    static constexpr bool PERM = true; static constexpr int NST = 0; static constexpr int WIDE = 2;
    bf16_t* Out;
    __device__ __forceinline__ void operator()(const f32x4 (&acc)[2][2][4][2], const Unit& u, int wr, int wc, int fr, int fq) const {
        const int col0 = u.pn * BM + wc * 64 + 8 * fq;
#pragma unroll
        EPI_LOOP_ROWS { const size_t r = (size_t)u.pm * BM + ai * HALF + wr * 64 + m * 16 + fr; const size_t off = r * DM + col0;
#pragma unroll
            for (int bj = 0; bj < 2; ++bj) *(u32x4*)(Out + off + bj * 32) = pack8(acc[ai][bj][m][0], acc[ai][bj][m][1]); }
    }
};
struct EpiS13R {
    static constexpr bool PERM = true; static constexpr int NST = 0;
    bf16_t* ActS; float* Logits;
    __device__ __forceinline__ void operator()(const f32x4 (&acc)[2][2][4][2], const Unit& u, int wr, int wc, int fr, int fq) const {
#pragma unroll
        EPI_LOOP_ROWS { const size_t r = (size_t)u.pm * BM + ai * HALF + wr * 64 + m * 16 + fr; const int cl = wc * 32 + 8 * fq;
            if (u.pn < 4) { const f32x4 a0 = acc[ai][0][m][0], a1 = acc[ai][0][m][1];
                *(u32x4*)(ActS + r * EDIM + u.pn * HALF + cl) = pack8(a0 * sig4(a0) * acc[ai][1][m][0], a1 * sig4(a1) * acc[ai][1][m][1]); }
            else { *(f32x4*)(Logits + r * 128 + cl) = acc[ai][0][m][0]; *(f32x4*)(Logits + r * 128 + cl + 4) = acc[ai][0][m][1]; } }
    }
};
constexpr float WQ_SCALE = 64.f, WQ_INV = 1.f / 64.f;
struct EpiAct {
    static constexpr bool PERM = true; static constexpr int NST = 0;
    unsigned char* Act;
    __device__ __forceinline__ void operator()(const f32x4 (&acc)[2][2][4][2], const Unit& u, int wr, int wc, int fr, int fq) const {
#pragma unroll
        EPI_LOOP_ROWS { const size_t r = (size_t)u.pm * BM + ai * HALF + wr * 64 + m * 16 + fr; const int cl = wc * 32 + 8 * fq;
            const f32x4 a0 = acc[ai][0][m][0], a1 = acc[ai][0][m][1];
            *(u32x2*)(Act + r * EDIM + u.pn * HALF + cl) = (u32x2){pack4_fp8(a0 * sig4(a0) * acc[ai][1][m][0]), pack4_fp8(a1 * sig4(a1) * acc[ai][1][m][1])}; }
    }
};
struct EpiS2 {
    static constexpr bool PERM = true; static constexpr int NST = 0; static constexpr int WIDE = 2;
    bf16_t* H;
    __device__ __forceinline__ void operator()(const f32x4 (&acc)[2][2][4][2], const Unit& u, int wr, int wc, int fr, int fq) const {
#pragma unroll
        EPI_LOOP_ROWS { const size_t r = (size_t)u.pm * BM + ai * HALF + wr * 64 + m * 16 + fr;
#pragma unroll
            for (int bj = 0; bj < 2; ++bj) { bf16_t* p = H + r * DM + u.pn * BM + bj * 32 + wc * 64 + 8 * fq; f32x4 h0, h1; unpack8(*(const u32x4*)p, h0, h1);
                *(u32x4*)p = pack8(h0 * ALPHA + acc[ai][bj][m][0], h1 * ALPHA + acc[ai][bj][m][1]); } }
    }
};
struct EpiY {
    static constexpr bool PERM = true; static constexpr int NST = 8; static constexpr int WIDE = 1;
    unsigned char* Y;
    __device__ __forceinline__ void operator()(const f32x4 (&acc)[2][2][4][2], const Unit& u, int wr, int wc, int fr, int fq) const {
#pragma unroll
        EPI_LOOP_ROWS { const size_t r = (size_t)u.pm * BM + ai * HALF + wr * 64 + m * 16 + fr;
            *(u32x4*)(Y + r * DM + u.pn * BM + wc * 64 + 16 * fq) = (u32x4){pack4_fp8(acc[ai][0][m][0]), pack4_fp8(acc[ai][0][m][1]), pack4_fp8(acc[ai][1][m][0]), pack4_fp8(acc[ai][1][m][1])}; }
    }
};
}

struct Frame {
    LAS unsigned char* lds; gu32* ctl; unsigned char* ws;
    int tid, lane, wave, G, c;
    const float* const* in; float* out;
};
#define WSP(T, off) ((T*)(F.ws + (off)))

struct CvtRegs { f32x4 v[16]; };
__device__ __forceinline__ void cvt_load(CvtRegs& R, const float* __restrict__ W, size_t ldw, int k0, int n0, int lane) {
    const float* src = W + (size_t)(k0 + 2 * (lane >> 4)) * ldw + n0 + 4 * (lane & 15);
#pragma unroll
    for (int ip = 0; ip < 8; ++ip) { R.v[2 * ip] = __builtin_nontemporal_load((const f32x4*)(src + (size_t)(8 * ip) * ldw)); R.v[2 * ip + 1] = __builtin_nontemporal_load((const f32x4*)(src + (size_t)(8 * ip + 1) * ldw)); }
}
template <bool LO>
__device__ __forceinline__ void cvt_store(const CvtRegs& R, int k0, bf16_t* Wt, size_t dpitch, size_t drow0, LAS unsigned* scr, int lane) {
    const int kq = lane >> 4, n4 = 4 * (lane & 15);
#pragma unroll
    for (int ip = 0; ip < 8; ++ip) { f32x4 a = R.v[2 * ip], b = R.v[2 * ip + 1];
        if (LO) {
#pragma unroll
            for (int j = 0; j < 4; ++j) { a[j] -= __builtin_bit_cast(float, f2bf(a[j]) << 16); b[j] -= __builtin_bit_cast(float, f2bf(b[j]) << 16); } }
#pragma unroll
        for (int j = 0; j < 4; ++j) scr[(n4 + j) * 33 + 4 * ip + kq] = pk2(a[j], b[j]); }
    LDS_WAIT();
    const int c = lane & 7;
#pragma unroll
    for (int j = 0; j < 8; ++j) { const int n = (lane >> 3) + 8 * j; const LAS unsigned* s = scr + n * 33 + 4 * c;
        u32x4 o; o.x = s[0]; o.y = s[1]; o.z = s[2]; o.w = s[3];
        __builtin_nontemporal_store(o, (u32x4*)(Wt + (drow0 + n) * dpitch + k0 + 8 * c)); }
    LDS_WAIT();
}
template <bool LO>
__device__ __forceinline__ void cvt_tile(const float* __restrict__ W, size_t ldw, int k0, int n0, bf16_t* Wt, size_t dpitch, size_t drow0, LAS unsigned* scr, int lane) {
    CvtRegs R; cvt_load(R, W, ldw, k0, n0, lane); cvt_store<LO>(R, k0, Wt, dpitch, drow0, scr, lane);
}
__device__ __forceinline__ void cvt_load8(CvtRegs& R, const float* __restrict__ W, size_t ldw, int k0, int n0, int lane) {
    const float* src = W + (size_t)(k0 + 4 * (lane >> 3)) * ldw + n0 + 4 * (lane & 7);
#pragma unroll
    for (int ip = 0; ip < 4; ++ip)
#pragma unroll
        for (int b = 0; b < 4; ++b) R.v[4 * ip + b] = __builtin_nontemporal_load((const f32x4*)(src + (size_t)(32 * ip + b) * ldw));
}
__device__ __forceinline__ void cvt_store8(const CvtRegs& R, int k0, unsigned char* Wt, size_t dpitch, size_t drow0, float scale, LAS unsigned* scr, int lane, bool nt = true) {
    const int kr = lane >> 3, n4 = 4 * (lane & 7);
#pragma unroll
    for (int ip = 0; ip < 4; ++ip)
#pragma unroll
        for (int j = 0; j < 4; ++j) { int w = __builtin_amdgcn_cvt_pk_fp8_f32(R.v[4 * ip][j] * scale, R.v[4 * ip + 1][j] * scale, 0, false); w = __builtin_amdgcn_cvt_pk_fp8_f32(R.v[4 * ip + 2][j] * scale, R.v[4 * ip + 3][j] * scale, w, true);
            scr[(n4 + j) * 33 + 8 * ip + kr] = (unsigned)w; }
    LDS_WAIT();
    const int c = lane & 7;
#pragma unroll
    for (int j = 0; j < 4; ++j) { const int n = (lane >> 3) + 8 * j; const LAS unsigned* sp = scr + n * 33 + 4 * c;
        u32x4 o; o.x = sp[0]; o.y = sp[1]; o.z = sp[2]; o.w = sp[3];
        if (nt) __builtin_nontemporal_store(o, (u32x4*)(Wt + (drow0 + n) * dpitch + k0 + 16 * c)); else *(u32x4*)(Wt + (drow0 + n) * dpitch + k0 + 16 * c) = o; }
    LDS_WAIT();
}
struct CvtJob { const float* W; void* Wt; int K, N, mode, nmat; size_t wstride, dstride; int fp8; int ldw; };
__device__ __forceinline__ int cvt_job_tiles(const CvtJob& j) { return j.nmat * (j.K / 64) * (j.N / 64); }
struct CvtTile { const float* W; void* Wt; size_t ldw, dpitch, drow0; int k0, n0; };
__device__ __forceinline__ CvtTile cvt_job_tile(const CvtJob& j, int it) {
    const int tn = j.fp8 ? 32 : 64, tk = j.fp8 ? 128 : 64;
    const int nnb = j.N / tn, per = (j.K / tk) * nnb, mat = it / per, r = it % per, kb = r / nnb, nb = r % nnb, n0 = nb * tn;
    const size_t drow0 = j.mode == 0 ? (size_t)n0 : (size_t)(n0 >> 7) * 256 + (j.mode - 1) * 128 + (n0 & 127);
    void* wt = j.fp8 ? (void*)((unsigned char*)j.Wt + (size_t)mat * j.dstride) : (void*)((bf16_t*)j.Wt + (size_t)mat * j.dstride);
    return CvtTile{j.W + (size_t)mat * j.wstride, wt, (size_t)(j.ldw ? j.ldw : j.N), (size_t)j.K, drow0, kb * tk, n0};
}
__device__ __forceinline__ void ln_row(const float* xrow, const LAS f32x4* g, const LAS f32x4* b, int lane, f32x4 (&v)[16], float& mean, float& rstd) {
    const f32x4* xr = (const f32x4*)xrow + lane; float s = 0.f;
#pragma unroll
    for (int j = 0; j < 16; ++j) { v[j] = __builtin_nontemporal_load(xr + 64 * j); s += (v[j][0] + v[j][1]) + (v[j][2] + v[j][3]); }
    mean = wave_sum(s) * (1.f / DM); float s2 = 0.f;
#pragma unroll
    for (int j = 0; j < 16; ++j) { v[j] = v[j] - mean; s2 += (v[j][0] * v[j][0] + v[j][1] * v[j][1]) + (v[j][2] * v[j][2] + v[j][3] * v[j][3]); }
    rstd = 1.f / sqrtf(wave_sum(s2) * (1.f / DM) + LN_EPS);
    asm volatile("" ::: "memory");
#pragma unroll
    for (int j = 0; j < 16; ++j) { const f32x4 gg = g[lane + 64 * j], bb = b[lane + 64 * j]; v[j] = v[j] * rstd * gg + bb; }
}

__device__ __forceinline__ void cvt_run(const Frame& F, int j0, int j1, int gw, int NGW, LAS unsigned* scr, int tlo = 0, int thi = 0x7fffffff) {
    int done = 0;
#pragma unroll 1
    for (int jn = j0; jn < j1; ++jn) {
        CvtJob j;
        switch (jn) {
            case 0: j = CvtJob{F.in[4] + 2048, WSP(unsigned char, WS_WING) + (size_t)10240 * DM, DM, 1536, 0, 1, 0, 0, 1, NZ}; break;
            case 11: j = CvtJob{F.in[4] + 3584, WSP(unsigned char, WS_WING) + (size_t)2048 * DM, DM, 2 * DM, 0, 1, 0, 0, 1, NZ}; break;
            case 12: j = CvtJob{F.in[4], WSP(unsigned char, WS_WING), DM, 2048, 0, 1, 0, 0, 1, NZ}; break;
            case 1: j = CvtJob{F.in[6], WSP(unsigned char, WS_WAO), AW, DM, 0, 1, 0, 0, 1, 0}; break;
            case 2: j = CvtJob{F.in[15], WSP(bf16_t, WS_WGLU), SW, SW, 0, 1, 0, 0, 0, 0}; break;
            case 3: j = CvtJob{F.in[16], WSP(unsigned char, WS_WSO), SW, DM, 0, 1, 0, 0, 1, 0}; break;
            case 4: j = CvtJob{F.in[17], WSP(unsigned char, WS_WOUT), DM, DM, 0, 1, 0, 0, 1, 0}; break;
            case 5: j = CvtJob{F.in[25], WSP(bf16_t, WS_WS13), DM, EDIM, 1, 1, 0, 0, 0, 0}; break;
            case 6: j = CvtJob{F.in[26], WSP(bf16_t, WS_WS13), DM, EDIM, 2, 1, 0, 0, 0, 0}; break;
            case 7: j = CvtJob{F.in[27], WSP(bf16_t, WS_WS2), EDIM, DM, 0, 1, 0, 0, 0, 0}; break;
            case 8: j = CvtJob{F.in[22], WSP(unsigned char, WS_WE13), DM, EDIM, 1, NE, (size_t)DM * EDIM, (size_t)1024 * DM, 1, 0}; break;
            case 9: j = CvtJob{F.in[23], WSP(unsigned char, WS_WE13), DM, EDIM, 2, NE, (size_t)DM * EDIM, (size_t)1024 * DM, 1, 0}; break;
            default: j = CvtJob{F.in[24], WSP(unsigned char, WS_WE2), EDIM, DM, 0, NE, (size_t)EDIM * DM, (size_t)DM * EDIM, 1, 0}; break;
        }
        const int nt0 = cvt_job_tiles(j);
        const int nt = (thi - done) < nt0 ? (thi - done) : nt0;
        int it = (tlo - done) > 0 ? (tlo - done) : 0;
        { const int gfirst = done + it; const int r = (gw - (gfirst - tlo) % NGW + NGW) % NGW; it += r; }
        if (it < nt) {
            CvtTile tc = cvt_job_tile(j, it); CvtRegs Ra;
            if (j.fp8) cvt_load8(Ra, tc.W, tc.ldw, tc.k0, tc.n0, F.lane); else cvt_load(Ra, tc.W, tc.ldw, tc.k0, tc.n0, F.lane);
#pragma unroll 1
            for (;;) {
                const int itn = it + NGW; const bool more = itn < nt;
                CvtTile tn = tc; CvtRegs Rb;
                if (more) { tn = cvt_job_tile(j, itn); if (j.fp8) cvt_load8(Rb, tn.W, tn.ldw, tn.k0, tn.n0, F.lane); else cvt_load(Rb, tn.W, tn.ldw, tn.k0, tn.n0, F.lane); }
                if (j.fp8) cvt_store8(Ra, tc.k0, (unsigned char*)tc.Wt, tc.dpitch, tc.drow0, pg8::WQ_SCALE, scr, F.lane, j.ldw == 0); else cvt_store<false>(Ra, tc.k0, (bf16_t*)tc.Wt, tc.dpitch, tc.drow0, scr, F.lane);
                if (!more) break;
                Ra = Rb; tc = tn; it = itn;
            }
        }
        done += nt0;
    }
}
__device__ __forceinline__ void stage_gb(Frame& F, const float* g, const float* b) {
    __syncthreads();
    for (int i = F.tid; i < DM / 4; i += 512) { ((LAS f32x4*)F.lds)[i] = ((const f32x4*)g)[i]; ((LAS f32x4*)(F.lds + 16384))[i] = ((const f32x4*)b)[i]; }
    __syncthreads();
}
__device__ __forceinline__ void p0_prologue(Frame& F) {
    LAS unsigned* scr = (LAS unsigned*)(F.lds + 32768 + F.wave * 8704);
    const int gw = F.c * 8 + F.wave, NGW = F.G * 8;
    stage_gb(F, F.in[2], F.in[3]);
    { bf16_t* H0B = WSP(bf16_t, WS_H0B); f32x2* St0 = WSP(f32x2, WS_STATS0);
      for (int r = gw; r < ROWS_Z; r += NGW) {
          u32x2* o = (u32x2*)(H0B + (size_t)r * DM) + F.lane;
          if (r < KVROWS) { const float* src = r < T_TOK ? F.in[0] + (size_t)r * DM : F.in[1] + (size_t)(r - T_TOK) * DM;
              f32x4 v[16]; float mean, rstd; ln_row(src, (const LAS f32x4*)F.lds, (const LAS f32x4*)(F.lds + 16384), F.lane, v, mean, rstd);
              if (r < T_TOK && F.lane == 0) St0[r] = (f32x2){mean, rstd};
#pragma unroll
              for (int j = 0; j < 16; ++j) __builtin_nontemporal_store((u32x2){pk2(v[j][0], v[j][1]), pk2(v[j][2], v[j][3])}, o + 64 * j);
              { unsigned* oq = (unsigned*)(WSP(unsigned char, WS_H0Q) + (size_t)r * DM) + F.lane;
#pragma unroll
                  for (int j = 0; j < 16; ++j) oq[64 * j] = pg8::pack4_fp8(v[j]); }
          } else { unsigned* oq = (unsigned*)(WSP(unsigned char, WS_H0Q) + (size_t)r * DM) + F.lane;
#pragma unroll
              for (int j = 0; j < 16; ++j) { o[64 * j] = (u32x2){0u, 0u}; oq[64 * j] = 0u; }
          } } }
    cvt_run(F, 0, 8, gw, NGW, scr); cvt_run(F, 11, 13, gw, NGW, scr);
    { bf16_t* Wr = WSP(bf16_t, WS_WS13);
      for (int kb = gw; kb < DM / 64; kb += NGW) { cvt_tile<false>(F.in[20], NE, kb * 64, 0, Wr, DM, 1024, scr, F.lane); cvt_tile<true>(F.in[20], NE, kb * 64, 0, Wr, DM, 1088, scr, F.lane); }
      u32x4* z = (u32x4*)(Wr + (size_t)1152 * DM);
      for (int i = (F.c * 512 + F.tid); i < 128 * DM * 2 / 16; i += F.G * 512) z[i] = (u32x4){0u, 0u, 0u, 0u}; }
}

typedef float f32x16 __attribute__((ext_vector_type(16)));
constexpr int ATT_KP = 144, ATT_VP = 584, ATT_V_OFF = 288 * ATT_KP;
static_assert(ATT_V_OFF + 64 * ATT_VP <= RING_BYTES, "attention LDS");
__device__ __forceinline__ int att_src_pos(int key, int n) {
    if (key < 128) return n > 0 ? NMETA + 128 * (n - 1) + key : -1;
    if (key < 256) return NMETA + 128 * n + (key - 128);
    if (key < 272) return key - 256;
    return -1;
}
__device__ __forceinline__ void attn_unit(Frame& F, int n, int kh) {
    const bf16_t* Qb = WSP(bf16_t, WS_QB); const bf16_t* Kb = WSP(bf16_t, WS_KB); const bf16_t* Vt = WSP(bf16_t, WS_VB); unsigned char* At = WSP(unsigned char, WS_ATT);
    LAS unsigned char* Ks = F.lds; LAS unsigned char* Vs = F.lds + ATT_V_OFF;
    __syncthreads();
    for (int p = F.tid; p < 288 * 8; p += 512) { const int j = p >> 3, c8 = p & 7, sp = att_src_pos(j, n);
        u32x4 v = (u32x4){0u, 0u, 0u, 0u};
        if (sp >= 0) v = *(const u32x4*)(Kb + (size_t)sp * KVW + kh * 64 + c8 * 8);
        *(LAS u32x4*)(Ks + j * ATT_KP + c8 * 16) = v; }
    for (int p = F.tid; p < 64 * 36; p += 512) { const int d = p / 36, q = p % 36, sp = att_src_pos(q * 8, n);
        u32x4 v = (u32x4){0u, 0u, 0u, 0u};
        if (sp >= 0) v = *(const u32x4*)(Vt + (size_t)(kh * 64 + d) * KVROWS + sp);
        LAS u32x2* dst = (LAS u32x2*)(Vs + d * ATT_VP + q * 16); dst[0] = (u32x2){v.x, v.y}; dst[1] = (u32x2){v.z, v.w}; }
    __syncthreads();
    const int hq = kh * 8 + F.wave, r32 = F.lane & 31, hh = F.lane >> 5;
    const float sink2 = F.in[5][hq] * LOG2E;
    const bool prevok = n > 0;
#pragma unroll 1
    for (int qt = 0; qt < 4; ++qt) {
        const bf16_t* qrow = Qb + (size_t)(128 * n + 32 * qt + r32) * AW + hq * 64 + 8 * hh;
        bf16x8 qf[4];
#pragma unroll
        for (int t = 0; t < 4; ++t) qf[t] = *(const bf16x8*)(qrow + 16 * t);
        f32x16 sacc[6];
#pragma unroll
        for (int x = 0; x < 6; ++x) {
            const int kb = x < 4 - qt ? 32 * (qt + x) : (x < 5 ? 128 + 32 * (x - (4 - qt)) : 256);
            f32x16 acc;
#pragma unroll
            for (int i = 0; i < 16; ++i) acc[i] = 0.f;
#pragma unroll
            for (int t = 0; t < 4; ++t) { const bf16x8 kf = *(const LAS bf16x8*)(Ks + (kb + r32) * ATT_KP + (16 * t + 8 * hh) * 2); acc = __builtin_amdgcn_mfma_f32_32x32x16_bf16(kf, qf[t], acc, 0, 0, 0); }
#pragma unroll
            for (int i = 0; i < 16; ++i) { const int m = (i & 3) + 8 * (i >> 2) + 4 * hh;
                bool vis;
                if (x < 4 - qt) vis = prevok && (x > 0 || m > r32);
                else if (x < 5) vis = (x < 4) || (m <= r32);
                else vis = m < 16;
                acc[i] = vis ? acc[i] : -1e30f; }
            sacc[x] = acc;
        }
        float mx = sink2;
#pragma unroll
        for (int x = 0; x < 6; ++x)
#pragma unroll
            for (int i = 0; i < 16; ++i) mx = fmaxf(mx, sacc[x][i]);
        mx = fmaxf(mx, __shfl_xor(mx, 32));
        float l = 0.f;
#pragma unroll
        for (int x = 0; x < 6; ++x)
#pragma unroll
            for (int i = 0; i < 16; ++i) { const float p = __builtin_amdgcn_exp2f(sacc[x][i] - mx); sacc[x][i] = p; l += p; }
        l += __shfl_xor(l, 32); l += __builtin_amdgcn_exp2f(sink2 - mx);
        f32x16 oacc[2];
#pragma unroll
        for (int dt = 0; dt < 2; ++dt)
#pragma unroll
            for (int i = 0; i < 16; ++i) oacc[dt][i] = 0.f;
#pragma unroll
        for (int x = 0; x < 6; ++x) {
            const int kb = x < 4 - qt ? 32 * (qt + x) : (x < 5 ? 128 + 32 * (x - (4 - qt)) : 256);
#pragma unroll
            for (int t2 = 0; t2 < 2; ++t2) {
                u32x4 pw; pw.x = pg8::cvt_pk_bf16(sacc[x][8 * t2 + 0], sacc[x][8 * t2 + 1]); pw.y = pg8::cvt_pk_bf16(sacc[x][8 * t2 + 2], sacc[x][8 * t2 + 3]);
                pw.z = pg8::cvt_pk_bf16(sacc[x][8 * t2 + 4], sacc[x][8 * t2 + 5]); pw.w = pg8::cvt_pk_bf16(sacc[x][8 * t2 + 6], sacc[x][8 * t2 + 7]);
                const bf16x8 pf = __builtin_bit_cast(bf16x8, pw);
#pragma unroll
                for (int dt = 0; dt < 2; ++dt) { const LAS u32x2* vp = (const LAS u32x2*)(Vs + (32 * dt + r32) * ATT_VP + (kb + 16 * t2 + 4 * hh) * 2);
                    const u32x2 a = vp[0], b = vp[2]; u32x4 vw; vw.x = a.x; vw.y = a.y; vw.z = b.x; vw.w = b.y;
                    oacc[dt] = __builtin_amdgcn_mfma_f32_32x32x16_bf16(__builtin_bit_cast(bf16x8, vw), pf, oacc[dt], 0, 0, 0); }
            }
        }
        const float inv = 1.f / l;
        unsigned char* orow = At + (size_t)(128 * n + 32 * qt + r32) * AW + hq * 64 + 4 * hh;
#pragma unroll
        for (int dt = 0; dt < 2; ++dt)
#pragma unroll
            for (int g = 0; g < 4; ++g) *(unsigned*)(orow + 32 * dt + 8 * g) = pg8::pack4_fp8((f32x4){oacc[dt][4 * g] * inv, oacc[dt][4 * g + 1] * inv, oacc[dt][4 * g + 2] * inv, oacc[dt][4 * g + 3] * inv});
    }
}

constexpr int SSM_NCH = KVROWS / 8, SSM_NBLK = (SSM_NCH + 63) / 64, SSM_EP = 132, SSM_SP = 272, SSM_UP = 272;
constexpr int SSM_UB = 0  , SSM_EB = 3 * 64 * SSM_UP  , SSM_SB = SSM_EB + 2 * 64 * SSM_EP * 4  ;
constexpr int SSM_APOW = SSM_EB, SSM_BBAR = SSM_APOW + 4608, SSM_KD = SSM_BBAR + 8192;
static_assert(SSM_KD + 16384 <= SSM_SB && SSM_SB + 64 * SSM_SP <= LUT_OFF, "SSM LDS");
__device__ __forceinline__ bf16x8 pack_frag(const float (&v)[8]) { u32x4 w; w.x = pk2(v[0], v[1]); w.y = pk2(v[2], v[3]); w.z = pk2(v[4], v[5]); w.w = pk2(v[6], v[7]); return __builtin_bit_cast(bf16x8, w); }
__device__ __forceinline__ f32x2 gelu_pk(f32x2 v) {
    const f32x2 av = __builtin_elementwise_abs(v), d = av * 0.2316418882f + 1.0f;
    f32x2 t; t.x = __builtin_amdgcn_rcpf(d.x); t.y = __builtin_amdgcn_rcpf(d.y);
    f32x2 q = t * 0.5307027145f + (-0.7265760135f); q = q * t + 0.7107068705f; q = q * t + (-0.142248368f); q = q * t + 0.127414796f; q = q * t;
    const f32x2 sq = (v * v) * (-0.72134752044f);
    f32x2 e; e.x = __builtin_amdgcn_exp2f(sq.x); e.y = __builtin_amdgcn_exp2f(sq.y);
    const f32x2 m = v * (q * e), r = v - m;
    f32x2 o; o.x = v.x < 0.f ? m.x : r.x; o.y = v.y < 0.f ? m.y : r.y; return o;
}
__device__ __forceinline__ void ssm_unit(Frame& F, int g, int bfull, int bend) {
    const int tid = F.tid, lane = F.lane, w = F.wave, nl = lane & 15, kg = lane >> 4;
    LAS f32x2* apow = (LAS f32x2*)(F.lds + SSM_APOW);
    LAS f32x2* bbar = (LAS f32x2*)(F.lds + SSM_BBAR);
    LAS float* Kd = (LAS float*)(F.lds + SSM_KD);
    LAS f32x2* clds = (LAS f32x2*)(F.lds + SSM_KD + 8192);
    LAS float* eb = (LAS float*)(F.lds + SSM_EB);
    LAS unsigned char* sb = F.lds + SSM_SB;
    LAS unsigned char* ub = F.lds + SSM_UB;
    const float* Cre = F.in[12] + (size_t)g * 16 * 64; const float* Cim = F.in[13] + (size_t)g * 16 * 64;
    const bf16_t* Ub = WSP(bf16_t, WS_UG) + (size_t)g * KVROWS * 16;
    const int ur0 = tid >> 4, uc0 = tid & 15;
#define SSM_ULOAD(b, r0, r1) do { r0 = *(const u32x4*)(Ub + (size_t)(64 * (b) + ur0) * 128 + uc0 * 8); r1 = *(const u32x4*)(Ub + (size_t)(64 * (b) + 32 + ur0) * 128 + uc0 * 8); } while (0)
#define SSM_USTORE(b, r0, r1) do { LAS unsigned char* u_ = ub + ((b) % 3) * 64 * SSM_UP; *(LAS u32x4*)(u_ + ur0 * SSM_UP + uc0 * 16) = r0; *(LAS u32x4*)(u_ + (32 + ur0) * SSM_UP + uc0 * 16) = r1; } while (0)
    u32x4 ua0, ua1, ub0, ub1;
    __syncthreads();
    SSM_ULOAD(0, ua0, ua1); SSM_ULOAD(1, ub0, ub1);
    { const int p = tid & 63, d = tid >> 6; const float dt = expf(F.in[9][g]), lr = F.in[7][g * 64 + p], li = F.in[8][g * 64 + p];
      { const float mg = expf(d * dt * lr); float sn, cs; sincosf(d * dt * li, &sn, &cs); apow[d * 64 + p] = (f32x2){mg * cs, mg * sn}; }
      if (d == 0) { const float mg = expf(8.f * dt * lr); float sn, cs; sincosf(8.f * dt * li, &sn, &cs); apow[8 * 64 + p] = (f32x2){mg * cs, mg * sn}; }
      if (d == 1) {
        const float em1 = expm1f(dt * lr), th = dt * li; float sn, cs; sincosf(th, &sn, &cs);
        const float ai = (em1 + 1.f) * sn, sh = sinf(0.5f * th), num_re = em1 * cs - 2.f * sh * sh;
        const float den = lr * lr + li * li, cre = (num_re * lr + ai * li) / den, cim = (ai * lr - num_re * li) / den;
        const float* br = F.in[10] + (size_t)(g * 64 + p) * 16; const float* bi = F.in[11] + (size_t)(g * 64 + p) * 16;
#pragma unroll
        for (int h = 0; h < 16; ++h) bbar[p * 16 + h] = (f32x2){cre * br[h] - cim * bi[h], cre * bi[h] + cim * br[h]};
      }
      for (int i = tid; i < 1024; i += 512) clds[i] = (f32x2){Cre[i], Cim[i]};
    }
    SSM_USTORE(0, ua0, ua1); SSM_USTORE(1, ub0, ub1);
    __syncthreads();
    { const int d = tid >> 6, ho = (tid >> 2) & 15, hq = tid & 3; float k0 = 0.f, k1 = 0.f, k2 = 0.f, k3 = 0.f;
#pragma unroll 8
      for (int p = 0; p < 64; ++p) { const f32x2 cc = clds[ho * 64 + p]; const float cr = cc.x, ci = cc.y; const f32x2 a = apow[d * 64 + p]; const float wr = cr * a.x - ci * a.y, wi = cr * a.y + ci * a.x;
          const f32x2 b0 = bbar[p * 16 + 4 * hq], b1 = bbar[p * 16 + 4 * hq + 1], b2 = bbar[p * 16 + 4 * hq + 2], b3 = bbar[p * 16 + 4 * hq + 3];
          k0 += wr * b0.x - wi * b0.y; k1 += wr * b1.x - wi * b1.y; k2 += wr * b2.x - wi * b2.y; k3 += wr * b3.x - wi * b3.y; }
      *(LAS f32x4*)(Kd + (d * 16 + ho) * 16 + 4 * hq) = (f32x4){k0, k1, k2, k3}; }
    __syncthreads();
    bf16x8 bE[4], bT[4], bC[4];
    { const int p = (16 * w + nl) & 63; const bool im = w >= 4;
#pragma unroll
      for (int t = 0; t < 4; ++t) { const int j = 2 * t + (kg >> 1); const f32x2 a = apow[(7 - j) * 64 + p]; float v[8];
#pragma unroll
          for (int jj = 0; jj < 8; ++jj) { const f32x2 b = bbar[p * 16 + 8 * (kg & 1) + jj]; v[jj] = im ? (a.x * b.y + a.y * b.x) : (a.x * b.x - a.y * b.y); }
          bE[t] = pack_frag(v); } }
#pragma unroll
    for (int t = 0; t < 4; ++t) { const int j = 2 * t + (kg >> 1); float v[8];
#pragma unroll
        for (int jj = 0; jj < 8; ++jj) v[jj] = (j <= w) ? Kd[(((w - j) & 7) * 16 + nl) * 16 + 8 * (kg & 1) + jj] : 0.f;
        bT[t] = pack_frag(v); }
#pragma unroll
    for (int t = 0; t < 4; ++t) { float v[8];
#pragma unroll
        for (int jj = 0; jj < 8; ++jj) { const int p = 16 * t + 4 * kg + (jj >> 1); const f32x2 a = apow[(w + 1) * 64 + p]; const f32x2 cc = clds[nl * 64 + p]; const float cr = cc.x, ci = cc.y;
            v[jj] = (jj & 1) == 0 ? (cr * a.x - ci * a.y) : (-cr * a.y - ci * a.x); }
        bC[t] = pack_frag(v); }
    const f32x2 a8 = apow[8 * 64 + lane];
    const int ecol = 2 * ((16 * w + nl) & 63) + (w >> 2);
    bf16_t* Y1 = WSP(bf16_t, WS_Y1); const float dsk = F.in[14][g * 16 + nl];
#define SSM_UFRAG(b, mt, t) (*(const LAS bf16x8*)(ub + ((b) % 3) * 64 * SSM_UP + (16 * (mt) + nl) * SSM_UP + (32 * (t) + 8 * kg) * 2))
#define SSM_EGEMM(b) do { LAS float* e_ = eb + ((b) & 1) * 64 * SSM_EP; _Pragma("unroll") for (int mt = 0; mt < 4; ++mt) { f32x4 c_ = (f32x4){0.f, 0.f, 0.f, 0.f}; \
        _Pragma("unroll") for (int t = 0; t < 4; ++t) c_ = __builtin_amdgcn_mfma_f32_16x16x32_bf16(SSM_UFRAG(b, mt, t), bE[t], c_, 0, 0, 0); \
        _Pragma("unroll") for (int r = 0; r < 4; ++r) e_[(16 * mt + 4 * kg + r) * SSM_EP + ecol] = c_[r]; } } while (0)
    __syncthreads();
    SSM_EGEMM(0);
    f32x2 xs = (f32x2){0.f, 0.f};
    __syncthreads();
#pragma unroll 1
    for (int b = 0; b < bend; ++b) {
        const bool full = b >= bfull;
        if (b + 2 < bend) SSM_ULOAD(b + 2, ua0, ua1);
        if (w == 0) {
            const LAS f32x2* e_ = (const LAS f32x2*)(eb + (b & 1) * 64 * SSM_EP) + lane;
            const f32x2 aa = (f32x2){a8.x, a8.x}, ab = (f32x2){-a8.y, a8.y};
#pragma unroll
            for (int hf = 0; hf < 2; ++hf) { f32x2 ev[32];
#pragma unroll
                for (int c = 0; c < 32; ++c) ev[c] = e_[(32 * hf + c) * (SSM_EP / 2)];
#pragma unroll
                for (int c = 0; c < 32; ++c) { *(LAS unsigned*)(sb + (32 * hf + c) * SSM_SP + lane * 4) = pk2(xs.x, xs.y);
                    xs = aa * xs + (ab * (f32x2){xs.y, xs.x} + ev[c]); } }
        }
        f32x4 acc[4];
        if (full) {
#pragma unroll
            for (int mt = 0; mt < 4; ++mt) { acc[mt] = (f32x4){0.f, 0.f, 0.f, 0.f};
#pragma unroll
                for (int t = 0; t < 4; ++t) acc[mt] = __builtin_amdgcn_mfma_f32_16x16x32_bf16(SSM_UFRAG(b, mt, t), bT[t], acc[mt], 0, 0, 0); }
        }
        if (b + 1 < bend) SSM_EGEMM(b + 1);
        if (b + 2 < bend) SSM_USTORE(b + 2, ua0, ua1);
        __syncthreads();
        if (full) {
#pragma unroll
            for (int mt = 0; mt < 4; ++mt) {
#pragma unroll
                for (int t = 0; t < 4; ++t) { const bf16x8 sf = *(const LAS bf16x8*)(sb + (16 * mt + nl) * SSM_SP + (32 * t + 8 * kg) * 2); acc[mt] = __builtin_amdgcn_mfma_f32_16x16x32_bf16(sf, bC[t], acc[mt], 0, 0, 0); }
            }
            { const LAS unsigned char* u_ = ub + (b % 3) * 64 * SSM_UP;
#pragma unroll
              for (int mt = 0; mt < 4; ++mt)
#pragma unroll
                for (int r2 = 0; r2 < 2; ++r2) { const int row = 16 * mt + 4 * kg + 2 * r2, ch = 64 * b + row, pos = 8 * ch + w;
                    const float u0 = bf2f(*(const LAS bf16_t*)(u_ + row * SSM_UP + (w * 16 + nl) * 2)), u1 = bf2f(*(const LAS bf16_t*)(u_ + (row + 1) * SSM_UP + (w * 16 + nl) * 2));
                    const f32x2 ge = gelu_pk((f32x2){acc[mt][2 * r2] + dsk * u0, acc[mt][2 * r2 + 1] + dsk * u1});
                    if (ch < SSM_NCH && pos >= NMETA) Y1[(size_t)(pos - NMETA) * SW + g * 16 + nl] = (bf16_t)f2bf(ge.x);
                    if (ch + 1 < SSM_NCH && pos + 8 >= NMETA) Y1[(size_t)(pos + 8 - NMETA) * SW + g * 16 + nl] = (bf16_t)f2bf(ge.y); } }
            __syncthreads();
        }
    }
#undef SSM_ULOAD
#undef SSM_USTORE
#undef SSM_UFRAG
#undef SSM_EGEMM
}

__device__ __forceinline__ void ln1_pass(Frame& F) {
    const int gw = F.c * 8 + F.wave, NGW = F.G * 8;
    const bf16_t* H = WSP(bf16_t, WS_H1F); const bf16_t* H0 = WSP(bf16_t, WS_H0B); bf16_t* Hb = WSP(bf16_t, WS_H1B); unsigned char* Hq = WSP(unsigned char, WS_H1LO);
    stage_gb(F, F.in[18], F.in[19]);
    const LAS f32x4* gl = (const LAS f32x4*)F.lds; const LAS f32x4* bl = (const LAS f32x4*)(F.lds + 16384);
#pragma unroll 1
    for (int r = gw; r < T_TOK; r += NGW) {
        const u32x2* x = (const u32x2*)(H + (size_t)r * DM) + F.lane; const u32x2* x0 = (const u32x2*)(H0 + (size_t)r * DM) + F.lane;
        u32x2* ob = (u32x2*)(Hb + (size_t)r * DM) + F.lane; unsigned* oq = (unsigned*)(Hq + (size_t)r * DM) + F.lane;
        float s = 0.f, q = 0.f;
#pragma unroll
        for (int j = 0; j < 16; ++j) { const u32x2 w = x[64 * j], w0 = x0[64 * j];
            const f32x4 v = (f32x4){bf_lo(w0.x), bf_hi(w0.x), bf_lo(w0.y), bf_hi(w0.y)} * ALPHA + (f32x4){bf_lo(w.x), bf_hi(w.x), bf_lo(w.y), bf_hi(w.y)};
            s += (v[0] + v[1]) + (v[2] + v[3]); q += (v[0] * v[0] + v[1] * v[1]) + (v[2] * v[2] + v[3] * v[3]); }
        const float mean = wave_sum(s) * (1.f / DM), var = fmaxf(wave_sum(q) * (1.f / DM) - mean * mean, 0.f), rstd = 1.f / sqrtf(var + LN_EPS);
        asm volatile("" ::: "memory");
#pragma unroll
        for (int j = 0; j < 16; ++j) { const u32x2 w = __builtin_nontemporal_load(x + 64 * j), w0 = __builtin_nontemporal_load(x0 + 64 * j);
            const f32x4 v = (f32x4){bf_lo(w0.x), bf_hi(w0.x), bf_lo(w0.y), bf_hi(w0.y)} * ALPHA + (f32x4){bf_lo(w.x), bf_hi(w.x), bf_lo(w.y), bf_hi(w.y)};
            const f32x4 y = (v - mean) * rstd * gl[F.lane + 64 * j] + bl[F.lane + 64 * j];
            ob[64 * j] = (u32x2){pk2(y[0], y[1]), pk2(y[2], y[3])}; __builtin_nontemporal_store(pg8::pack4_fp8(y), oq + 64 * j);
            if ((j & 3) == 3) asm volatile("" ::: "memory"); }
    }
}

__device__ __forceinline__ void route_pass(Frame& F) {
    const int gw = F.c * 8 + F.wave, NGW = F.G * 8, lane = F.lane;
    LAS unsigned* hist = (LAS unsigned*)F.lds;
    __syncthreads();
    if (F.tid < NE) hist[F.tid] = 0u;
    __syncthreads();
    const float* Lg = WSP(float, WS_LOGITS); int* TI = WSP(int, WS_TOPI); float* TW = WSP(float, WS_TOPW);
    const float bias = F.in[21][lane];
    for (int t = gw; t < T_TOK; t += NGW) {
        const float lg = Lg[(size_t)t * 128 + lane] + Lg[(size_t)t * 128 + 64 + lane];
        const float score = 1.f / (1.f + expf(-lg)), sel = score + bias;
        int rk = 0;
#pragma unroll
        for (int x = 1; x < 8; ++x) { const float o = __shfl_xor(sel, x); const int pl = lane ^ x; rk += (o > sel || (o == sel && pl < lane)) ? 1 : 0; }
        float gs = rk < 2 ? sel : 0.f; gs += __shfl_xor(gs, 1); gs += __shfl_xor(gs, 2); gs += __shfl_xor(gs, 4);
        int grk = 0; const int mg = lane >> 3;
#pragma unroll
        for (int x = 1; x < 8; ++x) { const float o = __shfl_xor(gs, 8 * x); const int og = mg ^ x; grk += (o > gs || (o == gs && og < mg)) ? 1 : 0; }
        float val = grk < 4 ? sel : -1e30f;
        int myi = 0; float myw = 0.f, wsum = 0.f;
#pragma unroll
        for (int k = 0; k < TOPK; ++k) {
            const float mx = wave_max(val); const unsigned long long bal = __ballot(val == mx); const int win = __builtin_ctzll(bal);
            const float ws = __shfl(score, win); wsum += ws;
            if (lane == k) { myi = win; myw = ws; }
            if (lane == win) val = -3e38f;
        }
        if (lane < TOPK) { TI[t * TOPK + lane] = myi; TW[t * TOPK + lane] = myw / wsum * 2.5f; __hip_atomic_fetch_add(&hist[myi], 1u, __ATOMIC_RELAXED, __HIP_MEMORY_SCOPE_WORKGROUP); }
    }
    __syncthreads();
    if (F.tid < NE && hist[F.tid]) __hip_atomic_fetch_add(F.ctl + CW_CNT + F.tid, hist[F.tid], RLX_AGENT);
    __syncthreads();
}

__device__ __forceinline__ void lists_pass(Frame& F) {
    LAS int* sh = (LAS int*)F.lds;
    const int* TI = WSP(int, WS_TOPI); int* POS = WSP(int, WS_POS); int* RT = WSP(int, WS_ROWTOK); int* TE = WSP(int, WS_TILEE); int* UT = WSP(int, WS_UTAB);
    for (int e = F.c; e < NE; e += F.G) {
        __syncthreads();
        if (F.tid < NE) sh[F.tid] = (int)__hip_atomic_load(F.ctl + CW_CNT + F.tid, RLX_AGENT);
        __syncthreads();
        int tb = 0; for (int j = 0; j < e; ++j) tb += (sh[j] + 255) >> 8;
        const int cnt = sh[e], mytiles = (cnt + 255) >> 8, base = tb * 256;
        if (e == NE - 1 && F.tid == 0) __hip_atomic_store(F.ctl + CW_NTILES, (unsigned)(tb + mytiles), RLX_AGENT);
        int kk[16]; int loc = 0;
#pragma unroll
        for (int j = 0; j < 16; ++j) { const int t = F.tid * 16 + j; const u32x4 a = *(const u32x4*)(TI + t * 8), b = *(const u32x4*)(TI + t * 8 + 4);
            int k = -1; k = (int)a.x == e ? 0 : k; k = (int)a.y == e ? 1 : k; k = (int)a.z == e ? 2 : k; k = (int)a.w == e ? 3 : k; k = (int)b.x == e ? 4 : k; k = (int)b.y == e ? 5 : k; k = (int)b.z == e ? 6 : k; k = (int)b.w == e ? 7 : k;
            kk[j] = k; loc += (k >= 0) ? 1 : 0; }
        int inc = loc;
#pragma unroll
        for (int o = 1; o < 64; o <<= 1) { const int v = __shfl_up(inc, o); if (F.lane >= o) inc += v; }
        if (F.lane == 63) sh[64 + F.wave] = inc;
        __syncthreads();
        int woff = 0; for (int w = 0; w < F.wave; ++w) woff += sh[64 + w];
        int rank = woff + inc - loc;
#pragma unroll
        for (int j = 0; j < 16; ++j) if (kk[j] >= 0) { const int t = F.tid * 16 + j; RT[base + rank] = t; POS[t * 8 + kk[j]] = base + rank; ++rank; }
        for (int i = cnt + F.tid; i < mytiles * 256; i += 512) RT[base + i] = 0;
        if (F.tid < mytiles) TE[tb + F.tid] = e;
        for (int idx = F.tid; idx < mytiles * 16; idx += 512) { const int pb = idx / (mytiles * 8), rem = idx % (mytiles * 8), t = rem >> 3, pn = pb * 8 + (rem & 7);
            UT[tb * 16 + idx] = (tb + t) | (pn << 16) | (e << 24); }
    }
}

__device__ __forceinline__ void combine_pass(Frame& F) {
    const int gw = F.c * 8 + F.wave, NGW = F.G * 8;
    const bf16_t* H = WSP(bf16_t, WS_H1B); const unsigned char* Y = WSP(unsigned char, WS_YB); const int* POS = WSP(int, WS_POS); const float* TW = WSP(float, WS_TOPW);
    stage_gb(F, F.in[28], F.in[29]);
    for (int t = gw; t < T_TOK; t += NGW) {
        f32x4 v[16]; const u32x2* hr = (const u32x2*)(H + (size_t)t * DM) + F.lane;
#pragma unroll
        for (int j = 0; j < 16; ++j) { const u32x2 h = __builtin_nontemporal_load(hr + 64 * j); v[j] = (f32x4){bf_lo(h.x), bf_hi(h.x), bf_lo(h.y), bf_hi(h.y)}; }
#pragma unroll 2
        for (int k = 0; k < TOPK; ++k) { const int row = POS[t * TOPK + k]; const float w = TW[t * TOPK + k]; const unsigned* yr = (const unsigned*)(Y + (size_t)row * DM) + F.lane;
#pragma unroll
            for (int j = 0; j < 16; ++j) { const int y = (int)__builtin_nontemporal_load(yr + 64 * j); const f32x2 lo = __builtin_amdgcn_cvt_pk_f32_fp8(y, false), hi = __builtin_amdgcn_cvt_pk_f32_fp8(y, true); v[j] += (f32x4){lo.x, lo.y, hi.x, hi.y} * w; } }
        float s = 0.f;
#pragma unroll
        for (int j = 0; j < 16; ++j) s += (v[j][0] + v[j][1]) + (v[j][2] + v[j][3]);
        const float mean = wave_sum(s) * (1.f / DM); float s2 = 0.f;
#pragma unroll
        for (int j = 0; j < 16; ++j) { v[j] = v[j] - mean; s2 += (v[j][0] * v[j][0] + v[j][1] * v[j][1]) + (v[j][2] * v[j][2] + v[j][3] * v[j][3]); }
        const float rstd = 1.f / sqrtf(wave_sum(s2) * (1.f / DM) + LN_EPS);
        f32x4* o = (f32x4*)(F.out + (size_t)t * DM) + F.lane;
        asm volatile("" ::: "memory");
#pragma unroll
        for (int j = 0; j < 16; ++j) { const f32x4 gg = ((const LAS f32x4*)F.lds)[F.lane + 64 * j], bb = ((const LAS f32x4*)(F.lds + 16384))[F.lane + 64 * j]; __builtin_nontemporal_store(v[j] * rstd * gg + bb, o + 64 * j); }
    }
}

#ifndef DUMP
#define DUMP 0
#endif
__device__ __forceinline__ void dump_f32(Frame& F, const float* src) {
    for (size_t i = (size_t)F.c * 512 + F.tid; i < (size_t)T_TOK * DM / 4; i += (size_t)F.G * 512) ((f32x4*)F.out)[i] = ((const f32x4*)src)[i];
}
__device__ __forceinline__ void dump_bf16(Frame& F, const bf16_t* src, int ld, int ncols, int colofs, size_t nrows) {
    for (size_t i = (size_t)F.c * 512 + F.tid; i < nrows * ncols; i += (size_t)F.G * 512) { const size_t r = i / ncols, c = i % ncols; if (r < T_TOK) F.out[r * DM + colofs + c] = bf2f(src[r * ld + c]); }
}
__device__ __forceinline__ void dump_zero(Frame& F) {
    for (size_t i = (size_t)F.c * 512 + F.tid; i < (size_t)T_TOK * DM / 4; i += (size_t)F.G * 512) ((f32x4*)F.out)[i] = (f32x4){0.f, 0.f, 0.f, 0.f};
}
__device__ __forceinline__ void p1_convert(Frame& F, int when) {
    int c = F.c; asm volatile("" : "+s"(c));
    LAS unsigned* scr = (LAS unsigned*)(F.lds + F.wave * 8704);
    const bool split = (F.G == 256);
    const int NT = split ? CVT_P1_TILES : 3 * NE * 64 * 8;
    if (!split) { if (when == 0) cvt_run(F, 8, 11, c * 8 + F.wave, F.G * 8, scr); return; }
    const int nA = 58, sB = 312, sA = 372;
    const int kc = (c >> 3) & 1;
    if (kc != when) return;
    int tlo, thi;
    if (c < 256 - nA) { tlo = c * sB; thi = tlo + sB; } else { tlo = (256 - nA) * sB + (c - (256 - nA)) * sA; thi = tlo + sA; }
    if (thi > NT) thi = NT; if (tlo > NT) tlo = NT;
    cvt_run(F, 8, 11, F.wave, 8, scr, tlo, thi);
}
struct Args { const float* in[30]; float* out; unsigned char* ws; int ph_lo, ph_hi, one, pad; };
__global__ void __launch_bounds__(512, 2) mk_fwd(Args args) {
    extern __shared__ __attribute__((aligned(16))) unsigned char lds[];
    Frame F;
    F.lds = (LAS unsigned char*)lds; F.ws = args.ws; F.ctl = (gu32*)(args.ws + WS_CTL);
    F.tid = threadIdx.x; F.lane = F.tid & 63; F.wave = __builtin_amdgcn_readfirstlane(F.tid >> 6); F.G = gridDim.x; F.c = blockIdx.x;
    F.in = args.in; F.out = args.out;
    volatile LAS unsigned* MISC = (volatile LAS unsigned*)(F.lds + MISC_OFF);
    for (int u = F.tid; u < (LDS_BYTES - RING_BYTES) / 4; u += 512) ((LAS unsigned*)(F.lds + RING_BYTES))[u] = 0u;
    __syncthreads();
    XcdBarrier bar; bar.bar = (unsigned*)(F.ctl + CW_BAR); bar.x = 0; bar.st = nullptr;
    if (args.one) bar = xcd_barrier_post((unsigned*)(F.ctl + CW_BAR), MISC + 8);
    const int lo = args.ph_lo, hi = args.ph_hi;
#ifndef PH_MASK
#define PH_MASK 0xffffffffu
#endif
#define IN(k) (((PH_MASK >> (k)) & 1u) && lo <= (k) && (k) < hi)
#define SEAM(k) do { if (IN(k) && IN((k) + 1)) xcd_barrier(bar); REFRESH(); } while (0)
#define REFRESH() do { int t_ = threadIdx.x; asm volatile("" : "+v"(t_)); F.tid = t_; F.lane = t_ & 63; F.wave = __builtin_amdgcn_readfirstlane(t_ >> 6); } while (0)
#ifndef HOT12
#define HOT12 0
#endif
#ifndef PROBE_REP
#define PROBE_REP 0u
#endif
#define RUN(k, ...) if (IN(k)) { __VA_ARGS__ if ((PROBE_REP >> (k)) & 1u) { xcd_barrier(bar); REFRESH(); __VA_ARGS__ } }
    LAS unsigned char* ring = F.lds;

    RUN(0, { p0_prologue(F);  }) SEAM(0);
    RUN(1, {
        p1_convert(F, 0); __syncthreads();
        { pg8::DenseSched S{(const char*)WSP(unsigned char, WS_H0Q), (const char*)(WSP(unsigned char, WS_WING) + (size_t)10240 * DM), DM / 2, 33, 6, F.G, F.c, 0, 0, 0};
          pg8::EpiZ E{WSP(bf16_t, WS_KB), WSP(bf16_t, WS_VB), WSP(bf16_t, WS_UG)};
          pg8::gemm_phase<pg8::EpiZ, pg8::DenseSched, true>(ring, F.tid, DM / 2, DM / 2, S, E); }
        __syncthreads(); REFRESH();
        { pg8::DenseSched S{(const char*)WSP(unsigned char, WS_H0Q), (const char*)WSP(unsigned char, WS_WING), DM / 2, 32, 40, F.G, F.c, 0, 0, 0};
          pg8::EpiGate EG{WSP(bf16_t, WS_QB), WSP(bf16_t, WS_GA), WSP(bf16_t, WS_GS)};
          pg8::gemm_phase<pg8::EpiGate, pg8::DenseSched, true>(ring, F.tid, DM / 2, DM / 2, S, EG); }
        __syncthreads(); p1_convert(F, 1);
    }) SEAM(1);
    RUN(2, {
        const bool big = F.G >= 256; const int ntask = big ? 128 : 64;
        for (int t = F.c; t < ntask; t += F.G) { const int g = big ? t >> 1 : t, hf = big ? (t & 1) : 0; ssm_unit(F, g, hf ? 11 : 0, (big && !hf) ? 11 : SSM_NBLK); }
        const int a0 = big ? F.c - 128 : F.c, astep = big ? F.G - 128 : F.G;
        if (a0 >= 0) for (int u = a0; u < 256; u += astep) attn_unit(F, u >> 2, u & 3);
    }) SEAM(2);
    RUN(3, {
        pg8::DenseSched S{(const char*)WSP(unsigned char, WS_ATT), (const char*)WSP(unsigned char, WS_WAO), AW / 2, 32, 16, F.G, F.c, 0, 0, 0};
        pg8::EpiMix<false> E{WSP(bf16_t, WS_GA), WSP(bf16_t, WS_MIX), nullptr};
        pg8::gemm_phase<pg8::EpiMix<false>, pg8::DenseSched, true>(ring, F.tid, AW / 2, AW / 2, S, E);
    }) REFRESH();
    RUN(4, {
        if (F.G == 256 && F.c >= 128) { LAS unsigned* scr = (LAS unsigned*)(F.lds + F.wave * 8704); const int t0 = CVT_P1_TILES + (F.c - 128) * CVT_P4_PER; cvt_run(F, 8, 11, F.wave, 8, scr, t0, t0 + CVT_P4_PER); }
        pg8::DenseSched S{(const char*)WSP(bf16_t, WS_Y1), (const char*)WSP(bf16_t, WS_WGLU), SW, 32, 4, F.G, F.c, 0, 0, 0};
        pg8::EpiGlu E{WSP(bf16_t, WS_Y1), WSP(unsigned char, WS_Y2)};
        pg8::gemm_phase(ring, F.tid, SW, SW, S, E);
    }) SEAM(4);
    RUN(5, {
        pg8::DenseSched S{(const char*)WSP(unsigned char, WS_Y2), (const char*)WSP(unsigned char, WS_WSO), SW / 2, 32, 16, F.G, F.c, 0, 0, 0};
        pg8::EpiMix<true> E{WSP(bf16_t, WS_GS), WSP(bf16_t, WS_MIX), WSP(unsigned char, WS_H0Q)};
        pg8::gemm_phase<pg8::EpiMix<true>, pg8::DenseSched, true>(ring, F.tid, SW / 2, SW / 2, S, E);
    }) SEAM(5);
    RUN(6, {
        pg8::DenseSched S{(const char*)WSP(unsigned char, WS_H0Q), (const char*)WSP(unsigned char, WS_WOUT), DM / 2, 32, 16, F.G, F.c, 0, 0, 0};
        pg8::EpiWout E{WSP(bf16_t, WS_H1F)};
        pg8::gemm_phase<pg8::EpiWout, pg8::DenseSched, true>(ring, F.tid, DM / 2, DM / 2, S, E);
    }) SEAM(6);
    RUN(7, { ln1_pass(F);  }) SEAM(7);
    RUN(8, {
        if (F.G == 256 && F.c >= 160) { LAS unsigned* scr = (LAS unsigned*)(F.lds + F.wave * 8704); const int t0 = CVT_P1_TILES + CVT_P4_TILES + (F.c - 160) * CVT_P8_PER; cvt_run(F, 8, 11, F.wave, 8, scr, t0, t0 + CVT_P8_PER); }
        pg8::DenseSched S{(const char*)WSP(bf16_t, WS_H1B), (const char*)WSP(bf16_t, WS_WS13), DM, 32, 5, F.G, F.c, 0, 0, 0};
        pg8::EpiS13R E{WSP(bf16_t, WS_ACTS), WSP(float, WS_LOGITS)};
        pg8::gemm_phase(ring, F.tid, DM, DM, S, E);
    }) SEAM(8);
    RUN(9, { route_pass(F);  }) SEAM(9);
    RUN(10, { lists_pass(F);  }) SEAM(10);
    RUN(11, {
        const int ntiles = __builtin_amdgcn_readfirstlane((int)__hip_atomic_load(F.ctl + CW_NTILES, RLX_AGENT));
        { pg8::MoeSched S{(const char*)WSP(unsigned char, WS_H1LO), (const char*)WSP(unsigned char, WS_WE13), DM / 2, WSP(int, WS_ROWTOK), WSP(int, WS_TILEE), 4, (size_t)1024 * DM, ntiles * 4, F.G, F.c};
          pg8::EpiAct E{WSP(unsigned char, WS_ACT)};
          pg8::gemm_phase<pg8::EpiAct, pg8::MoeSched, true>(ring, F.tid, DM / 2, DM / 2, S, E); }
        { pg8::DenseSched S{(const char*)WSP(bf16_t, WS_ACTS), (const char*)WSP(bf16_t, WS_WS2), EDIM, 32, 16, F.G, F.c, 0, 0, 0};
          pg8::EpiS2 E{WSP(bf16_t, WS_H1B)};
          pg8::gemm_phase(ring, F.tid, EDIM, EDIM, S, E); }
    }) SEAM(11);
    RUN(12, {
        const int ntiles = __builtin_amdgcn_readfirstlane((int)__hip_atomic_load(F.ctl + CW_NTILES, RLX_AGENT)); const int nunits = ntiles * 16;
        LAS int* lut = (LAS int*)(F.lds + LUT_OFF);
#if HOT12
        __syncthreads();
        if (F.tid < 64) lut[F.tid] = (F.c & 3) | (((F.c >> 2) & 15) << 16);
        __syncthreads();
        { pg8::MoeTabSched S{(const char*)WSP(unsigned char, WS_ACT), (const char*)WSP(unsigned char, WS_WE2), EDIM / 2, lut, (size_t)DM * EDIM, nunits, F.G, F.c};
          pg8::EpiY E{WSP(unsigned char, WS_YB)};
          pg8::gemm_phase<pg8::EpiY, pg8::MoeTabSched, true>(ring, F.tid, EDIM / 2, EDIM / 2, S, E); }
        xcd_barrier(bar); REFRESH();
#endif
        __syncthreads();
        if (F.tid < 64) { const int L = F.tid * F.G + F.c; lut[F.tid] = L < nunits ? WSP(int, WS_UTAB)[pg8::xcd_remap(L, nunits)] : 0; }
        __syncthreads();
        pg8::MoeTabSched S{(const char*)WSP(unsigned char, WS_ACT), (const char*)WSP(unsigned char, WS_WE2), EDIM / 2, lut, (size_t)DM * EDIM, nunits, F.G, F.c};
        pg8::EpiY E{WSP(unsigned char, WS_YB)};
        pg8::gemm_phase<pg8::EpiY, pg8::MoeTabSched, true>(ring, F.tid, EDIM / 2, EDIM / 2, S, E);
    }) SEAM(12);
    RUN(13, { combine_pass(F);  })
#if DUMP
    if (lo <= 14 && 14 < hi) {
#if DUMP == 1
        dump_f32(F, WSP(float, WS_H1F));
#elif DUMP == 2
        dump_bf16(F, WSP(bf16_t, WS_MIX), DM, DM, 0, T_TOK);
#elif DUMP == 3
        dump_zero(F); __syncthreads();
        dump_bf16(F, WSP(bf16_t, WS_ATT), AW, AW, 0, T_TOK); dump_bf16(F, WSP(bf16_t, WS_Y1), SW, SW, AW, T_TOK);
#elif DUMP == 4
        dump_zero(F); __syncthreads();
        dump_bf16(F, WSP(bf16_t, WS_QB), AW, AW, 0, T_TOK); dump_bf16(F, WSP(bf16_t, WS_KB), KVW, KVW, AW, T_TOK); dump_bf16(F, WSP(bf16_t, WS_VB), KVW, KVW, AW + KVW, T_TOK);
        dump_bf16(F, WSP(bf16_t, WS_UG), 1026, 1026, AW + 2 * KVW, T_TOK);
#elif DUMP == 5
        dump_bf16(F, WSP(bf16_t, WS_GA), DM, DM, 0, T_TOK);
#elif DUMP == 7
        dump_bf16(F, WSP(bf16_t, WS_WIN) + (size_t)3584 * DM, DM, DM, 0, T_TOK);
#elif DUMP == 6
        dump_bf16(F, WSP(bf16_t, WS_H0B), DM, DM, 0, T_TOK);
#endif
    }
#endif
#undef IN
#undef SEAM
}

#ifndef PH_MASK
#define PH_MASK_HOST 0xffffffffu
#else
#define PH_MASK_HOST (PH_MASK)
#endif
extern "C" void kernel_launch(void* const* d_in, const int* in_sizes, int n_in, void* d_out, int out_size, void* d_ws, size_t ws_size, hipStream_t stream) {
    static int grid = 0;
    if (grid == 0) {
        if (n_in != 30 || in_sizes[0] != T_TOK * DM || out_size != T_TOK * DM || ws_size < WS_END) { fprintf(stderr, "kernel_launch: unexpected shapes / workspace (n_in %d, ws %zu, need %zu)\n", n_in, ws_size, (size_t)WS_END); grid = -1; return; }
        int dev = 0, cus = 0, per_cu = 0;
        if (hipGetDevice(&dev) != hipSuccess || hipDeviceGetAttribute(&cus, hipDeviceAttributeMultiprocessorCount, dev) != hipSuccess) { grid = -1; return; }
        if (hipFuncSetAttribute((const void*)mk_fwd, hipFuncAttributeMaxDynamicSharedMemorySize, LDS_BYTES) != hipSuccess) { fprintf(stderr, "kernel_launch: hipFuncSetAttribute failed\n"); grid = -1; return; }
        if (hipOccupancyMaxActiveBlocksPerMultiprocessor(&per_cu, (const void*)mk_fwd, 512, LDS_BYTES) != hipSuccess || per_cu < 1) fprintf(stderr, "kernel_launch: occupancy query reports %d\n", per_cu);
        (void)hipGetLastError();
        grid = cus;
    }
    if (grid < 0) return;
    if (hipMemsetAsync((char*)d_ws + WS_CTL, 0, CTL_ZERO_BYTES, stream) != hipSuccess) return;
    Args a{};
    for (int i = 0; i < 30; ++i) a.in[i] = (const float*)d_in[i];
    a.out = (float*)d_out; a.ws = (unsigned char*)d_ws; a.pad = 0;
#if MK_ONE_LAUNCH
    a.ph_lo = 0; a.ph_hi = NPHASE; a.one = 1;
    hipLaunchKernelGGL(mk_fwd, dim3(grid), dim3(512), LDS_BYTES, stream, a);
#else
    for (int p = 0; p < NPHASE + (DUMP ? 1 : 0); ++p) { a.ph_lo = p; a.ph_hi = p + 1; a.one = 0;
        if (!((PH_MASK_HOST >> p) & 1u)) continue;
        hipLaunchKernelGGL(mk_fwd, dim3(grid), dim3(512), LDS_BYTES, stream, a); }
#endif
}
```

```cpp
#include <hip/hip_runtime.h>
#include <cstdio>
#include <cstdint>

#define LAS __attribute__((address_space(3)))
#define GAS __attribute__((address_space(1)))
typedef unsigned short bf16_t;
typedef short bf16x8 __attribute__((ext_vector_type(8)));
typedef float f32x4 __attribute__((ext_vector_type(4)));
typedef float f32x2 __attribute__((ext_vector_type(2)));
typedef unsigned u32x4 __attribute__((ext_vector_type(4)));
typedef unsigned u32x2 __attribute__((ext_vector_type(2)));
typedef GAS unsigned gu32;

#ifndef MK_ONE_LAUNCH
#define MK_ONE_LAUNCH 1
#endif

constexpr int T_TOK = 8192, DM = 4096, NMETA = 16, ROWS_Z = 8448, KVROWS = 8208;
constexpr int NZ = 11776, AW = 2048, KVW = 256, SW = 1024;
constexpr int NE = 64, TOPK = 8, EDIM = 512;
constexpr float ALPHA = 1.189207115002721f;
constexpr float LN_EPS = 1e-5f;
constexpr float LOG2E = 1.4426950408889634f;
constexpr float QSCALE = 0.125f * LOG2E;
constexpr int MAXTILES = 320;
constexpr int NPHASE = 14;
constexpr int CVT_P8_PER = 120, CVT_P4_PER = 28, CVT_P8_TILES = 96 * CVT_P8_PER, CVT_P4_TILES = 128 * CVT_P4_PER, CVT_P1_TILES = 3 * NE * 64 * 8 - CVT_P8_TILES - CVT_P4_TILES;

constexpr size_t MiB = 1u << 20;
constexpr size_t WS_CTL = 0, CTL_ZERO_BYTES = 32768;
constexpr size_t WS_TOPI = 1 * MiB, WS_TOPW = WS_TOPI + 256 * 1024, WS_POS = WS_TOPW + 256 * 1024;
constexpr size_t WS_ROWTOK = 2 * MiB, WS_TILEE = 2 * MiB + 512 * 1024, WS_UTAB = WS_TILEE + 8192  , WS_STATS0 = 2 * MiB + 768 * 1024;
constexpr size_t WS_SSME = 3 * MiB, WS_LOGITS = 4 * MiB;
constexpr size_t WS_H1F = 8 * MiB, WS_H1B = 136 * MiB, WS_H1LO = 200 * MiB, WS_ACT = 264 * MiB, WS_ACTS = 344 * MiB;
constexpr size_t WS_WE2 = 352 * MiB, WS_WS2 = 608 * MiB, WS_WS13 = 612 * MiB;
constexpr size_t WS_WE13 = 640 * MiB, WS_WIN = 1152 * MiB, WS_WAO = 1244 * MiB, WS_WGLU = 1260 * MiB, WS_WSO = 1262 * MiB, WS_WOUT = 1270 * MiB;
constexpr size_t WS_H0B = 1302 * MiB, WS_QB = 1368 * MiB, WS_KB = 1400 * MiB, WS_VB = 1405 * MiB, WS_UG = 1410 * MiB;
constexpr size_t WS_GA = 1427 * MiB, WS_GS = 1491 * MiB, WS_ATT = 1555 * MiB, WS_Y1 = 1587 * MiB, WS_Y2 = 1603 * MiB, WS_MIX = 1619 * MiB;
constexpr size_t WS_END = 1683 * MiB;
constexpr size_t WS_WING = WS_WIN + 16 * MiB;
constexpr size_t WS_H0Q = WS_ACT + 40 * MiB;
constexpr size_t WS_YB = 640 * MiB;
static_assert(WS_YB + (size_t)MAXTILES * 256 * DM * 2 <= WS_H0B, "YB overlay");
constexpr int CW_TMO = 0, CW_CODE = 1, CW_NTILES = 64, CW_CNT = 128  , CW_BAR = 4096;

constexpr int RING_BYTES = 131072, LDS_BYTES = 147456, MISC_OFF = LDS_BYTES - 256, LUT_OFF = LDS_BYTES - 1024;

#define RLX_AGENT __ATOMIC_RELAXED, __HIP_MEMORY_SCOPE_AGENT
#define LDS_WAIT() asm volatile("s_waitcnt lgkmcnt(0)" ::: "memory")
#define VM_WAIT() asm volatile("s_waitcnt vmcnt(0)" ::: "memory")
__device__ __forceinline__ unsigned f2bf(float f) { unsigned u = __builtin_bit_cast(unsigned, f); return (u + 0x7fffu + ((u >> 16) & 1u)) >> 16; }
typedef __bf16 bf16x2_t __attribute__((ext_vector_type(2)));
__device__ __forceinline__ unsigned pk2(float lo, float hi) { f32x2 v = {lo, hi}; bf16x2_t b = __builtin_convertvector(v, bf16x2_t); return __builtin_bit_cast(unsigned, b); }
__device__ __forceinline__ float bf_lo(unsigned w) { return __builtin_bit_cast(float, w << 16); }
__device__ __forceinline__ float bf_hi(unsigned w) { return __builtin_bit_cast(float, w & 0xffff0000u); }
__device__ __forceinline__ float bf2f(bf16_t h) { return __builtin_bit_cast(float, ((unsigned)h) << 16); }
__device__ __forceinline__ float fast_sigmoid(float x) { return __builtin_amdgcn_rcpf(1.0f + __builtin_amdgcn_exp2f(-x * LOG2E)); }
__device__ __forceinline__ float wave_sum(float v) {
#pragma unroll
    for (int o = 1; o < 64; o <<= 1) v += __shfl_xor(v, o);
    return v;
}
__device__ __forceinline__ float wave_max(float v) {
#pragma unroll
    for (int o = 1; o < 64; o <<= 1) v = fmaxf(v, __shfl_xor(v, o));
    return v;
}

#define XB_TMO      128
#define XB_XCNT(j)  (256  + 64 * (j))
#define XB_XSUB(j)  (1280 + 64 * (j))
#define XB_XGEN(j)  (2304 + 64 * (j))
#define XB_TOP      3328
#define XB_TOPGEN   3392
#define XCD_BAR_WORDS 3456
#define XB_SPIN_CAP (1u << 18)
__device__ __forceinline__ unsigned xb_ld(unsigned* p)              { return __hip_atomic_load(p, __ATOMIC_RELAXED, __HIP_MEMORY_SCOPE_AGENT); }
__device__ __forceinline__ unsigned xb_add(unsigned* p, unsigned v) { return __hip_atomic_fetch_add(p, v, __ATOMIC_RELAXED, __HIP_MEMORY_SCOPE_AGENT); }
__device__ __forceinline__ unsigned xb_xcc_id() { return (unsigned)__builtin_amdgcn_s_getreg((3 << 11) | 20) & 0xFu; }
#define XB_SPIN(cond, bar) do { unsigned _sp = 0; while (cond) { __builtin_amdgcn_s_sleep(1); \
    if ((++_sp & 255u) == 0u) { if (xb_ld(&(bar)[XB_TMO])) break; if (_sp > XB_SPIN_CAP) { atomicAdd(&(bar)[XB_TMO], 1u); break; } } } } while (0)
struct XcdBarrier { unsigned* bar; unsigned x; volatile LAS unsigned* st; };
__device__ __forceinline__ XcdBarrier xcd_barrier_post(unsigned* bar, volatile LAS unsigned* st) {
    XcdBarrier b; b.bar = bar; b.x = xb_xcc_id(); b.st = st;
    if (threadIdx.x == 0) (void)xb_add(&bar[XB_XCNT(b.x)], 1u);
    return b;
}
__device__ __forceinline__ void xcd_barrier_complete(unsigned* bar, unsigned x, unsigned& nloc, unsigned& nx) {
    const unsigned G = gridDim.x * gridDim.y * gridDim.z;
    unsigned sum, cnt, mine, sp = 0u;
    for (;;) {
        sum = 0u; cnt = 0u; mine = 0u;
#pragma unroll
        for (unsigned j = 0; j < 16; ++j) { const unsigned c = xb_ld(&bar[XB_XCNT(j)]); sum += c; cnt += (c > 0u) ? 1u : 0u; mine = (j == x) ? c : mine; }
        if (sum == G) break;
        __builtin_amdgcn_s_sleep(1);
        if ((++sp & 255u) == 0u) { if (xb_ld(&bar[XB_TMO])) break; if (sp > XB_SPIN_CAP) { atomicAdd(&bar[XB_TMO], 1u); break; } }
    }
    nloc = mine > 0u ? mine : 1u; nx = cnt > 0u ? cnt : 1u;
}
__device__ __forceinline__ void xcd_barrier(const XcdBarrier& b) {
    asm volatile("s_waitcnt vmcnt(0)" ::: "memory");
    __syncthreads();
    if (threadIdx.x == 0) {
        unsigned* bar = b.bar;
        __builtin_amdgcn_s_waitcnt(0);
        unsigned nloc = b.st[0], nx = b.st[1];
        if (nloc == 0u) { xcd_barrier_complete(bar, b.x, nloc, nx); b.st[0] = nloc; b.st[1] = nx; }
        const unsigned old = xb_add(&bar[XB_XSUB(b.x)], 1u);
        const unsigned gen = old / nloc;
        if (old + 1u == (gen + 1u) * nloc) {
            __builtin_amdgcn_fence(__ATOMIC_RELEASE, "agent");
            asm volatile("s_waitcnt vmcnt(0)" ::: "memory");
            const unsigned og = xb_add(&bar[XB_TOP], 1u);
            const unsigned tg = og / nx;
            if (og + 1u == (tg + 1u) * nx) xb_add(&bar[XB_TOPGEN], 1u);
            else XB_SPIN(xb_ld(&bar[XB_TOPGEN]) == tg, bar);
            __builtin_amdgcn_fence(__ATOMIC_ACQUIRE, "agent");
            xb_add(&bar[XB_XGEN(b.x)], 1u);
            asm volatile("s_waitcnt vmcnt(0)" ::: "memory");
        } else {
            XB_SPIN(xb_ld(&bar[XB_XGEN(b.x)]) == gen, bar);
            __builtin_amdgcn_fence(__ATOMIC_ACQUIRE, "agent");
            asm volatile("s_waitcnt vmcnt(0)" ::: "memory");
        }
    }
    __syncthreads();
}

namespace pg8 {
constexpr int BM = 256, BK = 64, HALF = 128, HTB = HALF * BK * 2, NXCD = 8, WGM = 8;
__device__ __forceinline__ int lds_byte(int r, int c) { const int st = (r >> 4) * 2 + (c >> 5), rr = r & 15, cc = c & 31, ob = rr * 64 + cc * 2; return st * 1024 + (ob ^ (((ob >> 9) & 1) << 5)); }
__device__ __forceinline__ void stage_rc(int b, int& R, int& C) { const int st = b / 1024, sb = b % 1024, swz = sb ^ (((sb >> 9) & 1) << 5); R = (st >> 1) * 16 + swz / 64; C = (st & 1) * 32 + (swz % 64) / 2; }
__device__ __forceinline__ int perm32(int rho) { const int n = rho >> 4, i = rho & 15; return 8 * (i >> 2) + 4 * n + (i & 3); }
struct Unit { int pm, pn, e; };
__device__ __forceinline__ unsigned cvt_pk_bf16(float lo, float hi) { f32x2 v = {lo, hi}; bf16x2_t b = __builtin_convertvector(v, bf16x2_t); return __builtin_bit_cast(unsigned, b); }

__device__ __forceinline__ void tile_of(int L, int nM, int nN, int& pm, int& pn) {
    const int nwg = nM * nN; int wgid = L;
    { const int q = nwg / NXCD, r = nwg % NXCD, xcd = wgid % NXCD, off = wgid / NXCD; wgid = (xcd < r ? xcd * (q + 1) : r * (q + 1) + (xcd - r) * q) + off; }
    const int nig = WGM * nN, gid = wgid / nig, fm = gid * WGM, gsz = (nM - fm) < WGM ? (nM - fm) : WGM;
    pm = fm + ((wgid % nig) % gsz); pn = (wgid % nig) / gsz;
}
struct DenseSched {
    const char* A; const char* Bt; int K, nM, nN, G, c, xpm, xpn0, xn, i0 = 0, i1 = 0x7fffffff, l0 = 0;
    __device__ __forceinline__ bool next(int i, Unit& u) const {
        if (i + i0 >= i1) return false;
        const int L = (i + i0) * G + c + l0, nwg = nM * nN;
        if (L >= nwg) { const int x = L - nwg; if (x < xn) { u.pm = xpm; u.pn = xpn0 + x; u.e = 0; return true; } return false; }
        tile_of(L, nM, nN, u.pm, u.pn); u.e = 0; return true;
    }
    __device__ __forceinline__ int arow(const Unit& u, int r) const { return u.pm * BM + r; }
    __device__ __forceinline__ const char* abase(const Unit&) const { return A; }
    __device__ __forceinline__ const char* bbase(const Unit& u) const { return Bt + (size_t)u.pn * BM * K * 2; }
};
struct MoeSched {
    const char* A; const char* Bt; int K; const int* rowlist; const int* tile_e; int nN; size_t bstride; int nunits, G, c;
    __device__ __forceinline__ bool next(int i, Unit& u) const {
        const int L = i * G + c; if (L >= nunits) return false;
        const int q = nunits / NXCD, r = nunits % NXCD, xcd = L % NXCD, off = L / NXCD;
        const int wgid = (xcd < r ? xcd * (q + 1) : r * (q + 1) + (xcd - r) * q) + off;
        u.pm = wgid / nN; u.pn = wgid % nN;
        u.e = __builtin_amdgcn_readfirstlane((int)__hip_atomic_load((const unsigned*)tile_e + u.pm, RLX_AGENT));
        return true;
    }
    __device__ __forceinline__ int arow(const Unit& u, int r) const { return rowlist ? rowlist[u.pm * BM + r] : u.pm * BM + r; }
    __device__ __forceinline__ const char* abase(const Unit&) const { return A; }
    __device__ __forceinline__ const char* bbase(const Unit& u) const { return Bt + (size_t)u.e * bstride + (size_t)u.pn * BM * K * 2; }
};

struct MoeTabSched {
    const char* A; const char* Bt; int K; const LAS int* lut; size_t bstride; int nunits, G, c;
    __device__ __forceinline__ bool next(int i, Unit& u) const {
        if (i * G + c >= nunits) return false;
        const int v = __builtin_amdgcn_readfirstlane(lut[i]);
        u.pm = v & 0xffff; u.pn = (v >> 16) & 0xff; u.e = (v >> 24) & 0xff; return true;
    }
    __device__ __forceinline__ int arow(const Unit& u, int r) const { return u.pm * BM + r; }
    __device__ __forceinline__ const char* abase(const Unit&) const { return A; }
    __device__ __forceinline__ const char* bbase(const Unit& u) const { return Bt + (size_t)u.e * bstride + (size_t)u.pn * BM * K * 2; }
};
__device__ __forceinline__ int xcd_remap(int L, int nunits) { const int q = nunits / NXCD, r = nunits % NXCD, xcd = L % NXCD, off = L / NXCD; return (xcd < r ? xcd * (q + 1) : r * (q + 1) + (xcd - r) * q) + off; }

typedef int v8i __attribute__((ext_vector_type(8)));
typedef int v4i __attribute__((ext_vector_type(4)));
template <class E, class = void> struct epi_wide { static constexpr int v = 0; };
template <class E> struct epi_wide<E, decltype((void)E::WIDE)> { static constexpr int v = E::WIDE; };
template <bool FP8> struct Frag;
template <> struct Frag<false> { bf16x8 bh[2]; };
template <> struct Frag<true> { v8i q; };
template <class Epi, class Sched, bool FP8 = false>
__device__ __forceinline__ void gemm_phase(LAS unsigned char* lds, const int tid, const int K, const int lda, const Sched& S, const Epi& E) {
    const int wid = __builtin_amdgcn_readfirstlane(tid >> 6), lane = tid & 63, wr = wid >> 2, wc = wid & 3, fr = lane & 15, fq = lane >> 4;
    int nt = K / BK; asm volatile("" : "+s"(nt));
    int sc1 = 0x7f7f7f7f, scw = 0x79797979; asm volatile("" : "+v"(sc1), "+v"(scw));
    int Rr[2]; unsigned Cb[2], voffB[2];
    constexpr int WIDE = epi_wide<Epi>::v;
#pragma unroll
    for (int i = 0; i < 2; ++i) { int R, C; stage_rc(tid * 16 + i * 8192, R, C);
        const int Rb = WIDE == 1 ? (64 * (R >> 5) + 16 * ((R >> 2) & 3) + 4 * ((R >> 4) & 1) + (R & 3)) : WIDE == 2 ? (64 * (R >> 5) + 8 * ((R >> 2) & 3) + 4 * ((R >> 4) & 1) + (R & 3))
                     : Epi::PERM ? ((R & ~31) + perm32(R & 31)) : R;
        Rr[i] = R; Cb[i] = (unsigned)C * 2u; voffB[i] = (unsigned)(Rb * K + C) * 2u; }
    const unsigned lda2 = (unsigned)lda * 2u;
    const size_t kstep = (size_t)(BK * 2);
    const size_t hstepB = (size_t)(WIDE == 1 ? 8 : WIDE == 2 ? 32 : HALF) * K * 2;
    const unsigned ldsw = (unsigned)wid * 1024u;
    const int aoff = lds_byte(wr * 64 + fr, fq * 8), boff = lds_byte(wc * 32 + fr, fq * 8);
    const LAS unsigned char* pA = lds + aoff; const LAS unsigned char* pB = lds + 65536 + boff;
#define PG8_SA(b, h) (((b) * 2 + (h)) * HTB)
#define PG8_SB(b, h) ((4 + (b) * 2 + (h)) * HTB)
#define PG8_STAGE(bufoff, gbase, voff) do { _Pragma("unroll") for (int _i = 0; _i < 2; ++_i) \
        __builtin_amdgcn_global_load_lds((const unsigned*)((const char*)(gbase) + (voff)[_i]), (LAS unsigned*)(lds + (bufoff) + ldsw + _i * 8192), 16, 0, 0); } while (0)
#define PG8_LD32(p, off) __builtin_shufflevector(*(const LAS v4i*)((p) + (off)), *(const LAS v4i*)((p) + (off) + 1024), 0, 1, 2, 3, 4, 5, 6, 7)
#define PG8_LDA(dst, b, h) do { _Pragma("unroll") for (int m = 0; m < 4; ++m) { if constexpr (FP8) dst[m].q = PG8_LD32(pA, PG8_SA(b, h) + m * 2048); \
        else { dst[m].bh[0] = *(const LAS bf16x8*)(pA + PG8_SA(b, h) + m * 2048); dst[m].bh[1] = *(const LAS bf16x8*)(pA + PG8_SA(b, h) + m * 2048 + 1024); } } } while (0)
#define PG8_LDB(dst, b, h) do { _Pragma("unroll") for (int n = 0; n < 2; ++n) { if constexpr (FP8) dst[n].q = PG8_LD32(pB, PG8_SB(b, h) - 65536 + n * 2048); \
        else { dst[n].bh[0] = *(const LAS bf16x8*)(pB + PG8_SB(b, h) - 65536 + n * 2048); dst[n].bh[1] = *(const LAS bf16x8*)(pB + PG8_SB(b, h) - 65536 + n * 2048 + 1024); } } } while (0)
#define PG8_MMA(ai, bj, At, Bt) do { __builtin_amdgcn_s_setprio(1); _Pragma("unroll") for (int m = 0; m < 4; ++m) _Pragma("unroll") for (int n = 0; n < 2; ++n) { \
        if constexpr (FP8) asm volatile("v_mfma_scale_f32_16x16x128_f8f6f4 %0, %1, %2, %0, %3, %4 op_sel_hi:[0,0,0]" : "+v"(acc[ai][bj][m][n]) : "v"(Bt[n].q), "v"(At[m].q), "v"(scw), "v"(sc1)); \
        else { acc[ai][bj][m][n] = __builtin_amdgcn_mfma_f32_16x16x32_bf16(Bt[n].bh[0], At[m].bh[0], acc[ai][bj][m][n], 0, 0, 0); acc[ai][bj][m][n] = __builtin_amdgcn_mfma_f32_16x16x32_bf16(Bt[n].bh[1], At[m].bh[1], acc[ai][bj][m][n], 0, 0, 0); } } \
        __builtin_amdgcn_s_setprio(0); } while (0)
#define PG8_MMAZ(ai, bj, At, Bt) do { __builtin_amdgcn_s_setprio(1); _Pragma("unroll") for (int m = 0; m < 4; ++m) _Pragma("unroll") for (int n = 0; n < 2; ++n) \
        asm volatile("v_mfma_scale_f32_16x16x128_f8f6f4 %0, %1, %2, 0, %3, %4 op_sel_hi:[0,0,0]" : "+v"(acc[ai][bj][m][n]) : "v"(Bt[n].q), "v"(At[m].q), "v"(scw), "v"(sc1)); \
        __builtin_amdgcn_s_setprio(0); } while (0)
#define PG8_WAIT_V(n) asm volatile("s_waitcnt vmcnt(" #n ")" ::: "memory")
#define PG8_WAIT_V8E(c) do { if (Epi::NST > 0 && (c)) asm volatile("s_waitcnt vmcnt(%0)" :: "n"(8 + Epi::NST) : "memory"); else PG8_WAIT_V(8); } while (0)
#define PG8_WAIT_L(n) asm volatile("s_waitcnt lgkmcnt(" #n ")" ::: "memory")
#define PG8_BAR __builtin_amdgcn_s_barrier()
#define PG8_SCHED __builtin_amdgcn_sched_barrier(0)
    Unit cur, nxt; int ui = 0;
    if (!S.next(0, cur)) return;
    f32x4 acc[2][2][4][2];
#pragma unroll
    for (int a = 0; a < 2; ++a)
#pragma unroll
        for (int b = 0; b < 2; ++b)
#pragma unroll
            for (int m = 0; m < 4; ++m)
#pragma unroll
                for (int n = 0; n < 2; ++n) acc[a][b][m][n] = (f32x4){0.f, 0.f, 0.f, 0.f};
    Frag<FP8> At[4], B0[2], B1[2];
    const char* cA = S.abase(cur); const char* cB = S.bbase(cur);
    unsigned ofA0[2], ofA1[2];
#pragma unroll
    for (int i = 0; i < 2; ++i) { ofA0[i] = (unsigned)S.arow(cur, Rr[i]) * lda2 + Cb[i]; ofA1[i] = (unsigned)S.arow(cur, HALF + Rr[i]) * lda2 + Cb[i]; }
    PG8_STAGE(PG8_SB(0, 0), cB, voffB); PG8_STAGE(PG8_SB(0, 1), cB + hstepB, voffB); PG8_STAGE(PG8_SA(0, 0), cA, ofA0); PG8_STAGE(PG8_SA(0, 1), cA, ofA1);
    if (wr == 1) PG8_BAR;
    PG8_WAIT_V(2); PG8_BAR;
    PG8_STAGE(PG8_SB(1, 0), cB + kstep, voffB); PG8_STAGE(PG8_SA(1, 0), cA + kstep, ofA0); PG8_STAGE(PG8_SB(1, 1), cB + hstepB + kstep, voffB);
    PG8_WAIT_V(6); PG8_BAR;
    for (;;) {
        const bool has_next = S.next(ui + 1, nxt);
        const char* nA = has_next ? S.abase(nxt) : cA; const char* nB = has_next ? S.bbase(nxt) : cB;
        unsigned ofN0[2], ofN1[2];
#pragma unroll
        for (int i = 0; i < 2; ++i) { ofN0[i] = has_next ? (unsigned)S.arow(nxt, Rr[i]) * lda2 + Cb[i] : ofA0[i]; ofN1[i] = has_next ? (unsigned)S.arow(nxt, HALF + Rr[i]) * lda2 + Cb[i] : ofA1[i]; }
        for (int t = 0; t < nt; t += 2) {
            const bool last = (t == nt - 2);
            const char* a1 = cA + (size_t)(t + 1) * kstep;
            const char* a2 = last ? nA : cA + (size_t)(t + 2) * kstep; const char* b2 = last ? nB : cB + (size_t)(t + 2) * kstep;
            const char* a3 = a2 + kstep; const char* b3 = b2 + kstep;
            unsigned o20[2], o21[2];
#pragma unroll
            for (int i = 0; i < 2; ++i) { o20[i] = last ? ofN0[i] : ofA0[i]; o21[i] = last ? ofN1[i] : ofA1[i]; }
            const bool after_epi = (t == 0) && (ui > 0);
            PG8_LDB(B0, 0, 0); PG8_LDB(B1, 0, 1); PG8_SCHED; PG8_LDA(At, 0, 0); PG8_STAGE(PG8_SA(1, 1), a1, ofA1);
            PG8_WAIT_V8E(after_epi); PG8_WAIT_L(0); PG8_BAR;
            if constexpr (FP8) { if (t == 0) { PG8_MMAZ(0, 0, At, B0); PG8_MMAZ(0, 1, At, B1); } else { PG8_MMA(0, 0, At, B0); PG8_MMA(0, 1, At, B1); } } else { PG8_MMA(0, 0, At, B0); PG8_MMA(0, 1, At, B1); }
            PG8_BAR; PG8_SCHED;
            PG8_LDA(At, 0, 1); PG8_STAGE(PG8_SB(0, 0), b2, voffB); PG8_STAGE(PG8_SB(0, 1), b2 + hstepB, voffB); PG8_STAGE(PG8_SA(0, 0), a2, o20);
            PG8_WAIT_V8E(after_epi); PG8_WAIT_L(0); PG8_BAR;
            if constexpr (FP8) { if (t == 0) { PG8_MMAZ(1, 0, At, B0); PG8_MMAZ(1, 1, At, B1); } else { PG8_MMA(1, 0, At, B0); PG8_MMA(1, 1, At, B1); } } else { PG8_MMA(1, 0, At, B0); PG8_MMA(1, 1, At, B1); }
            PG8_BAR; PG8_SCHED;
            PG8_LDB(B0, 1, 0); PG8_LDB(B1, 1, 1); PG8_SCHED; PG8_LDA(At, 1, 0); PG8_STAGE(PG8_SA(0, 1), a2, o21);
            PG8_WAIT_V(8); PG8_WAIT_L(0); PG8_BAR; PG8_MMA(0, 0, At, B0); PG8_MMA(0, 1, At, B1); PG8_BAR; PG8_SCHED;
            PG8_LDA(At, 1, 1); PG8_STAGE(PG8_SB(1, 0), b3, voffB); PG8_STAGE(PG8_SB(1, 1), b3 + hstepB, voffB); PG8_STAGE(PG8_SA(1, 0), a3, o20);
            PG8_WAIT_V(8); PG8_WAIT_L(0); PG8_BAR; PG8_MMA(1, 0, At, B0); PG8_MMA(1, 1, At, B1); PG8_BAR; PG8_SCHED;
        }
        if (wr == 0) PG8_BAR;
        if constexpr (FP8) asm volatile("s_nop 15\n\ts_nop 15" ::: "memory");
        E(acc, cur, wr, wc, fr, fq);
        if (!has_next) break;
        if constexpr (!FP8) {
#pragma unroll
        for (int a = 0; a < 2; ++a)
#pragma unroll
            for (int b = 0; b < 2; ++b)
#pragma unroll
                for (int m = 0; m < 4; ++m)
#pragma unroll
                    for (int n = 0; n < 2; ++n) acc[a][b][m][n] = (f32x4){0.f, 0.f, 0.f, 0.f};
        }
        cur = nxt; cA = nA; cB = nB; ++ui;
#pragma unroll
        for (int i = 0; i < 2; ++i) { ofA0[i] = ofN0[i]; ofA1[i] = ofN1[i]; }
        if (wr == 1) PG8_BAR;
    }
    PG8_WAIT_V(0);
    PG8_BAR;
#undef PG8_SA
#undef PG8_SB
#undef PG8_STAGE
#undef PG8_LDA
#undef PG8_LD32
#undef PG8_LDB
#undef PG8_MMA
#undef PG8_MMAZ
#undef PG8_WAIT_V
#undef PG8_WAIT_V8E
#undef PG8_WAIT_L
#undef PG8_BAR
#undef PG8_SCHED
}

#define EPI_LOOP_ROWS for (int ai = 0; ai < 2; ++ai) _Pragma("unroll") for (int m = 0; m < 4; ++m)
__device__ __forceinline__ u32x4 pack8(const f32x4& v0, const f32x4& v1) { u32x4 w; w.x = cvt_pk_bf16(v0[0], v0[1]); w.y = cvt_pk_bf16(v0[2], v0[3]); w.z = cvt_pk_bf16(v1[0], v1[1]); w.w = cvt_pk_bf16(v1[2], v1[3]); return w; }
__device__ __forceinline__ void unpack8(const u32x4& w, f32x4& v0, f32x4& v1) { v0 = (f32x4){bf_lo(w.x), bf_hi(w.x), bf_lo(w.y), bf_hi(w.y)}; v1 = (f32x4){bf_lo(w.z), bf_hi(w.z), bf_lo(w.w), bf_hi(w.w)}; }
__device__ __forceinline__ unsigned pack4_fp8(const f32x4& v) { int w = __builtin_amdgcn_cvt_pk_fp8_f32(v[0], v[1], 0, false); w = __builtin_amdgcn_cvt_pk_fp8_f32(v[2], v[3], w, true); return (unsigned)w; }
__device__ __forceinline__ f32x4 sig4(const f32x4& v) { return (f32x4){fast_sigmoid(v[0]), fast_sigmoid(v[1]), fast_sigmoid(v[2]), fast_sigmoid(v[3])}; }

struct EpiZ {
    static constexpr bool PERM = true; static constexpr int NST = 0;
    bf16_t *Kb, *Vb, *Ug;
    __device__ __forceinline__ void operator()(const f32x4 (&acc)[2][2][4][2], const Unit& u, int wr, int wc, int fr, int fq) const {
        const int pn = u.pn;
#pragma unroll
        EPI_LOOP_ROWS {
            const int r = u.pm * BM + ai * HALF + wr * 64 + m * 16 + fr;
            if (r < KVROWS) { const int sp = r < T_TOK ? r + NMETA : r - T_TOK;
#pragma unroll
              for (int bj = 0; bj < 2; ++bj) {
                const int cl = bj * HALF + wc * 32 + 8 * fq;
                const f32x4 v0 = acc[ai][bj][m][0], v1 = acc[ai][bj][m][1];
                if (pn == 0) *(u32x4*)(Kb + (size_t)sp * KVW + cl) = pack8(v0, v1);
                else if (pn == 1) { bf16_t* vp = Vb + (size_t)cl * KVROWS + sp;
#pragma unroll
                    for (int j = 0; j < 4; ++j) { vp[(size_t)j * KVROWS] = (bf16_t)f2bf(v0[j]); vp[(size_t)(4 + j) * KVROWS] = (bf16_t)f2bf(v1[j]); } }
                else { const int col = (pn - 2) * BM + cl;
                    *(u32x4*)(Ug + ((size_t)(col >> 4) * KVROWS + sp) * 16 + (col & 15)) = pack8(v0, v1); }
              } }
        }
    }
};
struct EpiGate {
    static constexpr bool PERM = true; static constexpr int NST = 0; static constexpr int WIDE = 2;
    bf16_t *Q, *Ga, *Gs;
    __device__ __forceinline__ void operator()(const f32x4 (&acc)[2][2][4][2], const Unit& u, int wr, int wc, int fr, int fq) const {
        const int row0 = u.pm * BM + wr * 64 + fr, cl = wc * 64 + 8 * fq;
        if (u.pn < 8) {
            bf16_t* base = Q + (size_t)row0 * AW + u.pn * BM + cl;
#pragma unroll
            EPI_LOOP_ROWS {
#pragma unroll
                for (int bj = 0; bj < 2; ++bj) *(u32x4*)(base + (size_t)(ai * HALF + m * 16) * AW + bj * 32) = pack8(acc[ai][bj][m][0] * QSCALE, acc[ai][bj][m][1] * QSCALE); }
        } else {
            bf16_t* base = (u.pn < 24 ? Ga : Gs) + (size_t)row0 * DM + ((u.pn - 8) & 15) * BM + cl;
#pragma unroll
            EPI_LOOP_ROWS {
#pragma unroll
                for (int bj = 0; bj < 2; ++bj) __builtin_nontemporal_store(pack8(sig4(acc[ai][bj][m][0]), sig4(acc[ai][bj][m][1])), (u32x4*)(base + (size_t)(ai * HALF + m * 16) * DM + bj * 32)); }
        }
    }
};
struct EpiGlu {
    static constexpr bool PERM = true; static constexpr int NST = 0;
    const bf16_t* Y1; unsigned char* Y2;
    __device__ __forceinline__ void operator()(const f32x4 (&acc)[2][2][4][2], const Unit& u, int wr, int wc, int fr, int fq) const {
#pragma unroll
        EPI_LOOP_ROWS { const size_t r = (size_t)u.pm * BM + ai * HALF + wr * 64 + m * 16 + fr;
#pragma unroll
            for (int bj = 0; bj < 2; ++bj) { const size_t off = r * SW + u.pn * BM + bj * HALF + wc * 32 + 8 * fq;
                f32x4 y0, y1; unpack8(*(const u32x4*)(Y1 + off), y0, y1);
                *(u32x2*)(Y2 + off) = (u32x2){pack4_fp8(y0 * sig4(acc[ai][bj][m][0])), pack4_fp8(y1 * sig4(acc[ai][bj][m][1]))}; } }
    }
};
template <bool ADD> struct EpiMix {
    static constexpr bool PERM = true; static constexpr int NST = 0; static constexpr int WIDE = ADD ? 1 : 2;
    const bf16_t* Gt; bf16_t* Mix; unsigned char* MixQ;
    __device__ __forceinline__ void operator()(const f32x4 (&acc)[2][2][4][2], const Unit& u, int wr, int wc, int fr, int fq) const {
#pragma unroll
        EPI_LOOP_ROWS { const size_t r = (size_t)u.pm * BM + ai * HALF + wr * 64 + m * 16 + fr;
            const size_t off0 = r * DM + u.pn * BM + wc * 64 + (ADD ? 16 : 8) * fq; unsigned q[4];
#pragma unroll
            for (int bj = 0; bj < 2; ++bj) { const size_t off = off0 + bj * (ADD ? 8 : 32);
                f32x4 g0, g1; unpack8(*(const u32x4*)(Gt + off), g0, g1);
                f32x4 o0 = g0 * acc[ai][bj][m][0], o1 = g1 * acc[ai][bj][m][1];
                if (ADD) { f32x4 p0, p1; unpack8(*(const u32x4*)(Mix + off), p0, p1); o0 += p0; o1 += p1; q[2 * bj] = pack4_fp8(o0); q[2 * bj + 1] = pack4_fp8(o1); }
                else *(u32x4*)(Mix + off) = pack8(o0, o1); }
            if (ADD) *(u32x4*)(MixQ + off0) = (u32x4){q[0], q[1], q[2], q[3]};
        }
    }
};
struct EpiWout {
    static constexpr bool PERM = true; static constexpr int NST = 0; static constexpr int WIDE = 2;
    bf16_t* Out;
    __device__ __forceinline__ void operator()(const f32x4 (&acc)[2][2][4][2], const Unit& u, int wr, int wc, int fr, int fq) const {
        const int col0 = u.pn * BM + wc * 64 + 8 * fq;
#pragma unroll
        EPI_LOOP_ROWS { const size_t r = (size_t)u.pm * BM + ai * HALF + wr * 64 + m * 16 + fr; const size_t off = r * DM + col0;
#pragma unroll
            for (int bj = 0; bj < 2; ++bj) *(u32x4*)(Out + off + bj * 32) = pack8(acc[ai][bj][m][0], acc[ai][bj][m][1]); }
    }
};
struct EpiS13R {
    static constexpr bool PERM = true; static constexpr int NST = 0;
    bf16_t* ActS; float* Logits;
    __device__ __forceinline__ void operator()(const f32x4 (&acc)[2][2][4][2], const Unit& u, int wr, int wc, int fr, int fq) const {
#pragma unroll
        EPI_LOOP_ROWS { const size_t r = (size_t)u.pm * BM + ai * HALF + wr * 64 + m * 16 + fr; const int cl = wc * 32 + 8 * fq;
            if (u.pn < 4) { const f32x4 a0 = acc[ai][0][m][0], a1 = acc[ai][0][m][1];
                *(u32x4*)(ActS + r * EDIM + u.pn * HALF + cl) = pack8(a0 * sig4(a0) * acc[ai][1][m][0], a1 * sig4(a1) * acc[ai][1][m][1]); }
            else { *(f32x4*)(Logits + r * 128 + cl) = acc[ai][0][m][0]; *(f32x4*)(Logits + r * 128 + cl + 4) = acc[ai][0][m][1]; } }
    }
};
constexpr float WQ_SCALE = 64.f, WQ_INV = 1.f / 64.f;
struct EpiAct {
    static constexpr bool PERM = true; static constexpr int NST = 0;
    unsigned char* Act;
    __device__ __forceinline__ void operator()(const f32x4 (&acc)[2][2][4][2], const Unit& u, int wr, int wc, int fr, int fq) const {
#pragma unroll
        EPI_LOOP_ROWS { const size_t r = (size_t)u.pm * BM + ai * HALF + wr * 64 + m * 16 + fr; const int cl = wc * 32 + 8 * fq;
            const f32x4 a0 = acc[ai][0][m][0], a1 = acc[ai][0][m][1];
            *(u32x2*)(Act + r * EDIM + u.pn * HALF + cl) = (u32x2){pack4_fp8(a0 * sig4(a0) * acc[ai][1][m][0]), pack4_fp8(a1 * sig4(a1) * acc[ai][1][m][1])}; }
    }
};
struct EpiS2 {
    static constexpr bool PERM = true; static constexpr int NST = 0; static constexpr int WIDE = 2;
    bf16_t* H;
    __device__ __forceinline__ void operator()(const f32x4 (&acc)[2][2][4][2], const Unit& u, int wr, int wc, int fr, int fq) const {
#pragma unroll
        EPI_LOOP_ROWS { const size_t r = (size_t)u.pm * BM + ai * HALF + wr * 64 + m * 16 + fr;
#pragma unroll
            for (int bj = 0; bj < 2; ++bj) { bf16_t* p = H + r * DM + u.pn * BM + bj * 32 + wc * 64 + 8 * fq; f32x4 h0, h1; unpack8(*(const u32x4*)p, h0, h1);
                *(u32x4*)p = pack8(h0 * ALPHA + acc[ai][bj][m][0], h1 * ALPHA + acc[ai][bj][m][1]); } }
    }
};
struct EpiY {
    static constexpr bool PERM = true; static constexpr int NST = 8; static constexpr int WIDE = 1;
    unsigned char* Y;
    __device__ __forceinline__ void operator()(const f32x4 (&acc)[2][2][4][2], const Unit& u, int wr, int wc, int fr, int fq) const {
#pragma unroll
        EPI_LOOP_ROWS { const size_t r = (size_t)u.pm * BM + ai * HALF + wr * 64 + m * 16 + fr;
            *(u32x4*)(Y + r * DM + u.pn * BM + wc * 64 + 16 * fq) = (u32x4){pack4_fp8(acc[ai][0][m][0]), pack4_fp8(acc[ai][0][m][1]), pack4_fp8(acc[ai][1][m][0]), pack4_fp8(acc[ai][1][m][1])}; }
    }
};
}

struct Frame {
    LAS unsigned char* lds; gu32* ctl; unsigned char* ws;
    int tid, lane, wave, G, c;
    const float* const* in; float* out;
};
#define WSP(T, off) ((T*)(F.ws + (off)))

struct CvtRegs { f32x4 v[16]; };
__device__ __forceinline__ void cvt_load(CvtRegs& R, const float* __restrict__ W, size_t ldw, int k0, int n0, int lane) {
    const float* src = W + (size_t)(k0 + 2 * (lane >> 4)) * ldw + n0 + 4 * (lane & 15);
#pragma unroll
    for (int ip = 0; ip < 8; ++ip) { R.v[2 * ip] = __builtin_nontemporal_load((const f32x4*)(src + (size_t)(8 * ip) * ldw)); R.v[2 * ip + 1] = __builtin_nontemporal_load((const f32x4*)(src + (size_t)(8 * ip + 1) * ldw)); }
}
template <bool LO>
__device__ __forceinline__ void cvt_store(const CvtRegs& R, int k0, bf16_t* Wt, size_t dpitch, size_t drow0, LAS unsigned* scr, int lane) {
    const int kq = lane >> 4, n4 = 4 * (lane & 15);
#pragma unroll
    for (int ip = 0; ip < 8; ++ip) { f32x4 a = R.v[2 * ip], b = R.v[2 * ip + 1];
        if (LO) {
#pragma unroll
            for (int j = 0; j < 4; ++j) { a[j] -= __builtin_bit_cast(float, f2bf(a[j]) << 16); b[j] -= __builtin_bit_cast(float, f2bf(b[j]) << 16); } }
#pragma unroll
        for (int j = 0; j < 4; ++j) scr[(n4 + j) * 33 + 4 * ip + kq] = pk2(a[j], b[j]); }
    LDS_WAIT();
    const int c = lane & 7;
#pragma unroll
    for (int j = 0; j < 8; ++j) { const int n = (lane >> 3) + 8 * j; const LAS unsigned* s = scr + n * 33 + 4 * c;
        u32x4 o; o.x = s[0]; o.y = s[1]; o.z = s[2]; o.w = s[3];
        __builtin_nontemporal_store(o, (u32x4*)(Wt + (drow0 + n) * dpitch + k0 + 8 * c)); }
    LDS_WAIT();
}
template <bool LO>
__device__ __forceinline__ void cvt_tile(const float* __restrict__ W, size_t ldw, int k0, int n0, bf16_t* Wt, size_t dpitch, size_t drow0, LAS unsigned* scr, int lane) {
    CvtRegs R; cvt_load(R, W, ldw, k0, n0, lane); cvt_store<LO>(R, k0, Wt, dpitch, drow0, scr, lane);
}
__device__ __forceinline__ void cvt_load8(CvtRegs& R, const float* __restrict__ W, size_t ldw, int k0, int n0, int lane) {
    const float* src = W + (size_t)(k0 + 4 * (lane >> 3)) * ldw + n0 + 4 * (lane & 7);
#pragma unroll
    for (int ip = 0; ip < 4; ++ip)
#pragma unroll
        for (int b = 0; b < 4; ++b) R.v[4 * ip + b] = __builtin_nontemporal_load((const f32x4*)(src + (size_t)(32 * ip + b) * ldw));
}
__device__ __forceinline__ void cvt_store8(const CvtRegs& R, int k0, unsigned char* Wt, size_t dpitch, size_t drow0, float scale, LAS unsigned* scr, int lane, bool nt = true) {
    const int kr = lane >> 3, n4 = 4 * (lane & 7);
#pragma unroll
    for (int ip = 0; ip < 4; ++ip)
#pragma unroll
        for (int j = 0; j < 4; ++j) { int w = __builtin_amdgcn_cvt_pk_fp8_f32(R.v[4 * ip][j] * scale, R.v[4 * ip + 1][j] * scale, 0, false); w = __builtin_amdgcn_cvt_pk_fp8_f32(R.v[4 * ip + 2][j] * scale, R.v[4 * ip + 3][j] * scale, w, true);
            scr[(n4 + j) * 33 + 8 * ip + kr] = (unsigned)w; }
    LDS_WAIT();
    const int c = lane & 7;
#pragma unroll
    for (int j = 0; j < 4; ++j) { const int n = (lane >> 3) + 8 * j; const LAS unsigned* sp = scr + n * 33 + 4 * c;
        u32x4 o; o.x = sp[0]; o.y = sp[1]; o.z = sp[2]; o.w = sp[3];
        if (nt) __builtin_nontemporal_store(o, (u32x4*)(Wt + (drow0 + n) * dpitch + k0 + 16 * c)); else *(u32x4*)(Wt + (drow0 + n) * dpitch + k0 + 16 * c) = o; }
    LDS_WAIT();
}
struct CvtJob { const float* W; void* Wt; int K, N, mode, nmat; size_t wstride, dstride; int fp8; int ldw; };
__device__ __forceinline__ int cvt_job_tiles(const CvtJob& j) { return j.nmat * (j.K / 64) * (j.N / 64); }
struct CvtTile { const float* W; void* Wt; size_t ldw, dpitch, drow0; int k0, n0; };
__device__ __forceinline__ CvtTile cvt_job_tile(const CvtJob& j, int it) {
    const int tn = j.fp8 ? 32 : 64, tk = j.fp8 ? 128 : 64;
    const int nnb = j.N / tn, per = (j.K / tk) * nnb, mat = it / per, r = it % per, kb = r / nnb, nb = r % nnb, n0 = nb * tn;
    const size_t drow0 = j.mode == 0 ? (size_t)n0 : (size_t)(n0 >> 7) * 256 + (j.mode - 1) * 128 + (n0 & 127);
    void* wt = j.fp8 ? (void*)((unsigned char*)j.Wt + (size_t)mat * j.dstride) : (void*)((bf16_t*)j.Wt + (size_t)mat * j.dstride);
    return CvtTile{j.W + (size_t)mat * j.wstride, wt, (size_t)(j.ldw ? j.ldw : j.N), (size_t)j.K, drow0, kb * tk, n0};
}
__device__ __forceinline__ void ln_row(const float* xrow, const LAS f32x4* g, const LAS f32x4* b, int lane, f32x4 (&v)[16], float& mean, float& rstd) {
    const f32x4* xr = (const f32x4*)xrow + lane; float s = 0.f;
#pragma unroll
    for (int j = 0; j < 16; ++j) { v[j] = __builtin_nontemporal_load(xr + 64 * j); s += (v[j][0] + v[j][1]) + (v[j][2] + v[j][3]); }
    mean = wave_sum(s) * (1.f / DM); float s2 = 0.f;
#pragma unroll
    for (int j = 0; j < 16; ++j) { v[j] = v[j] - mean; s2 += (v[j][0] * v[j][0] + v[j][1] * v[j][1]) + (v[j][2] * v[j][2] + v[j][3] * v[j][3]); }
    rstd = 1.f / sqrtf(wave_sum(s2) * (1.f / DM) + LN_EPS);
    asm volatile("" ::: "memory");
#pragma unroll
    for (int j = 0; j < 16; ++j) { const f32x4 gg = g[lane + 64 * j], bb = b[lane + 64 * j]; v[j] = v[j] * rstd * gg + bb; }
}

__device__ __forceinline__ void cvt_run(const Frame& F, int j0, int j1, int gw, int NGW, LAS unsigned* scr, int tlo = 0, int thi = 0x7fffffff) {
    int done = 0;
#pragma unroll 1
    for (int jn = j0; jn < j1; ++jn) {
        CvtJob j;
        switch (jn) {
            case 0: j = CvtJob{F.in[4] + 2048, WSP(unsigned char, WS_WING) + (size_t)10240 * DM, DM, 1536, 0, 1, 0, 0, 1, NZ}; break;
            case 11: j = CvtJob{F.in[4] + 3584, WSP(unsigned char, WS_WING) + (size_t)2048 * DM, DM, 2 * DM, 0, 1, 0, 0, 1, NZ}; break;
            case 12: j = CvtJob{F.in[4], WSP(unsigned char, WS_WING), DM, 2048, 0, 1, 0, 0, 1, NZ}; break;
            case 1: j = CvtJob{F.in[6], WSP(unsigned char, WS_WAO), AW, DM, 0, 1, 0, 0, 1, 0}; break;
            case 2: j = CvtJob{F.in[15], WSP(bf16_t, WS_WGLU), SW, SW, 0, 1, 0, 0, 0, 0}; break;
            case 3: j = CvtJob{F.in[16], WSP(unsigned char, WS_WSO), SW, DM, 0, 1, 0, 0, 1, 0}; break;
            case 4: j = CvtJob{F.in[17], WSP(unsigned char, WS_WOUT), DM, DM, 0, 1, 0, 0, 1, 0}; break;
            case 5: j = CvtJob{F.in[25], WSP(bf16_t, WS_WS13), DM, EDIM, 1, 1, 0, 0, 0, 0}; break;
            case 6: j = CvtJob{F.in[26], WSP(bf16_t, WS_WS13), DM, EDIM, 2, 1, 0, 0, 0, 0}; break;
            case 7: j = CvtJob{F.in[27], WSP(bf16_t, WS_WS2), EDIM, DM, 0, 1, 0, 0, 0, 0}; break;
            case 8: j = CvtJob{F.in[22], WSP(unsigned char, WS_WE13), DM, EDIM, 1, NE, (size_t)DM * EDIM, (size_t)1024 * DM, 1, 0}; break;
            case 9: j = CvtJob{F.in[23], WSP(unsigned char, WS_WE13), DM, EDIM, 2, NE, (size_t)DM * EDIM, (size_t)1024 * DM, 1, 0}; break;
            default: j = CvtJob{F.in[24], WSP(unsigned char, WS_WE2), EDIM, DM, 0, NE, (size_t)EDIM * DM, (size_t)DM * EDIM, 1, 0}; break;
        }
        const int nt0 = cvt_job_tiles(j);
        const int nt = (thi - done) < nt0 ? (thi - done) : nt0;
        int it = (tlo - done) > 0 ? (tlo - done) : 0;
        { const int gfirst = done + it; const int r = (gw - (gfirst - tlo) % NGW + NGW) % NGW; it += r; }
        if (it < nt) {
            CvtTile tc = cvt_job_tile(j, it); CvtRegs Ra;
            if (j.fp8) cvt_load8(Ra, tc.W, tc.ldw, tc.k0, tc.n0, F.lane); else cvt_load(Ra, tc.W, tc.ldw, tc.k0, tc.n0, F.lane);
#pragma unroll 1
            for (;;) {
                const int itn = it + NGW; const bool more = itn < nt;
                CvtTile tn = tc; CvtRegs Rb;
                if (more) { tn = cvt_job_tile(j, itn); if (j.fp8) cvt_load8(Rb, tn.W, tn.ldw, tn.k0, tn.n0, F.lane); else cvt_load(Rb, tn.W, tn.ldw, tn.k0, tn.n0, F.lane); }
                if (j.fp8) cvt_store8(Ra, tc.k0, (unsigned char*)tc.Wt, tc.dpitch, tc.drow0, pg8::WQ_SCALE, scr, F.lane, j.ldw == 0); else cvt_store<false>(Ra, tc.k0, (bf16_t*)tc.Wt, tc.dpitch, tc.drow0, scr, F.lane);
                if (!more) break;
                Ra = Rb; tc = tn; it = itn;
            }
        }
        done += nt0;
    }
}
__device__ __forceinline__ void stage_gb(Frame& F, const float* g, const float* b) {
    __syncthreads();
    for (int i = F.tid; i < DM / 4; i += 512) { ((LAS f32x4*)F.lds)[i] = ((const f32x4*)g)[i]; ((LAS f32x4*)(F.lds + 16384))[i] = ((const f32x4*)b)[i]; }
    __syncthreads();
}
__device__ __forceinline__ void p0_prologue(Frame& F) {
    LAS unsigned* scr = (LAS unsigned*)(F.lds + 32768 + F.wave * 8704);
    const int gw = F.c * 8 + F.wave, NGW = F.G * 8;
    stage_gb(F, F.in[2], F.in[3]);
    { bf16_t* H0B = WSP(bf16_t, WS_H0B); f32x2* St0 = WSP(f32x2, WS_STATS0);
      for (int r = gw; r < ROWS_Z; r += NGW) {
          u32x2* o = (u32x2*)(H0B + (size_t)r * DM) + F.lane;
          if (r < KVROWS) { const float* src = r < T_TOK ? F.in[0] + (size_t)r * DM : F.in[1] + (size_t)(r - T_TOK) * DM;
              f32x4 v[16]; float mean, rstd; ln_row(src, (const LAS f32x4*)F.lds, (const LAS f32x4*)(F.lds + 16384), F.lane, v, mean, rstd);
              if (r < T_TOK && F.lane == 0) St0[r] = (f32x2){mean, rstd};
#pragma unroll
              for (int j = 0; j < 16; ++j) __builtin_nontemporal_store((u32x2){pk2(v[j][0], v[j][1]), pk2(v[j][2], v[j][3])}, o + 64 * j);
              { unsigned* oq = (unsigned*)(WSP(unsigned char, WS_H0Q) + (size_t)r * DM) + F.lane;
#pragma unroll
                  for (int j = 0; j < 16; ++j) oq[64 * j] = pg8::pack4_fp8(v[j]); }
          } else { unsigned* oq = (unsigned*)(WSP(unsigned char, WS_H0Q) + (size_t)r * DM) + F.lane;
#pragma unroll
              for (int j = 0; j < 16; ++j) { o[64 * j] = (u32x2){0u, 0u}; oq[64 * j] = 0u; }
          } } }
    cvt_run(F, 0, 8, gw, NGW, scr); cvt_run(F, 11, 13, gw, NGW, scr);
    { bf16_t* Wr = WSP(bf16_t, WS_WS13);
      for (int kb = gw; kb < DM / 64; kb += NGW) { cvt_tile<false>(F.in[20], NE, kb * 64, 0, Wr, DM, 1024, scr, F.lane); cvt_tile<true>(F.in[20], NE, kb * 64, 0, Wr, DM, 1088, scr, F.lane); }
      u32x4* z = (u32x4*)(Wr + (size_t)1152 * DM);
      for (int i = (F.c * 512 + F.tid); i < 128 * DM * 2 / 16; i += F.G * 512) z[i] = (u32x4){0u, 0u, 0u, 0u}; }
}

typedef float f32x16 __attribute__((ext_vector_type(16)));
constexpr int ATT_KP = 144, ATT_VP = 584, ATT_V_OFF = 288 * ATT_KP;
static_assert(ATT_V_OFF + 64 * ATT_VP <= RING_BYTES, "attention LDS");
__device__ __forceinline__ int att_src_pos(int key, int n) {
    if (key < 128) return n > 0 ? NMETA + 128 * (n - 1) + key : -1;
    if (key < 256) return NMETA + 128 * n + (key - 128);
    if (key < 272) return key - 256;
    return -1;
}
__device__ __forceinline__ void attn_unit(Frame& F, int n, int kh) {
    const bf16_t* Qb = WSP(bf16_t, WS_QB); const bf16_t* Kb = WSP(bf16_t, WS_KB); const bf16_t* Vt = WSP(bf16_t, WS_VB); unsigned char* At = WSP(unsigned char, WS_ATT);
    LAS unsigned char* Ks = F.lds; LAS unsigned char* Vs = F.lds + ATT_V_OFF;
    __syncthreads();
    for (int p = F.tid; p < 288 * 8; p += 512) { const int j = p >> 3, c8 = p & 7, sp = att_src_pos(j, n);
        u32x4 v = (u32x4){0u, 0u, 0u, 0u};
        if (sp >= 0) v = *(const u32x4*)(Kb + (size_t)sp * KVW + kh * 64 + c8 * 8);
        *(LAS u32x4*)(Ks + j * ATT_KP + c8 * 16) = v; }
    for (int p = F.tid; p < 64 * 36; p += 512) { const int d = p / 36, q = p % 36, sp = att_src_pos(q * 8, n);
        u32x4 v = (u32x4){0u, 0u, 0u, 0u};
        if (sp >= 0) v = *(const u32x4*)(Vt + (size_t)(kh * 64 + d) * KVROWS + sp);
        LAS u32x2* dst = (LAS u32x2*)(Vs + d * ATT_VP + q * 16); dst[0] = (u32x2){v.x, v.y}; dst[1] = (u32x2){v.z, v.w}; }
    __syncthreads();
    const int hq = kh * 8 + F.wave, r32 = F.lane & 31, hh = F.lane >> 5;
    const float sink2 = F.in[5][hq] * LOG2E;
    const bool prevok = n > 0;
#pragma unroll 1
    for (int qt = 0; qt < 4; ++qt) {
        const bf16_t* qrow = Qb + (size_t)(128 * n + 32 * qt + r32) * AW + hq * 64 + 8 * hh;
        bf16x8 qf[4];
#pragma unroll
        for (int t = 0; t < 4; ++t) qf[t] = *(const bf16x8*)(qrow + 16 * t);
        f32x16 sacc[6];
#pragma unroll
        for (int x = 0; x < 6; ++x) {
            const int kb = x < 4 - qt ? 32 * (qt + x) : (x < 5 ? 128 + 32 * (x - (4 - qt)) : 256);
            f32x16 acc;
#pragma unroll
            for (int i = 0; i < 16; ++i) acc[i] = 0.f;
#pragma unroll
            for (int t = 0; t < 4; ++t) { const bf16x8 kf = *(const LAS bf16x8*)(Ks + (kb + r32) * ATT_KP + (16 * t + 8 * hh) * 2); acc = __builtin_amdgcn_mfma_f32_32x32x16_bf16(kf, qf[t], acc, 0, 0, 0); }
#pragma unroll
            for (int i = 0; i < 16; ++i) { const int m = (i & 3) + 8 * (i >> 2) + 4 * hh;
                bool vis;
                if (x < 4 - qt) vis = prevok && (x > 0 || m > r32);
                else if (x < 5) vis = (x < 4) || (m <= r32);
                else vis = m < 16;
                acc[i] = vis ? acc[i] : -1e30f; }
            sacc[x] = acc;
        }
        float mx = sink2;
#pragma unroll
        for (int x = 0; x < 6; ++x)
#pragma unroll
            for (int i = 0; i < 16; ++i) mx = fmaxf(mx, sacc[x][i]);
        mx = fmaxf(mx, __shfl_xor(mx, 32));
        float l = 0.f;
#pragma unroll
        for (int x = 0; x < 6; ++x)
#pragma unroll
            for (int i = 0; i < 16; ++i) { const float p = __builtin_amdgcn_exp2f(sacc[x][i] - mx); sacc[x][i] = p; l += p; }
        l += __shfl_xor(l, 32); l += __builtin_amdgcn_exp2f(sink2 - mx);
        f32x16 oacc[2];
#pragma unroll
        for (int dt = 0; dt < 2; ++dt)
#pragma unroll
            for (int i = 0; i < 16; ++i) oacc[dt][i] = 0.f;
#pragma unroll
        for (int x = 0; x < 6; ++x) {
            const int kb = x < 4 - qt ? 32 * (qt + x) : (x < 5 ? 128 + 32 * (x - (4 - qt)) : 256);
#pragma unroll
            for (int t2 = 0; t2 < 2; ++t2) {
                u32x4 pw; pw.x = pg8::cvt_pk_bf16(sacc[x][8 * t2 + 0], sacc[x][8 * t2 + 1]); pw.y = pg8::cvt_pk_bf16(sacc[x][8 * t2 + 2], sacc[x][8 * t2 + 3]);
                pw.z = pg8::cvt_pk_bf16(sacc[x][8 * t2 + 4], sacc[x][8 * t2 + 5]); pw.w = pg8::cvt_pk_bf16(sacc[x][8 * t2 + 6], sacc[x][8 * t2 + 7]);
                const bf16x8 pf = __builtin_bit_cast(bf16x8, pw);
#pragma unroll
                for (int dt = 0; dt < 2; ++dt) { const LAS u32x2* vp = (const LAS u32x2*)(Vs + (32 * dt + r32) * ATT_VP + (kb + 16 * t2 + 4 * hh) * 2);
                    const u32x2 a = vp[0], b = vp[2]; u32x4 vw; vw.x = a.x; vw.y = a.y; vw.z = b.x; vw.w = b.y;
                    oacc[dt] = __builtin_amdgcn_mfma_f32_32x32x16_bf16(__builtin_bit_cast(bf16x8, vw), pf, oacc[dt], 0, 0, 0); }
            }
        }
        const float inv = 1.f / l;
        unsigned char* orow = At + (size_t)(128 * n + 32 * qt + r32) * AW + hq * 64 + 4 * hh;
#pragma unroll
        for (int dt = 0; dt < 2; ++dt)
#pragma unroll
            for (int g = 0; g < 4; ++g) *(unsigned*)(orow + 32 * dt + 8 * g) = pg8::pack4_fp8((f32x4){oacc[dt][4 * g] * inv, oacc[dt][4 * g + 1] * inv, oacc[dt][4 * g + 2] * inv, oacc[dt][4 * g + 3] * inv});
    }
}

constexpr int SSM_NCH = KVROWS / 8, SSM_NBLK = (SSM_NCH + 63) / 64, SSM_EP = 132, SSM_SP = 272, SSM_UP = 272;
constexpr int SSM_UB = 0  , SSM_EB = 3 * 64 * SSM_UP  , SSM_SB = SSM_EB + 2 * 64 * SSM_EP * 4  ;
constexpr int SSM_APOW = SSM_EB, SSM_BBAR = SSM_APOW + 4608, SSM_KD = SSM_BBAR + 8192;
static_assert(SSM_KD + 16384 <= SSM_SB && SSM_SB + 64 * SSM_SP <= LUT_OFF, "SSM LDS");
__device__ __forceinline__ bf16x8 pack_frag(const float (&v)[8]) { u32x4 w; w.x = pk2(v[0], v[1]); w.y = pk2(v[2], v[3]); w.z = pk2(v[4], v[5]); w.w = pk2(v[6], v[7]); return __builtin_bit_cast(bf16x8, w); }
__device__ __forceinline__ f32x2 gelu_pk(f32x2 v) {
    const f32x2 av = __builtin_elementwise_abs(v), d = av * 0.2316418882f + 1.0f;
    f32x2 t; t.x = __builtin_amdgcn_rcpf(d.x); t.y = __builtin_amdgcn_rcpf(d.y);
    f32x2 q = t * 0.5307027145f + (-0.7265760135f); q = q * t + 0.7107068705f; q = q * t + (-0.142248368f); q = q * t + 0.127414796f; q = q * t;
    const f32x2 sq = (v * v) * (-0.72134752044f);
    f32x2 e; e.x = __builtin_amdgcn_exp2f(sq.x); e.y = __builtin_amdgcn_exp2f(sq.y);
    const f32x2 m = v * (q * e), r = v - m;
    f32x2 o; o.x = v.x < 0.f ? m.x : r.x; o.y = v.y < 0.f ? m.y : r.y; return o;
}
__device__ __forceinline__ void ssm_unit(Frame& F, int g, int bfull, int bend) {
    const int tid = F.tid, lane = F.lane, w = F.wave, nl = lane & 15, kg = lane >> 4;
    LAS f32x2* apow = (LAS f32x2*)(F.lds + SSM_APOW);
    LAS f32x2* bbar = (LAS f32x2*)(F.lds + SSM_BBAR);
    LAS float* Kd = (LAS float*)(F.lds + SSM_KD);
    LAS f32x2* clds = (LAS f32x2*)(F.lds + SSM_KD + 8192);
    LAS float* eb = (LAS float*)(F.lds + SSM_EB);
    LAS unsigned char* sb = F.lds + SSM_SB;
    LAS unsigned char* ub = F.lds + SSM_UB;
    const float* Cre = F.in[12] + (size_t)g * 16 * 64; const float* Cim = F.in[13] + (size_t)g * 16 * 64;
    const bf16_t* Ub = WSP(bf16_t, WS_UG) + (size_t)g * KVROWS * 16;
    const int ur0 = tid >> 4, uc0 = tid & 15;
#define SSM_ULOAD(b, r0, r1) do { r0 = *(const u32x4*)(Ub + (size_t)(64 * (b) + ur0) * 128 + uc0 * 8); r1 = *(const u32x4*)(Ub + (size_t)(64 * (b) + 32 + ur0) * 128 + uc0 * 8); } while (0)
#define SSM_USTORE(b, r0, r1) do { LAS unsigned char* u_ = ub + ((b) % 3) * 64 * SSM_UP; *(LAS u32x4*)(u_ + ur0 * SSM_UP + uc0 * 16) = r0; *(LAS u32x4*)(u_ + (32 + ur0) * SSM_UP + uc0 * 16) = r1; } while (0)
    u32x4 ua0, ua1, ub0, ub1;
    __syncthreads();
    SSM_ULOAD(0, ua0, ua1); SSM_ULOAD(1, ub0, ub1);
    { const int p = tid & 63, d = tid >> 6; const float dt = expf(F.in[9][g]), lr = F.in[7][g * 64 + p], li = F.in[8][g * 64 + p];
      { const float mg = expf(d * dt * lr); float sn, cs; sincosf(d * dt * li, &sn, &cs); apow[d * 64 + p] = (f32x2){mg * cs, mg * sn}; }
      if (d == 0) { const float mg = expf(8.f * dt * lr); float sn, cs; sincosf(8.f * dt * li, &sn, &cs); apow[8 * 64 + p] = (f32x2){mg * cs, mg * sn}; }
      if (d == 1) {
        const float em1 = expm1f(dt * lr), th = dt * li; float sn, cs; sincosf(th, &sn, &cs);
        const float ai = (em1 + 1.f) * sn, sh = sinf(0.5f * th), num_re = em1 * cs - 2.f * sh * sh;
        const float den = lr * lr + li * li, cre = (num_re * lr + ai * li) / den, cim = (ai * lr - num_re * li) / den;
        const float* br = F.in[10] + (size_t)(g * 64 + p) * 16; const float* bi = F.in[11] + (size_t)(g * 64 + p) * 16;
#pragma unroll
        for (int h = 0; h < 16; ++h) bbar[p * 16 + h] = (f32x2){cre * br[h] - cim * bi[h], cre * bi[h] + cim * br[h]};
      }
      for (int i = tid; i < 1024; i += 512) clds[i] = (f32x2){Cre[i], Cim[i]};
    }
    SSM_USTORE(0, ua0, ua1); SSM_USTORE(1, ub0, ub1);
    __syncthreads();
    { const int d = tid >> 6, ho = (tid >> 2) & 15, hq = tid & 3; float k0 = 0.f, k1 = 0.f, k2 = 0.f, k3 = 0.f;
#pragma unroll 8
      for (int p = 0; p < 64; ++p) { const f32x2 cc = clds[ho * 64 + p]; const float cr = cc.x, ci = cc.y; const f32x2 a = apow[d * 64 + p]; const float wr = cr * a.x - ci * a.y, wi = cr * a.y + ci * a.x;
          const f32x2 b0 = bbar[p * 16 + 4 * hq], b1 = bbar[p * 16 + 4 * hq + 1], b2 = bbar[p * 16 + 4 * hq + 2], b3 = bbar[p * 16 + 4 * hq + 3];
          k0 += wr * b0.x - wi * b0.y; k1 += wr * b1.x - wi * b1.y; k2 += wr * b2.x - wi * b2.y; k3 += wr * b3.x - wi * b3.y; }
      *(LAS f32x4*)(Kd + (d * 16 + ho) * 16 + 4 * hq) = (f32x4){k0, k1, k2, k3}; }
    __syncthreads();
    bf16x8 bE[4], bT[4], bC[4];
    { const int p = (16 * w + nl) & 63; const bool im = w >= 4;
#pragma unroll
      for (int t = 0; t < 4; ++t) { const int j = 2 * t + (kg >> 1); const f32x2 a = apow[(7 - j) * 64 + p]; float v[8];
#pragma unroll
          for (int jj = 0; jj < 8; ++jj) { const f32x2 b = bbar[p * 16 + 8 * (kg & 1) + jj]; v[jj] = im ? (a.x * b.y + a.y * b.x) : (a.x * b.x - a.y * b.y); }
          bE[t] = pack_frag(v); } }
#pragma unroll
    for (int t = 0; t < 4; ++t) { const int j = 2 * t + (kg >> 1); float v[8];
#pragma unroll
        for (int jj = 0; jj < 8; ++jj) v[jj] = (j <= w) ? Kd[(((w - j) & 7) * 16 + nl) * 16 + 8 * (kg & 1) + jj] : 0.f;
        bT[t] = pack_frag(v); }
#pragma unroll
    for (int t = 0; t < 4; ++t) { float v[8];
#pragma unroll
        for (int jj = 0; jj < 8; ++jj) { const int p = 16 * t + 4 * kg + (jj >> 1); const f32x2 a = apow[(w + 1) * 64 + p]; const f32x2 cc = clds[nl * 64 + p]; const float cr = cc.x, ci = cc.y;
            v[jj] = (jj & 1) == 0 ? (cr * a.x - ci * a.y) : (-cr * a.y - ci * a.x); }
        bC[t] = pack_frag(v); }
    const f32x2 a8 = apow[8 * 64 + lane];
    const int ecol = 2 * ((16 * w + nl) & 63) + (w >> 2);
    bf16_t* Y1 = WSP(bf16_t, WS_Y1); const float dsk = F.in[14][g * 16 + nl];
#define SSM_UFRAG(b, mt, t) (*(const LAS bf16x8*)(ub + ((b) % 3) * 64 * SSM_UP + (16 * (mt) + nl) * SSM_UP + (32 * (t) + 8 * kg) * 2))
#define SSM_EGEMM(b) do { LAS float* e_ = eb + ((b) & 1) * 64 * SSM_EP; _Pragma("unroll") for (int mt = 0; mt < 4; ++mt) { f32x4 c_ = (f32x4){0.f, 0.f, 0.f, 0.f}; \
        _Pragma("unroll") for (int t = 0; t < 4; ++t) c_ = __builtin_amdgcn_mfma_f32_16x16x32_bf16(SSM_UFRAG(b, mt, t), bE[t], c_, 0, 0, 0); \
        _Pragma("unroll") for (int r = 0; r < 4; ++r) e_[(16 * mt + 4 * kg + r) * SSM_EP + ecol] = c_[r]; } } while (0)
    __syncthreads();
    SSM_EGEMM(0);
    f32x2 xs = (f32x2){0.f, 0.f};
    __syncthreads();
#pragma unroll 1
    for (int b = 0; b < bend; ++b) {
        const bool full = b >= bfull;
        if (b + 2 < bend) SSM_ULOAD(b + 2, ua0, ua1);
        if (w == 0) {
            const LAS f32x2* e_ = (const LAS f32x2*)(eb + (b & 1) * 64 * SSM_EP) + lane;
            const f32x2 aa = (f32x2){a8.x, a8.x}, ab = (f32x2){-a8.y, a8.y};
#pragma unroll
            for (int hf = 0; hf < 2; ++hf) { f32x2 ev[32];
#pragma unroll
                for (int c = 0; c < 32; ++c) ev[c] = e_[(32 * hf + c) * (SSM_EP / 2)];
#pragma unroll
                for (int c = 0; c < 32; ++c) { *(LAS unsigned*)(sb + (32 * hf + c) * SSM_SP + lane * 4) = pk2(xs.x, xs.y);
                    xs = aa * xs + (ab * (f32x2){xs.y, xs.x} + ev[c]); } }
        }
        f32x4 acc[4];
        if (full) {
#pragma unroll
            for (int mt = 0; mt < 4; ++mt) { acc[mt] = (f32x4){0.f, 0.f, 0.f, 0.f};
#pragma unroll
                for (int t = 0; t < 4; ++t) acc[mt] = __builtin_amdgcn_mfma_f32_16x16x32_bf16(SSM_UFRAG(b, mt, t), bT[t], acc[mt], 0, 0, 0); }
        }
        if (b + 1 < bend) SSM_EGEMM(b + 1);
        if (b + 2 < bend) SSM_USTORE(b + 2, ua0, ua1);
        __syncthreads();
        if (full) {
#pragma unroll
            for (int mt = 0; mt < 4; ++mt) {
#pragma unroll
                for (int t = 0; t < 4; ++t) { const bf16x8 sf = *(const LAS bf16x8*)(sb + (16 * mt + nl) * SSM_SP + (32 * t + 8 * kg) * 2); acc[mt] = __builtin_amdgcn_mfma_f32_16x16x32_bf16(sf, bC[t], acc[mt], 0, 0, 0); }
            }
            { const LAS unsigned char* u_ = ub + (b % 3) * 64 * SSM_UP;
#pragma unroll
              for (int mt = 0; mt < 4; ++mt)
#pragma unroll
                for (int r2 = 0; r2 < 2; ++r2) { const int row = 16 * mt + 4 * kg + 2 * r2, ch = 64 * b + row, pos = 8 * ch + w;
                    const float u0 = bf2f(*(const LAS bf16_t*)(u_ + row * SSM_UP + (w * 16 + nl) * 2)), u1 = bf2f(*(const LAS bf16_t*)(u_ + (row + 1) * SSM_UP + (w * 16 + nl) * 2));
                    const f32x2 ge = gelu_pk((f32x2){acc[mt][2 * r2] + dsk * u0, acc[mt][2 * r2 + 1] + dsk * u1});
                    if (ch < SSM_NCH && pos >= NMETA) Y1[(size_t)(pos - NMETA) * SW + g * 16 + nl] = (bf16_t)f2bf(ge.x);
                    if (ch + 1 < SSM_NCH && pos + 8 >= NMETA) Y1[(size_t)(pos + 8 - NMETA) * SW + g * 16 + nl] = (bf16_t)f2bf(ge.y); } }
            __syncthreads();
        }
    }
#undef SSM_ULOAD
#undef SSM_USTORE
#undef SSM_UFRAG
#undef SSM_EGEMM
}

__device__ __forceinline__ void ln1_pass(Frame& F) {
    const int gw = F.c * 8 + F.wave, NGW = F.G * 8;
    const bf16_t* H = WSP(bf16_t, WS_H1F); const bf16_t* H0 = WSP(bf16_t, WS_H0B); bf16_t* Hb = WSP(bf16_t, WS_H1B); unsigned char* Hq = WSP(unsigned char, WS_H1LO);
    stage_gb(F, F.in[18], F.in[19]);
    const LAS f32x4* gl = (const LAS f32x4*)F.lds; const LAS f32x4* bl = (const LAS f32x4*)(F.lds + 16384);
#pragma unroll 1
    for (int r = gw; r < T_TOK; r += NGW) {
        const u32x2* x = (const u32x2*)(H + (size_t)r * DM) + F.lane; const u32x2* x0 = (const u32x2*)(H0 + (size_t)r * DM) + F.lane;
        u32x2* ob = (u32x2*)(Hb + (size_t)r * DM) + F.lane; unsigned* oq = (unsigned*)(Hq + (size_t)r * DM) + F.lane;
        float s = 0.f, q = 0.f;
#pragma unroll
        for (int j = 0; j < 16; ++j) { const u32x2 w = x[64 * j], w0 = x0[64 * j];
            const f32x4 v = (f32x4){bf_lo(w0.x), bf_hi(w0.x), bf_lo(w0.y), bf_hi(w0.y)} * ALPHA + (f32x4){bf_lo(w.x), bf_hi(w.x), bf_lo(w.y), bf_hi(w.y)};
            s += (v[0] + v[1]) + (v[2] + v[3]); q += (v[0] * v[0] + v[1] * v[1]) + (v[2] * v[2] + v[3] * v[3]); }
        const float mean = wave_sum(s) * (1.f / DM), var = fmaxf(wave_sum(q) * (1.f / DM) - mean * mean, 0.f), rstd = 1.f / sqrtf(var + LN_EPS);
        asm volatile("" ::: "memory");
#pragma unroll
        for (int j = 0; j < 16; ++j) { const u32x2 w = __builtin_nontemporal_load(x + 64 * j), w0 = __builtin_nontemporal_load(x0 + 64 * j);
            const f32x4 v = (f32x4){bf_lo(w0.x), bf_hi(w0.x), bf_lo(w0.y), bf_hi(w0.y)} * ALPHA + (f32x4){bf_lo(w.x), bf_hi(w.x), bf_lo(w.y), bf_hi(w.y)};
            const f32x4 y = (v - mean) * rstd * gl[F.lane + 64 * j] + bl[F.lane + 64 * j];
            ob[64 * j] = (u32x2){pk2(y[0], y[1]), pk2(y[2], y[3])}; __builtin_nontemporal_store(pg8::pack4_fp8(y), oq + 64 * j);
            if ((j & 3) == 3) asm volatile("" ::: "memory"); }
    }
}

__device__ __forceinline__ void route_pass(Frame& F) {
    const int gw = F.c * 8 + F.wave, NGW = F.G * 8, lane = F.lane;
    LAS unsigned* hist = (LAS unsigned*)F.lds;
    __syncthreads();
    if (F.tid < NE) hist[F.tid] = 0u;
    __syncthreads();
    const float* Lg = WSP(float, WS_LOGITS); int* TI = WSP(int, WS_TOPI); float* TW = WSP(float, WS_TOPW);
    const float bias = F.in[21][lane];
    for (int t = gw; t < T_TOK; t += NGW) {
        const float lg = Lg[(size_t)t * 128 + lane] + Lg[(size_t)t * 128 + 64 + lane];
        const float score = 1.f / (1.f + expf(-lg)), sel = score + bias;
        int rk = 0;
#pragma unroll
        for (int x = 1; x < 8; ++x) { const float o = __shfl_xor(sel, x); const int pl = lane ^ x; rk += (o > sel || (o == sel && pl < lane)) ? 1 : 0; }
        float gs = rk < 2 ? sel : 0.f; gs += __shfl_xor(gs, 1); gs += __shfl_xor(gs, 2); gs += __shfl_xor(gs, 4);
        int grk = 0; const int mg = lane >> 3;
#pragma unroll
        for (int x = 1; x < 8; ++x) { const float o = __shfl_xor(gs, 8 * x); const int og = mg ^ x; grk += (o > gs || (o == gs && og < mg)) ? 1 : 0; }
        float val = grk < 4 ? sel : -1e30f;
        int myi = 0; float myw = 0.f, wsum = 0.f;
#pragma unroll
        for (int k = 0; k < TOPK; ++k) {
            const float mx = wave_max(val); const unsigned long long bal = __ballot(val == mx); const int win = __builtin_ctzll(bal);
            const float ws = __shfl(score, win); wsum += ws;
            if (lane == k) { myi = win; myw = ws; }
            if (lane == win) val = -3e38f;
        }
        if (lane < TOPK) { TI[t * TOPK + lane] = myi; TW[t * TOPK + lane] = myw / wsum * 2.5f; __hip_atomic_fetch_add(&hist[myi], 1u, __ATOMIC_RELAXED, __HIP_MEMORY_SCOPE_WORKGROUP); }
    }
    __syncthreads();
    if (F.tid < NE && hist[F.tid]) __hip_atomic_fetch_add(F.ctl + CW_CNT + F.tid, hist[F.tid], RLX_AGENT);
    __syncthreads();
}

__device__ __forceinline__ void lists_pass(Frame& F) {
    LAS int* sh = (LAS int*)F.lds;
    const int* TI = WSP(int, WS_TOPI); int* POS = WSP(int, WS_POS); int* RT = WSP(int, WS_ROWTOK); int* TE = WSP(int, WS_TILEE); int* UT = WSP(int, WS_UTAB);
    for (int e = F.c; e < NE; e += F.G) {
        __syncthreads();
        if (F.tid < NE) sh[F.tid] = (int)__hip_atomic_load(F.ctl + CW_CNT + F.tid, RLX_AGENT);
        __syncthreads();
        int tb = 0; for (int j = 0; j < e; ++j) tb += (sh[j] + 255) >> 8;
        const int cnt = sh[e], mytiles = (cnt + 255) >> 8, base = tb * 256;
        if (e == NE - 1 && F.tid == 0) __hip_atomic_store(F.ctl + CW_NTILES, (unsigned)(tb + mytiles), RLX_AGENT);
        int kk[16]; int loc = 0;
#pragma unroll
        for (int j = 0; j < 16; ++j) { const int t = F.tid * 16 + j; const u32x4 a = *(const u32x4*)(TI + t * 8), b = *(const u32x4*)(TI + t * 8 + 4);
            int k = -1; k = (int)a.x == e ? 0 : k; k = (int)a.y == e ? 1 : k; k = (int)a.z == e ? 2 : k; k = (int)a.w == e ? 3 : k; k = (int)b.x == e ? 4 : k; k = (int)b.y == e ? 5 : k; k = (int)b.z == e ? 6 : k; k = (int)b.w == e ? 7 : k;
            kk[j] = k; loc += (k >= 0) ? 1 : 0; }
        int inc = loc;
#pragma unroll
        for (int o = 1; o < 64; o <<= 1) { const int v = __shfl_up(inc, o); if (F.lane >= o) inc += v; }
        if (F.lane == 63) sh[64 + F.wave] = inc;
        __syncthreads();
        int woff = 0; for (int w = 0; w < F.wave; ++w) woff += sh[64 + w];
        int rank = woff + inc - loc;
#pragma unroll
        for (int j = 0; j < 16; ++j) if (kk[j] >= 0) { const int t = F.tid * 16 + j; RT[base + rank] = t; POS[t * 8 + kk[j]] = base + rank; ++rank; }
        for (int i = cnt + F.tid; i < mytiles * 256; i += 512) RT[base + i] = 0;
        if (F.tid < mytiles) TE[tb + F.tid] = e;
        for (int idx = F.tid; idx < mytiles * 16; idx += 512) { const int pb = idx / (mytiles * 8), rem = idx % (mytiles * 8), t = rem >> 3, pn = pb * 8 + (rem & 7);
            UT[tb * 16 + idx] = (tb + t) | (pn << 16) | (e << 24); }
    }
}

__device__ __forceinline__ void combine_pass(Frame& F) {
    const int gw = F.c * 8 + F.wave, NGW = F.G * 8;
    const bf16_t* H = WSP(bf16_t, WS_H1B); const unsigned char* Y = WSP(unsigned char, WS_YB); const int* POS = WSP(int, WS_POS); const float* TW = WSP(float, WS_TOPW);
    stage_gb(F, F.in[28], F.in[29]);
    for (int t = gw; t < T_TOK; t += NGW) {
        f32x4 v[16]; const u32x2* hr = (const u32x2*)(H + (size_t)t * DM) + F.lane;
#pragma unroll
        for (int j = 0; j < 16; ++j) { const u32x2 h = __builtin_nontemporal_load(hr + 64 * j); v[j] = (f32x4){bf_lo(h.x), bf_hi(h.x), bf_lo(h.y), bf_hi(h.y)}; }
#pragma unroll 2
        for (int k = 0; k < TOPK; ++k) { const int row = POS[t * TOPK + k]; const float w = TW[t * TOPK + k]; const unsigned* yr = (const unsigned*)(Y + (size_t)row * DM) + F.lane;
#pragma unroll
            for (int j = 0; j < 16; ++j) { const int y = (int)__builtin_nontemporal_load(yr + 64 * j); const f32x2 lo = __builtin_amdgcn_cvt_pk_f32_fp8(y, false), hi = __builtin_amdgcn_cvt_pk_f32_fp8(y, true); v[j] += (f32x4){lo.x, lo.y, hi.x, hi.y} * w; } }
        float s = 0.f;
#pragma unroll
        for (int j = 0; j < 16; ++j) s += (v[j][0] + v[j][1]) + (v[j][2] + v[j][3]);
        const float mean = wave_sum(s) * (1.f / DM); float s2 = 0.f;
#pragma unroll
        for (int j = 0; j < 16; ++j) { v[j] = v[j] - mean; s2 += (v[j][0] * v[j][0] + v[j][1] * v[j][1]) + (v[j][2] * v[j][2] + v[j][3] * v[j][3]); }
        const float rstd = 1.f / sqrtf(wave_sum(s2) * (1.f / DM) + LN_EPS);
        f32x4* o = (f32x4*)(F.out + (size_t)t * DM) + F.lane;
        asm volatile("" ::: "memory");
#pragma unroll
        for (int j = 0; j < 16; ++j) { const f32x4 gg = ((const LAS f32x4*)F.lds)[F.lane + 64 * j], bb = ((const LAS f32x4*)(F.lds + 16384))[F.lane + 64 * j]; __builtin_nontemporal_store(v[j] * rstd * gg + bb, o + 64 * j); }
    }
}

#ifndef DUMP
#define DUMP 0
#endif
__device__ __forceinline__ void dump_f32(Frame& F, const float* src) {
    for (size_t i = (size_t)F.c * 512 + F.tid; i < (size_t)T_TOK * DM / 4; i += (size_t)F.G * 512) ((f32x4*)F.out)[i] = ((const f32x4*)src)[i];
}
__device__ __forceinline__ void dump_bf16(Frame& F, const bf16_t* src, int ld, int ncols, int colofs, size_t nrows) {
    for (size_t i = (size_t)F.c * 512 + F.tid; i < nrows * ncols; i += (size_t)F.G * 512) { const size_t r = i / ncols, c = i % ncols; if (r < T_TOK) F.out[r * DM + colofs + c] = bf2f(src[r * ld + c]); }
}
__device__ __forceinline__ void dump_zero(Frame& F) {
    for (size_t i = (size_t)F.c * 512 + F.tid; i < (size_t)T_TOK * DM / 4; i += (size_t)F.G * 512) ((f32x4*)F.out)[i] = (f32x4){0.f, 0.f, 0.f, 0.f};
}
__device__ __forceinline__ void p1_convert(Frame& F, int when) {
    int c = F.c; asm volatile("" : "+s"(c));
    LAS unsigned* scr = (LAS unsigned*)(F.lds + F.wave * 8704);
    const bool split = (F.G == 256);
    const int NT = split ? CVT_P1_TILES : 3 * NE * 64 * 8;
    if (!split) { if (when == 0) cvt_run(F, 8, 11, c * 8 + F.wave, F.G * 8, scr); return; }
    const int nA = 58, sB = 312, sA = 372;
    const int kc = (c >> 3) & 1;
    if (kc != when) return;
    int tlo, thi;
    if (c < 256 - nA) { tlo = c * sB; thi = tlo + sB; } else { tlo = (256 - nA) * sB + (c - (256 - nA)) * sA; thi = tlo + sA; }
    if (thi > NT) thi = NT; if (tlo > NT) tlo = NT;
    cvt_run(F, 8, 11, F.wave, 8, scr, tlo, thi);
}
struct Args { const float* in[30]; float* out; unsigned char* ws; int ph_lo, ph_hi, one, pad; };
__global__ void __launch_bounds__(512, 2) mk_fwd(Args args) {
    extern __shared__ __attribute__((aligned(16))) unsigned char lds[];
    Frame F;
    F.lds = (LAS unsigned char*)lds; F.ws = args.ws; F.ctl = (gu32*)(args.ws + WS_CTL);
    F.tid = threadIdx.x; F.lane = F.tid & 63; F.wave = __builtin_amdgcn_readfirstlane(F.tid >> 6); F.G = gridDim.x; F.c = blockIdx.x;
    F.in = args.in; F.out = args.out;
    volatile LAS unsigned* MISC = (volatile LAS unsigned*)(F.lds + MISC_OFF);
    for (int u = F.tid; u < (LDS_BYTES - RING_BYTES) / 4; u += 512) ((LAS unsigned*)(F.lds + RING_BYTES))[u] = 0u;
    __syncthreads();
    XcdBarrier bar; bar.bar = (unsigned*)(F.ctl + CW_BAR); bar.x = 0; bar.st = nullptr;
    if (args.one) bar = xcd_barrier_post((unsigned*)(F.ctl + CW_BAR), MISC + 8);
    const int lo = args.ph_lo, hi = args.ph_hi;
#ifndef PH_MASK
#define PH_MASK 0xffffffffu
#endif
#define IN(k) (((PH_MASK >> (k)) & 1u) && lo <= (k) && (k) < hi)
#define SEAM(k) do { if (IN(k) && IN((k) + 1)) xcd_barrier(bar); REFRESH(); } while (0)
#define REFRESH() do { int t_ = threadIdx.x; asm volatile("" : "+v"(t_)); F.tid = t_; F.lane = t_ & 63; F.wave = __builtin_amdgcn_readfirstlane(t_ >> 6); } while (0)
#ifndef HOT12
#define HOT12 0
#endif
#ifndef PROBE_REP
#define PROBE_REP 0u
#endif
#define RUN(k, ...) if (IN(k)) { __VA_ARGS__ if ((PROBE_REP >> (k)) & 1u) { xcd_barrier(bar); REFRESH(); __VA_ARGS__ } }
    LAS unsigned char* ring = F.lds;

    RUN(0, { p0_prologue(F);  }) SEAM(0);
    RUN(1, {
        p1_convert(F, 0); __syncthreads();
        { pg8::DenseSched S{(const char*)WSP(unsigned char, WS_H0Q), (const char*)(WSP(unsigned char, WS_WING) + (size_t)10240 * DM), DM / 2, 33, 6, F.G, F.c, 0, 0, 0};
          pg8::EpiZ E{WSP(bf16_t, WS_KB), WSP(bf16_t, WS_VB), WSP(bf16_t, WS_UG)};
          pg8::gemm_phase<pg8::EpiZ, pg8::DenseSched, true>(ring, F.tid, DM / 2, DM / 2, S, E); }
        __syncthreads(); REFRESH();
        { pg8::DenseSched S{(const char*)WSP(unsigned char, WS_H0Q), (const char*)WSP(unsigned char, WS_WING), DM / 2, 32, 40, F.G, F.c, 0, 0, 0};
          pg8::EpiGate EG{WSP(bf16_t, WS_QB), WSP(bf16_t, WS_GA), WSP(bf16_t, WS_GS)};
          pg8::gemm_phase<pg8::EpiGate, pg8::DenseSched, true>(ring, F.tid, DM / 2, DM / 2, S, EG); }
        __syncthreads(); p1_convert(F, 1);
    }) SEAM(1);
    RUN(2, {
        const bool big = F.G >= 256; const int ntask = big ? 128 : 64;
        for (int t = F.c; t < ntask; t += F.G) { const int g = big ? t >> 1 : t, hf = big ? (t & 1) : 0; ssm_unit(F, g, hf ? 11 : 0, (big && !hf) ? 11 : SSM_NBLK); }
        const int a0 = big ? F.c - 128 : F.c, astep = big ? F.G - 128 : F.G;
        if (a0 >= 0) for (int u = a0; u < 256; u += astep) attn_unit(F, u >> 2, u & 3);
    }) SEAM(2);
    RUN(3, {
        pg8::DenseSched S{(const char*)WSP(unsigned char, WS_ATT), (const char*)WSP(unsigned char, WS_WAO), AW / 2, 32, 16, F.G, F.c, 0, 0, 0};
        pg8::EpiMix<false> E{WSP(bf16_t, WS_GA), WSP(bf16_t, WS_MIX), nullptr};
        pg8::gemm_phase<pg8::EpiMix<false>, pg8::DenseSched, true>(ring, F.tid, AW / 2, AW / 2, S, E);
    }) REFRESH();
    RUN(4, {
        if (F.G == 256 && F.c >= 128) { LAS unsigned* scr = (LAS unsigned*)(F.lds + F.wave * 8704); const int t0 = CVT_P1_TILES + (F.c - 128) * CVT_P4_PER; cvt_run(F, 8, 11, F.wave, 8, scr, t0, t0 + CVT_P4_PER); }
        pg8::DenseSched S{(const char*)WSP(bf16_t, WS_Y1), (const char*)WSP(bf16_t, WS_WGLU), SW, 32, 4, F.G, F.c, 0, 0, 0};
        pg8::EpiGlu E{WSP(bf16_t, WS_Y1), WSP(unsigned char, WS_Y2)};
        pg8::gemm_phase(ring, F.tid, SW, SW, S, E);
    }) SEAM(4);
    RUN(5, {
        pg8::DenseSched S{(const char*)WSP(unsigned char, WS_Y2), (const char*)WSP(unsigned char, WS_WSO), SW / 2, 32, 16, F.G, F.c, 0, 0, 0};
        pg8::EpiMix<true> E{WSP(bf16_t, WS_GS), WSP(bf16_t, WS_MIX), WSP(unsigned char, WS_H0Q)};
        pg8::gemm_phase<pg8::EpiMix<true>, pg8::DenseSched, true>(ring, F.tid, SW / 2, SW / 2, S, E);
    }) SEAM(5);
    RUN(6, {
        pg8::DenseSched S{(const char*)WSP(unsigned char, WS_H0Q), (const char*)WSP(unsigned char, WS_WOUT), DM / 2, 32, 16, F.G, F.c, 0, 0, 0};
        pg8::EpiWout E{WSP(bf16_t, WS_H1F)};
        pg8::gemm_phase<pg8::EpiWout, pg8::DenseSched, true>(ring, F.tid, DM / 2, DM / 2, S, E);
    }) SEAM(6);
    RUN(7, { ln1_pass(F);  }) SEAM(7);
    RUN(8, {
        if (F.G == 256 && F.c >= 160) { LAS unsigned* scr = (LAS unsigned*)(F.lds + F.wave * 8704); const int t0 = CVT_P1_TILES + CVT_P4_TILES + (F.c - 160) * CVT_P8_PER; cvt_run(F, 8, 11, F.wave, 8, scr, t0, t0 + CVT_P8_PER); }
        pg8::DenseSched S{(const char*)WSP(bf16_t, WS_H1B), (const char*)WSP(bf16_t, WS_WS13), DM, 32, 5, F.G, F.c, 0, 0, 0};
        pg8::EpiS13R E{WSP(bf16_t, WS_ACTS), WSP(float, WS_LOGITS)};
        pg8::gemm_phase(ring, F.tid, DM, DM, S, E);
    }) SEAM(8);
    RUN(9, { route_pass(F);  }) SEAM(9);
    RUN(10, { lists_pass(F);
        if (F.G == 256 && args.one && F.c >= 64) { pg8::DenseSched S{(const char*)WSP(bf16_t, WS_ACTS), (const char*)WSP(bf16_t, WS_WS2), EDIM, 32, 16, 192, F.c - 64, 0, 0, 0}; S.i1 = 2;
            pg8::EpiS2 E{WSP(bf16_t, WS_H1B)};
            pg8::gemm_phase(ring, F.tid, EDIM, EDIM, S, E); }
    }) SEAM(10);
    RUN(11, {
        const int ntiles = __builtin_amdgcn_readfirstlane((int)__hip_atomic_load(F.ctl + CW_NTILES, RLX_AGENT));
        { pg8::MoeSched S{(const char*)WSP(unsigned char, WS_H1LO), (const char*)WSP(unsigned char, WS_WE13), DM / 2, WSP(int, WS_ROWTOK), WSP(int, WS_TILEE), 4, (size_t)1024 * DM, ntiles * 4, F.G, F.c};
          pg8::EpiAct E{WSP(unsigned char, WS_ACT)};
          pg8::gemm_phase<pg8::EpiAct, pg8::MoeSched, true>(ring, F.tid, DM / 2, DM / 2, S, E); }
        { const bool early = (F.G == 256 && args.one);
          const int rem = (ntiles * 4) % F.G, nl = F.G - rem; const bool lite = early && rem > 0 && nl >= 64;
          if (!lite || F.c >= rem) {
          pg8::DenseSched S{(const char*)WSP(bf16_t, WS_ACTS), (const char*)WSP(bf16_t, WS_WS2), EDIM, 32, 16, lite ? nl : F.G, lite ? F.c - rem : F.c, 0, 0, 0}; S.l0 = early ? 384 : 0;
          pg8::EpiS2 E{WSP(bf16_t, WS_H1B)};
          pg8::gemm_phase(ring, F.tid, EDIM, EDIM, S, E); } }
    }) SEAM(11);
    RUN(12, {
        const int ntiles = __builtin_amdgcn_readfirstlane((int)__hip_atomic_load(F.ctl + CW_NTILES, RLX_AGENT)); const int nunits = ntiles * 16;
        LAS int* lut = (LAS int*)(F.lds + LUT_OFF);
#if HOT12
        __syncthreads();
        if (F.tid < 64) lut[F.tid] = (F.c & 3) | (((F.c >> 2) & 15) << 16);
        __syncthreads();
        { pg8::MoeTabSched S{(const char*)WSP(unsigned char, WS_ACT), (const char*)WSP(unsigned char, WS_WE2), EDIM / 2, lut, (size_t)DM * EDIM, nunits, F.G, F.c};
          pg8::EpiY E{WSP(unsigned char, WS_YB)};
          pg8::gemm_phase<pg8::EpiY, pg8::MoeTabSched, true>(ring, F.tid, EDIM / 2, EDIM / 2, S, E); }
        xcd_barrier(bar); REFRESH();
#endif
        __syncthreads();
        if (F.tid < 64) { const int L = F.tid * F.G + F.c; lut[F.tid] = L < nunits ? WSP(int, WS_UTAB)[pg8::xcd_remap(L, nunits)] : 0; }
        __syncthreads();
        pg8::MoeTabSched S{(const char*)WSP(unsigned char, WS_ACT), (const char*)WSP(unsigned char, WS_WE2), EDIM / 2, lut, (size_t)DM * EDIM, nunits, F.G, F.c};
        pg8::EpiY E{WSP(unsigned char, WS_YB)};
        pg8::gemm_phase<pg8::EpiY, pg8::MoeTabSched, true>(ring, F.tid, EDIM / 2, EDIM / 2, S, E);
    }) SEAM(12);
    RUN(13, { combine_pass(F);  })
#if DUMP
    if (lo <= 14 && 14 < hi) {
#if DUMP == 1
        dump_f32(F, WSP(float, WS_H1F));
#elif DUMP == 2
        dump_bf16(F, WSP(bf16_t, WS_MIX), DM, DM, 0, T_TOK);
#elif DUMP == 3
        dump_zero(F); __syncthreads();
        dump_bf16(F, WSP(bf16_t, WS_ATT), AW, AW, 0, T_TOK); dump_bf16(F, WSP(bf16_t, WS_Y1), SW, SW, AW, T_TOK);
#elif DUMP == 4
        dump_zero(F); __syncthreads();
        dump_bf16(F, WSP(bf16_t, WS_QB), AW, AW, 0, T_TOK); dump_bf16(F, WSP(bf16_t, WS_KB), KVW, KVW, AW, T_TOK); dump_bf16(F, WSP(bf16_t, WS_VB), KVW, KVW, AW + KVW, T_TOK);
        dump_bf16(F, WSP(bf16_t, WS_UG), 1026, 1026, AW + 2 * KVW, T_TOK);
#elif DUMP == 5
        dump_bf16(F, WSP(bf16_t, WS_GA), DM, DM, 0, T_TOK);
#elif DUMP == 7
        dump_bf16(F, WSP(bf16_t, WS_WIN) + (size_t)3584 * DM, DM, DM, 0, T_TOK);
#elif DUMP == 6
        dump_bf16(F, WSP(bf16_t, WS_H0B), DM, DM, 0, T_TOK);
#endif
    }
#endif
#undef IN
#undef SEAM
}

#ifndef PH_MASK
#define PH_MASK_HOST 0xffffffffu
#else
#define PH_MASK_HOST (PH_MASK)
#endif
extern "C" void kernel_launch(void* const* d_in, const int* in_sizes, int n_in, void* d_out, int out_size, void* d_ws, size_t ws_size, hipStream_t stream) {
    static int grid = 0;
    if (grid == 0) {
        if (n_in != 30 || in_sizes[0] != T_TOK * DM || out_size != T_TOK * DM || ws_size < WS_END) { fprintf(stderr, "kernel_launch: unexpected shapes / workspace (n_in %d, ws %zu, need %zu)\n", n_in, ws_size, (size_t)WS_END); grid = -1; return; }
        int dev = 0, cus = 0, per_cu = 0;
        if (hipGetDevice(&dev) != hipSuccess || hipDeviceGetAttribute(&cus, hipDeviceAttributeMultiprocessorCount, dev) != hipSuccess) { grid = -1; return; }
        if (hipFuncSetAttribute((const void*)mk_fwd, hipFuncAttributeMaxDynamicSharedMemorySize, LDS_BYTES) != hipSuccess) { fprintf(stderr, "kernel_launch: hipFuncSetAttribute failed\n"); grid = -1; return; }
        if (hipOccupancyMaxActiveBlocksPerMultiprocessor(&per_cu, (const void*)mk_fwd, 512, LDS_BYTES) != hipSuccess || per_cu < 1) fprintf(stderr, "kernel_launch: occupancy query reports %d\n", per_cu);
        (void)hipGetLastError();
        grid = cus;
    }
    if (grid < 0) return;
    if (hipMemsetAsync((char*)d_ws + WS_CTL, 0, CTL_ZERO_BYTES, stream) != hipSuccess) return;
    Args a{};
    for (int i = 0; i < 30; ++i) a.in[i] = (const float*)d_in[i];
    a.out = (float*)d_out; a.ws = (unsigned char*)d_ws; a.pad = 0;
#if MK_ONE_LAUNCH
    a.ph_lo = 0; a.ph_hi = NPHASE; a.one = 1;
    hipLaunchKernelGGL(mk_fwd, dim3(grid), dim3(512), LDS_BYTES, stream, a);
#else
    for (int p = 0; p < NPHASE + (DUMP ? 1 : 0); ++p) { a.ph_lo = p; a.ph_hi = p + 1; a.one = 0;
        if (!((PH_MASK_HOST >> p) & 1u)) continue;
        hipLaunchKernelGGL(mk_fwd, dim3(grid), dim3(512), LDS_BYTES, stream, a); }
#endif
}
```

```cpp
#include <hip/hip_runtime.h>
#include <cstdio>
#include <cstdint>

#define LAS __attribute__((address_space(3)))
#define GAS __attribute__((address_space(1)))
typedef unsigned short bf16_t;
typedef short bf16x8 __attribute__((ext_vector_type(8)));
typedef float f32x4 __attribute__((ext_vector_type(4)));
typedef float f32x2 __attribute__((ext_vector_type(2)));
typedef unsigned u32x4 __attribute__((ext_vector_type(4)));
typedef unsigned u32x2 __attribute__((ext_vector_type(2)));
typedef GAS unsigned gu32;

#ifndef MK_ONE_LAUNCH
#define MK_ONE_LAUNCH 1
#endif

constexpr int T_TOK = 8192, DM = 4096, NMETA = 16, ROWS_Z = 8448, KVROWS = 8208;
constexpr int NZ = 11776, AW = 2048, KVW = 256, SW = 1024;
constexpr int NE = 64, TOPK = 8, EDIM = 512;
constexpr float ALPHA = 1.189207115002721f;
constexpr float LN_EPS = 1e-5f;
constexpr float LOG2E = 1.4426950408889634f;
constexpr float QSCALE = 0.125f * LOG2E;
constexpr int MAXTILES = 320;
constexpr int NPHASE = 14;
constexpr int CVT_P8_PER = 120, CVT_P4_PER = 28, CVT_P8_TILES = 96 * CVT_P8_PER, CVT_P4_TILES = 128 * CVT_P4_PER, CVT_P1_TILES = 3 * NE * 64 * 8 - CVT_P8_TILES - CVT_P4_TILES;

constexpr size_t MiB = 1u << 20;
constexpr size_t WS_CTL = 0, CTL_ZERO_BYTES = 32768;
constexpr size_t WS_TOPI = 1 * MiB, WS_TOPW = WS_TOPI + 256 * 1024, WS_POS = WS_TOPW + 256 * 1024;
constexpr size_t WS_ROWTOK = 2 * MiB, WS_TILEE = 2 * MiB + 512 * 1024, WS_UTAB = WS_TILEE + 8192  , WS_STATS0 = 2 * MiB + 768 * 1024;
constexpr size_t WS_SSME = 3 * MiB, WS_LOGITS = 4 * MiB;
constexpr size_t WS_H1F = 8 * MiB, WS_H1B = 136 * MiB, WS_H1LO = 200 * MiB, WS_ACT = 264 * MiB, WS_ACTS = 344 * MiB;
constexpr size_t WS_WE2 = 352 * MiB, WS_WS2 = 608 * MiB, WS_WS13 = 612 * MiB;
constexpr size_t WS_WE13 = 640 * MiB, WS_WIN = 1152 * MiB, WS_WAO = 1244 * MiB, WS_WGLU = 1260 * MiB, WS_WSO = 1262 * MiB, WS_WOUT = 1270 * MiB;
constexpr size_t WS_H0B = 1302 * MiB, WS_QB = 1368 * MiB, WS_KB = 1400 * MiB, WS_VB = 1405 * MiB, WS_UG = 1410 * MiB;
constexpr size_t WS_GA = 1427 * MiB, WS_GS = 1491 * MiB, WS_ATT = 1555 * MiB, WS_Y1 = 1587 * MiB, WS_Y2 = 1603 * MiB, WS_MIX = 1619 * MiB;
constexpr size_t WS_END = 1683 * MiB;
constexpr size_t WS_WING = WS_WIN + 16 * MiB;
constexpr size_t WS_H0Q = WS_ACT + 40 * MiB;
constexpr size_t WS_YB = 640 * MiB;
static_assert(WS_YB + (size_t)MAXTILES * 256 * DM * 2 <= WS_H0B, "YB overlay");
constexpr int CW_TMO = 0, CW_CODE = 1, CW_NTILES = 64, CW_CNT = 128  , CW_BAR = 4096;

constexpr int RING_BYTES = 131072, LDS_BYTES = 147456, MISC_OFF = LDS_BYTES - 256, LUT_OFF = LDS_BYTES - 1024;

#define RLX_AGENT __ATOMIC_RELAXED, __HIP_MEMORY_SCOPE_AGENT
#define LDS_WAIT() asm volatile("s_waitcnt lgkmcnt(0)" ::: "memory")
#define VM_WAIT() asm volatile("s_waitcnt vmcnt(0)" ::: "memory")
__device__ __forceinline__ unsigned f2bf(float f) { unsigned u = __builtin_bit_cast(unsigned, f); return (u + 0x7fffu + ((u >> 16) & 1u)) >> 16; }
typedef __bf16 bf16x2_t __attribute__((ext_vector_type(2)));
__device__ __forceinline__ unsigned pk2(float lo, float hi) { f32x2 v = {lo, hi}; bf16x2_t b = __builtin_convertvector(v, bf16x2_t); return __builtin_bit_cast(unsigned, b); }
__device__ __forceinline__ float bf_lo(unsigned w) { return __builtin_bit_cast(float, w << 16); }
__device__ __forceinline__ float bf_hi(unsigned w) { return __builtin_bit_cast(float, w & 0xffff0000u); }
__device__ __forceinline__ float bf2f(bf16_t h) { return __builtin_bit_cast(float, ((unsigned)h) << 16); }
__device__ __forceinline__ float fast_sigmoid(float x) { return __builtin_amdgcn_rcpf(1.0f + __builtin_amdgcn_exp2f(-x * LOG2E)); }
__device__ __forceinline__ float wave_sum(float v) {
#pragma unroll
    for (int o = 1; o < 64; o <<= 1) v += __shfl_xor(v, o);
    return v;
}
__device__ __forceinline__ float wave_max(float v) {
#pragma unroll
    for (int o = 1; o < 64; o <<= 1) v = fmaxf(v, __shfl_xor(v, o));
    return v;
}

#define XB_TMO      128
#define XB_XCNT(j)  (256  + 64 * (j))
#define XB_XSUB(j)  (1280 + 64 * (j))
#define XB_XGEN(j)  (2304 + 64 * (j))
#define XB_TOP      3328
#define XB_TOPGEN   3392
#define XCD_BAR_WORDS 3456
#define XB_SPIN_CAP (1u << 18)
__device__ __forceinline__ unsigned xb_ld(unsigned* p)              { return __hip_atomic_load(p, __ATOMIC_RELAXED, __HIP_MEMORY_SCOPE_AGENT); }
__device__ __forceinline__ unsigned xb_add(unsigned* p, unsigned v) { return __hip_atomic_fetch_add(p, v, __ATOMIC_RELAXED, __HIP_MEMORY_SCOPE_AGENT); }
__device__ __forceinline__ unsigned xb_xcc_id() { return (unsigned)__builtin_amdgcn_s_getreg((3 << 11) | 20) & 0xFu; }
#define XB_SPIN(cond, bar) do { unsigned _sp = 0; while (cond) { __builtin_amdgcn_s_sleep(1); \
    if ((++_sp & 255u) == 0u) { if (xb_ld(&(bar)[XB_TMO])) break; if (_sp > XB_SPIN_CAP) { atomicAdd(&(bar)[XB_TMO], 1u); break; } } } } while (0)
struct XcdBarrier { unsigned* bar; unsigned x; volatile LAS unsigned* st; };
__device__ __forceinline__ XcdBarrier xcd_barrier_post(unsigned* bar, volatile LAS unsigned* st) {
    XcdBarrier b; b.bar = bar; b.x = xb_xcc_id(); b.st = st;
    if (threadIdx.x == 0) (void)xb_add(&bar[XB_XCNT(b.x)], 1u);
    return b;
}
__device__ __forceinline__ void xcd_barrier_complete(unsigned* bar, unsigned x, unsigned& nloc, unsigned& nx) {
    const unsigned G = gridDim.x * gridDim.y * gridDim.z;
    unsigned sum, cnt, mine, sp = 0u;
    for (;;) {
        sum = 0u; cnt = 0u; mine = 0u;
#pragma unroll
        for (unsigned j = 0; j < 16; ++j) { const unsigned c = xb_ld(&bar[XB_XCNT(j)]); sum += c; cnt += (c > 0u) ? 1u : 0u; mine = (j == x) ? c : mine; }
        if (sum == G) break;
        __builtin_amdgcn_s_sleep(1);
        if ((++sp & 255u) == 0u) { if (xb_ld(&bar[XB_TMO])) break; if (sp > XB_SPIN_CAP) { atomicAdd(&bar[XB_TMO], 1u); break; } }
    }
    nloc = mine > 0u ? mine : 1u; nx = cnt > 0u ? cnt : 1u;
}
__device__ __forceinline__ void xcd_barrier(const XcdBarrier& b) {
    asm volatile("s_waitcnt vmcnt(0)" ::: "memory");
    __syncthreads();
    if (threadIdx.x == 0) {
        unsigned* bar = b.bar;
        __builtin_amdgcn_s_waitcnt(0);
        unsigned nloc = b.st[0], nx = b.st[1];
        if (nloc == 0u) { xcd_barrier_complete(bar, b.x, nloc, nx); b.st[0] = nloc; b.st[1] = nx; }
        const unsigned old = xb_add(&bar[XB_XSUB(b.x)], 1u);
        const unsigned gen = old / nloc;
        if (old + 1u == (gen + 1u) * nloc) {
            __builtin_amdgcn_fence(__ATOMIC_RELEASE, "agent");
            asm volatile("s_waitcnt vmcnt(0)" ::: "memory");
            const unsigned og = xb_add(&bar[XB_TOP], 1u);
            const unsigned tg = og / nx;
            if (og + 1u == (tg + 1u) * nx) xb_add(&bar[XB_TOPGEN], 1u);
            else XB_SPIN(xb_ld(&bar[XB_TOPGEN]) == tg, bar);
            __builtin_amdgcn_fence(__ATOMIC_ACQUIRE, "agent");
            xb_add(&bar[XB_XGEN(b.x)], 1u);
            asm volatile("s_waitcnt vmcnt(0)" ::: "memory");
        } else {
            XB_SPIN(xb_ld(&bar[XB_XGEN(b.x)]) == gen, bar);
            __builtin_amdgcn_fence(__ATOMIC_ACQUIRE, "agent");
            asm volatile("s_waitcnt vmcnt(0)" ::: "memory");
        }
    }
    __syncthreads();
}

namespace pg8 {
constexpr int BM = 256, BK = 64, HALF = 128, HTB = HALF * BK * 2, NXCD = 8, WGM = 8;
__device__ __forceinline__ int lds_byte(int r, int c) { const int st = (r >> 4) * 2 + (c >> 5), rr = r & 15, cc = c & 31, ob = rr * 64 + cc * 2; return st * 1024 + (ob ^ (((ob >> 9) & 1) << 5)); }
__device__ __forceinline__ void stage_rc(int b, int& R, int& C) { const int st = b / 1024, sb = b % 1024, swz = sb ^ (((sb >> 9) & 1) << 5); R = (st >> 1) * 16 + swz / 64; C = (st & 1) * 32 + (swz % 64) / 2; }
__device__ __forceinline__ int perm32(int rho) { const int n = rho >> 4, i = rho & 15; return 8 * (i >> 2) + 4 * n + (i & 3); }
struct Unit { int pm, pn, e; };
__device__ __forceinline__ unsigned cvt_pk_bf16(float lo, float hi) { f32x2 v = {lo, hi}; bf16x2_t b = __builtin_convertvector(v, bf16x2_t); return __builtin_bit_cast(unsigned, b); }

__device__ __forceinline__ void tile_of(int L, int nM, int nN, int& pm, int& pn) {
    const int nwg = nM * nN; int wgid = L;
    { const int q = nwg / NXCD, r = nwg % NXCD, xcd = wgid % NXCD, off = wgid / NXCD; wgid = (xcd < r ? xcd * (q + 1) : r * (q + 1) + (xcd - r) * q) + off; }
    const int nig = WGM * nN, gid = wgid / nig, fm = gid * WGM, gsz = (nM - fm) < WGM ? (nM - fm) : WGM;
    pm = fm + ((wgid % nig) % gsz); pn = (wgid % nig) / gsz;
}
struct DenseSched {
    const char* A; const char* Bt; int K, nM, nN, G, c, xpm, xpn0, xn, i0 = 0, i1 = 0x7fffffff, l0 = 0;
    __device__ __forceinline__ bool next(int i, Unit& u) const {
        if (i + i0 >= i1) return false;
        const int L = (i + i0) * G + c + l0, nwg = nM * nN;
        if (L >= nwg) { const int x = L - nwg; if (x < xn) { u.pm = xpm; u.pn = xpn0 + x; u.e = 0; return true; } return false; }
        tile_of(L, nM, nN, u.pm, u.pn); u.e = 0; return true;
    }
    __device__ __forceinline__ int arow(const Unit& u, int r) const { return u.pm * BM + r; }
    __device__ __forceinline__ const char* abase(const Unit&) const { return A; }
    __device__ __forceinline__ const char* bbase(const Unit& u) const { return Bt + (size_t)u.pn * BM * K * 2; }
};
struct MoeSched {
    const char* A; const char* Bt; int K; const int* rowlist; const int* tile_e; int nN; size_t bstride; int nunits, G, c;
    __device__ __forceinline__ bool next(int i, Unit& u) const {
        const int L = i * G + c; if (L >= nunits) return false;
        const int q = nunits / NXCD, r = nunits % NXCD, xcd = L % NXCD, off = L / NXCD;
        const int wgid = (xcd < r ? xcd * (q + 1) : r * (q + 1) + (xcd - r) * q) + off;
        u.pm = wgid / nN; u.pn = wgid % nN;
        u.e = __builtin_amdgcn_readfirstlane((int)__hip_atomic_load((const unsigned*)tile_e + u.pm, RLX_AGENT));
        return true;
    }
    __device__ __forceinline__ int arow(const Unit& u, int r) const { return rowlist ? rowlist[u.pm * BM + r] : u.pm * BM + r; }
    __device__ __forceinline__ const char* abase(const Unit&) const { return A; }
    __device__ __forceinline__ const char* bbase(const Unit& u) const { return Bt + (size_t)u.e * bstride + (size_t)u.pn * BM * K * 2; }
};

struct MoeTabSched {
    const char* A; const char* Bt; int K; const LAS int* lut; size_t bstride; int nunits, G, c;
    __device__ __forceinline__ bool next(int i, Unit& u) const {
        if (i * G + c >= nunits) return false;
        const int v = __builtin_amdgcn_readfirstlane(lut[i]);
        u.pm = v & 0xffff; u.pn = (v >> 16) & 0xff; u.e = (v >> 24) & 0xff; return true;
    }
    __device__ __forceinline__ int arow(const Unit& u, int r) const { return u.pm * BM + r; }
    __device__ __forceinline__ const char* abase(const Unit&) const { return A; }
    __device__ __forceinline__ const char* bbase(const Unit& u) const { return Bt + (size_t)u.e * bstride + (size_t)u.pn * BM * K * 2; }
};
__device__ __forceinline__ int xcd_remap(int L, int nunits) { const int q = nunits / NXCD, r = nunits % NXCD, xcd = L % NXCD, off = L / NXCD; return (xcd < r ? xcd * (q + 1) : r * (q + 1) + (xcd - r) * q) + off; }

typedef int v8i __attribute__((ext_vector_type(8)));
typedef int v4i __attribute__((ext_vector_type(4)));
template <class E, class = void> struct epi_wide { static constexpr int v = 0; };
template <class E> struct epi_wide<E, decltype((void)E::WIDE)> { static constexpr int v = E::WIDE; };
template <bool FP8> struct Frag;
template <> struct Frag<false> { bf16x8 bh[2]; };
template <> struct Frag<true> { v8i q; };
template <class Epi, class Sched, bool FP8 = false>
__device__ __forceinline__ void gemm_phase(LAS unsigned char* lds, const int tid, const int K, const int lda, const Sched& S, const Epi& E) {
    const int wid = __builtin_amdgcn_readfirstlane(tid >> 6), lane = tid & 63, wr = wid >> 2, wc = wid & 3, fr = lane & 15, fq = lane >> 4;
    int nt = K / BK; asm volatile("" : "+s"(nt));
    int sc1 = 0x7f7f7f7f, scw = 0x79797979; asm volatile("" : "+v"(sc1), "+v"(scw));
    int Rr[2]; unsigned Cb[2], voffB[2];
    constexpr int WIDE = epi_wide<Epi>::v;
#pragma unroll
    for (int i = 0; i < 2; ++i) { int R, C; stage_rc(tid * 16 + i * 8192, R, C);
        const int Rb = WIDE == 1 ? (64 * (R >> 5) + 16 * ((R >> 2) & 3) + 4 * ((R >> 4) & 1) + (R & 3)) : WIDE == 2 ? (64 * (R >> 5) + 8 * ((R >> 2) & 3) + 4 * ((R >> 4) & 1) + (R & 3))
                     : Epi::PERM ? ((R & ~31) + perm32(R & 31)) : R;
        Rr[i] = R; Cb[i] = (unsigned)C * 2u; voffB[i] = (unsigned)(Rb * K + C) * 2u; }
    const unsigned lda2 = (unsigned)lda * 2u;
    const size_t kstep = (size_t)(BK * 2);
    const size_t hstepB = (size_t)(WIDE == 1 ? 8 : WIDE == 2 ? 32 : HALF) * K * 2;
    const unsigned ldsw = (unsigned)wid * 1024u;
    const int aoff = lds_byte(wr * 64 + fr, fq * 8), boff = lds_byte(wc * 32 + fr, fq * 8);
    const LAS unsigned char* pA = lds + aoff; const LAS unsigned char* pB = lds + 65536 + boff;
#define PG8_SA(b, h) (((b) * 2 + (h)) * HTB)
#define PG8_SB(b, h) ((4 + (b) * 2 + (h)) * HTB)
#define PG8_STAGE(bufoff, gbase, voff) do { _Pragma("unroll") for (int _i = 0; _i < 2; ++_i) \
        __builtin_amdgcn_global_load_lds((const unsigned*)((const char*)(gbase) + (voff)[_i]), (LAS unsigned*)(lds + (bufoff) + ldsw + _i * 8192), 16, 0, 0); } while (0)
#define PG8_LD32(p, off) __builtin_shufflevector(*(const LAS v4i*)((p) + (off)), *(const LAS v4i*)((p) + (off) + 1024), 0, 1, 2, 3, 4, 5, 6, 7)
#define PG8_LDA(dst, b, h) do { _Pragma("unroll") for (int m = 0; m < 4; ++m) { if constexpr (FP8) dst[m].q = PG8_LD32(pA, PG8_SA(b, h) + m * 2048); \
        else { dst[m].bh[0] = *(const LAS bf16x8*)(pA + PG8_SA(b, h) + m * 2048); dst[m].bh[1] = *(const LAS bf16x8*)(pA + PG8_SA(b, h) + m * 2048 + 1024); } } } while (0)
#define PG8_LDB(dst, b, h) do { _Pragma("unroll") for (int n = 0; n < 2; ++n) { if constexpr (FP8) dst[n].q = PG8_LD32(pB, PG8_SB(b, h) - 65536 + n * 2048); \
        else { dst[n].bh[0] = *(const LAS bf16x8*)(pB + PG8_SB(b, h) - 65536 + n * 2048); dst[n].bh[1] = *(const LAS bf16x8*)(pB + PG8_SB(b, h) - 65536 + n * 2048 + 1024); } } } while (0)
#define PG8_MMA(ai, bj, At, Bt) do { __builtin_amdgcn_s_setprio(1); _Pragma("unroll") for (int m = 0; m < 4; ++m) _Pragma("unroll") for (int n = 0; n < 2; ++n) { \
        if constexpr (FP8) asm volatile("v_mfma_scale_f32_16x16x128_f8f6f4 %0, %1, %2, %0, %3, %4 op_sel_hi:[0,0,0]" : "+v"(acc[ai][bj][m][n]) : "v"(Bt[n].q), "v"(At[m].q), "v"(scw), "v"(sc1)); \
        else { acc[ai][bj][m][n] = __builtin_amdgcn_mfma_f32_16x16x32_bf16(Bt[n].bh[0], At[m].bh[0], acc[ai][bj][m][n], 0, 0, 0); acc[ai][bj][m][n] = __builtin_amdgcn_mfma_f32_16x16x32_bf16(Bt[n].bh[1], At[m].bh[1], acc[ai][bj][m][n], 0, 0, 0); } } \
        __builtin_amdgcn_s_setprio(0); } while (0)
#define PG8_MMAZ(ai, bj, At, Bt) do { __builtin_amdgcn_s_setprio(1); _Pragma("unroll") for (int m = 0; m < 4; ++m) _Pragma("unroll") for (int n = 0; n < 2; ++n) \
        asm volatile("v_mfma_scale_f32_16x16x128_f8f6f4 %0, %1, %2, 0, %3, %4 op_sel_hi:[0,0,0]" : "+v"(acc[ai][bj][m][n]) : "v"(Bt[n].q), "v"(At[m].q), "v"(scw), "v"(sc1)); \
        __builtin_amdgcn_s_setprio(0); } while (0)
#define PG8_WAIT_V(n) asm volatile("s_waitcnt vmcnt(" #n ")" ::: "memory")
#define PG8_WAIT_V8E(c) do { if (Epi::NST > 0 && (c)) asm volatile("s_waitcnt vmcnt(%0)" :: "n"(8 + Epi::NST) : "memory"); else PG8_WAIT_V(8); } while (0)
#define PG8_WAIT_L(n) asm volatile("s_waitcnt lgkmcnt(" #n ")" ::: "memory")
#define PG8_BAR __builtin_amdgcn_s_barrier()
#define PG8_SCHED __builtin_amdgcn_sched_barrier(0)
    Unit cur, nxt; int ui = 0;
    if (!S.next(0, cur)) return;
    f32x4 acc[2][2][4][2];
#pragma unroll
    for (int a = 0; a < 2; ++a)
#pragma unroll
        for (int b = 0; b < 2; ++b)
#pragma unroll
            for (int m = 0; m < 4; ++m)
#pragma unroll
                for (int n = 0; n < 2; ++n) acc[a][b][m][n] = (f32x4){0.f, 0.f, 0.f, 0.f};
    Frag<FP8> At[4], B0[2], B1[2];
    const char* cA = S.abase(cur); const char* cB = S.bbase(cur);
    unsigned ofA0[2], ofA1[2];
#pragma unroll
    for (int i = 0; i < 2; ++i) { ofA0[i] = (unsigned)S.arow(cur, Rr[i]) * lda2 + Cb[i]; ofA1[i] = (unsigned)S.arow(cur, HALF + Rr[i]) * lda2 + Cb[i]; }
    PG8_STAGE(PG8_SB(0, 0), cB, voffB); PG8_STAGE(PG8_SB(0, 1), cB + hstepB, voffB); PG8_STAGE(PG8_SA(0, 0), cA, ofA0); PG8_STAGE(PG8_SA(0, 1), cA, ofA1);
    if (wr == 1) PG8_BAR;
    PG8_WAIT_V(2); PG8_BAR;
    PG8_STAGE(PG8_SB(1, 0), cB + kstep, voffB); PG8_STAGE(PG8_SA(1, 0), cA + kstep, ofA0); PG8_STAGE(PG8_SB(1, 1), cB + hstepB + kstep, voffB);
    PG8_WAIT_V(6); PG8_BAR;
    for (;;) {
        const bool has_next = S.next(ui + 1, nxt);
        const char* nA = has_next ? S.abase(nxt) : cA; const char* nB = has_next ? S.bbase(nxt) : cB;
        unsigned ofN0[2], ofN1[2];
#pragma unroll
        for (int i = 0; i < 2; ++i) { ofN0[i] = has_next ? (unsigned)S.arow(nxt, Rr[i]) * lda2 + Cb[i] : ofA0[i]; ofN1[i] = has_next ? (unsigned)S.arow(nxt, HALF + Rr[i]) * lda2 + Cb[i] : ofA1[i]; }
        for (int t = 0; t < nt; t += 2) {
            const bool last = (t == nt - 2);
            const char* a1 = cA + (size_t)(t + 1) * kstep;
            const char* a2 = last ? nA : cA + (size_t)(t + 2) * kstep; const char* b2 = last ? nB : cB + (size_t)(t + 2) * kstep;
            const char* a3 = a2 + kstep; const char* b3 = b2 + kstep;
            unsigned o20[2], o21[2];
#pragma unroll
            for (int i = 0; i < 2; ++i) { o20[i] = last ? ofN0[i] : ofA0[i]; o21[i] = last ? ofN1[i] : ofA1[i]; }
            const bool after_epi = (t == 0) && (ui > 0);
            PG8_LDB(B0, 0, 0); PG8_LDB(B1, 0, 1); PG8_SCHED; PG8_LDA(At, 0, 0); PG8_STAGE(PG8_SA(1, 1), a1, ofA1);
            PG8_WAIT_V8E(after_epi); PG8_WAIT_L(0); PG8_BAR;
            if constexpr (FP8) { if (t == 0) { PG8_MMAZ(0, 0, At, B0); PG8_MMAZ(0, 1, At, B1); } else { PG8_MMA(0, 0, At, B0); PG8_MMA(0, 1, At, B1); } } else { PG8_MMA(0, 0, At, B0); PG8_MMA(0, 1, At, B1); }
            PG8_BAR; PG8_SCHED;
            PG8_LDA(At, 0, 1); PG8_STAGE(PG8_SB(0, 0), b2, voffB); PG8_STAGE(PG8_SB(0, 1), b2 + hstepB, voffB); PG8_STAGE(PG8_SA(0, 0), a2, o20);
            PG8_WAIT_V8E(after_epi); PG8_WAIT_L(0); PG8_BAR;
            if constexpr (FP8) { if (t == 0) { PG8_MMAZ(1, 0, At, B0); PG8_MMAZ(1, 1, At, B1); } else { PG8_MMA(1, 0, At, B0); PG8_MMA(1, 1, At, B1); } } else { PG8_MMA(1, 0, At, B0); PG8_MMA(1, 1, At, B1); }
            PG8_BAR; PG8_SCHED;
            PG8_LDB(B0, 1, 0); PG8_LDB(B1, 1, 1); PG8_SCHED; PG8_LDA(At, 1, 0); PG8_STAGE(PG8_SA(0, 1), a2, o21);
            PG8_WAIT_V(8); PG8_WAIT_L(0); PG8_BAR; PG8_MMA(0, 0, At, B0); PG8_MMA(0, 1, At, B1); PG8_BAR; PG8_SCHED;
            PG8_LDA(At, 1, 1); PG8_STAGE(PG8_SB(1, 0), b3, voffB); PG8_STAGE(PG8_SB(1, 1), b3 + hstepB, voffB); PG8_STAGE(PG8_SA(1, 0), a3, o20);
            PG8_WAIT_V(8); PG8_WAIT_L(0); PG8_BAR; PG8_MMA(1, 0, At, B0); PG8_MMA(1, 1, At, B1); PG8_BAR; PG8_SCHED;
        }
        if (wr == 0) PG8_BAR;
        if constexpr (FP8) asm volatile("s_nop 15\n\ts_nop 15" ::: "memory");
        E(acc, cur, wr, wc, fr, fq);
        if (!has_next) break;
        if constexpr (!FP8) {
#pragma unroll
        for (int a = 0; a < 2; ++a)
#pragma unroll
            for (int b = 0; b < 2; ++b)
#pragma unroll
                for (int m = 0; m < 4; ++m)
#pragma unroll
                    for (int n = 0; n < 2; ++n) acc[a][b][m][n] = (f32x4){0.f, 0.f, 0.f, 0.f};
        }
        cur = nxt; cA = nA; cB = nB; ++ui;
#pragma unroll
        for (int i = 0; i < 2; ++i) { ofA0[i] = ofN0[i]; ofA1[i] = ofN1[i]; }
        if (wr == 1) PG8_BAR;
    }
    PG8_WAIT_V(0);
    PG8_BAR;
#undef PG8_SA
#undef PG8_SB
#undef PG8_STAGE
#undef PG8_LDA
#undef PG8_LD32
#undef PG8_LDB
#undef PG8_MMA
#undef PG8_MMAZ
#undef PG8_WAIT_V
#undef PG8_WAIT_V8E
#undef PG8_WAIT_L
#undef PG8_BAR
#undef PG8_SCHED
}

#define EPI_LOOP_ROWS for (int ai = 0; ai < 2; ++ai) _Pragma("unroll") for (int m = 0; m < 4; ++m)
__device__ __forceinline__ u32x4 pack8(const f32x4& v0, const f32x4& v1) { u32x4 w; w.x = cvt_pk_bf16(v0[0], v0[1]); w.y = cvt_pk_bf16(v0[2], v0[3]); w.z = cvt_pk_bf16(v1[0], v1[1]); w.w = cvt_pk_bf16(v1[2], v1[3]); return w; }
__device__ __forceinline__ void unpack8(const u32x4& w, f32x4& v0, f32x4& v1) { v0 = (f32x4){bf_lo(w.x), bf_hi(w.x), bf_lo(w.y), bf_hi(w.y)}; v1 = (f32x4){bf_lo(w.z), bf_hi(w.z), bf_lo(w.w), bf_hi(w.w)}; }
__device__ __forceinline__ unsigned pack4_fp8(const f32x4& v) { int w = __builtin_amdgcn_cvt_pk_fp8_f32(v[0], v[1], 0, false); w = __builtin_amdgcn_cvt_pk_fp8_f32(v[2], v[3], w, true); return (unsigned)w; }
__device__ __forceinline__ f32x4 sig4(const f32x4& v) { return (f32x4){fast_sigmoid(v[0]), fast_sigmoid(v[1]), fast_sigmoid(v[2]), fast_sigmoid(v[3])}; }

struct EpiZ {
    static constexpr bool PERM = true; static constexpr int NST = 0;
    bf16_t *Kb, *Vb, *Ug;
    __device__ __forceinline__ void operator()(const f32x4 (&acc)[2][2][4][2], const Unit& u, int wr, int wc, int fr, int fq) const {
        const int pn = u.pn;
#pragma unroll
        EPI_LOOP_ROWS {
            const int r = u.pm * BM + ai * HALF + wr * 64 + m * 16 + fr;
            if (r < KVROWS) { const int sp = r < T_TOK ? r + NMETA : r - T_TOK;
#pragma unroll
              for (int bj = 0; bj < 2; ++bj) {
                const int cl = bj * HALF + wc * 32 + 8 * fq;
                const f32x4 v0 = acc[ai][bj][m][0], v1 = acc[ai][bj][m][1];
                if (pn == 0) *(u32x4*)(Kb + (size_t)sp * KVW + cl) = pack8(v0, v1);
                else if (pn == 1) { bf16_t* vp = Vb + (size_t)cl * KVROWS + sp;
#pragma unroll
                    for (int j = 0; j < 4; ++j) { vp[(size_t)j * KVROWS] = (bf16_t)f2bf(v0[j]); vp[(size_t)(4 + j) * KVROWS] = (bf16_t)f2bf(v1[j]); } }
                else { const int col = (pn - 2) * BM + cl;
                    *(u32x4*)(Ug + ((size_t)(col >> 4) * KVROWS + sp) * 16 + (col & 15)) = pack8(v0, v1); }
              } }
        }
    }
};
struct EpiGate {
    static constexpr bool PERM = true; static constexpr int NST = 0; static constexpr int WIDE = 2;
    bf16_t *Q, *Ga, *Gs;
    __device__ __forceinline__ void operator()(const f32x4 (&acc)[2][2][4][2], const Unit& u, int wr, int wc, int fr, int fq) const {
        const int row0 = u.pm * BM + wr * 64 + fr, cl = wc * 64 + 8 * fq;
        if (u.pn < 8) {
            bf16_t* base = Q + (size_t)row0 * AW + u.pn * BM + cl;
#pragma unroll
            EPI_LOOP_ROWS {
#pragma unroll
                for (int bj = 0; bj < 2; ++bj) *(u32x4*)(base + (size_t)(ai * HALF + m * 16) * AW + bj * 32) = pack8(acc[ai][bj][m][0] * QSCALE, acc[ai][bj][m][1] * QSCALE); }
        } else {
            bf16_t* base = (u.pn < 24 ? Ga : Gs) + (size_t)row0 * DM + ((u.pn - 8) & 15) * BM + cl;
#pragma unroll
            EPI_LOOP_ROWS {
#pragma unroll
                for (int bj = 0; bj < 2; ++bj) __builtin_nontemporal_store(pack8(sig4(acc[ai][bj][m][0]), sig4(acc[ai][bj][m][1])), (u32x4*)(base + (size_t)(ai * HALF + m * 16) * DM + bj * 32)); }
        }
    }
};
struct EpiGlu {
    static constexpr bool PERM = true; static constexpr int NST = 0;
    const bf16_t* Y1; unsigned char* Y2;
    __device__ __forceinline__ void operator()(const f32x4 (&acc)[2][2][4][2], const Unit& u, int wr, int wc, int fr, int fq) const {
#pragma unroll
        EPI_LOOP_ROWS { const size_t r = (size_t)u.pm * BM + ai * HALF + wr * 64 + m * 16 + fr;
#pragma unroll
            for (int bj = 0; bj < 2; ++bj) { const size_t off = r * SW + u.pn * BM + bj * HALF + wc * 32 + 8 * fq;
                f32x4 y0, y1; unpack8(*(const u32x4*)(Y1 + off), y0, y1);
                *(u32x2*)(Y2 + off) = (u32x2){pack4_fp8(y0 * sig4(acc[ai][bj][m][0])), pack4_fp8(y1 * sig4(acc[ai][bj][m][1]))}; } }
    }
};
template <bool ADD> struct EpiMix {
    static constexpr bool PERM = true; static constexpr int NST = 0; static constexpr int WIDE = ADD ? 1 : 2;
    const bf16_t* Gt; bf16_t* Mix; unsigned char* MixQ;
    __device__ __forceinline__ void operator()(const f32x4 (&acc)[2][2][4][2], const Unit& u, int wr, int wc, int fr, int fq) const {
#pragma unroll
        EPI_LOOP_ROWS { const size_t r = (size_t)u.pm * BM + ai * HALF + wr * 64 + m * 16 + fr;
            const size_t off0 = r * DM + u.pn * BM + wc * 64 + (ADD ? 16 : 8) * fq; unsigned q[4];
#pragma unroll
            for (int bj = 0; bj < 2; ++bj) { const size_t off = off0 + bj * (ADD ? 8 : 32);
                f32x4 g0, g1; unpack8(*(const u32x4*)(Gt + off), g0, g1);
                f32x4 o0 = g0 * acc[ai][bj][m][0], o1 = g1 * acc[ai][bj][m][1];
                if (ADD) { f32x4 p0, p1; unpack8(*(const u32x4*)(Mix + off), p0, p1); o0 += p0; o1 += p1; q[2 * bj] = pack4_fp8(o0); q[2 * bj + 1] = pack4_fp8(o1); }
                else *(u32x4*)(Mix + off) = pack8(o0, o1); }
            if (ADD) *(u32x4*)(MixQ + off0) = (u32x4){q[0], q[1], q[2], q[3]};
        }
    }
};
struct EpiWout {
    static constexpr bool PERM = true; static constexpr int NST = 0; static constexpr int WIDE = 2;
    bf16_t* Out;
    __device__ __forceinline__ void operator()(const f32x4 (&acc)[2][2][4][2], const Unit& u, int wr, int wc, int fr, int fq) const {
        const int col0 = u.pn * BM + wc * 64 + 8 * fq;
#pragma unroll
        EPI_LOOP_ROWS { const size_t r = (size_t)u.pm * BM + ai * HALF + wr * 64 + m * 16 + fr; const size_t off = r * DM + col0;
#pragma unroll
            for (int bj = 0; bj < 2; ++bj) *(u32x4*)(Out + off + bj * 32) = pack8(acc[ai][bj][m][0], acc[ai][bj][m][1]); }
    }
};
struct EpiS13R {
    static constexpr bool PERM = true; static constexpr int NST = 0;
    bf16_t* ActS; float* Logits;
    __device__ __forceinline__ void operator()(const f32x4 (&acc)[2][2][4][2], const Unit& u, int wr, int wc, int fr, int fq) const {
#pragma unroll
        EPI_LOOP_ROWS { const size_t r = (size_t)u.pm * BM + ai * HALF + wr * 64 + m * 16 + fr; const int cl = wc * 32 + 8 * fq;
            if (u.pn < 4) { const f32x4 a0 = acc[ai][0][m][0], a1 = acc[ai][0][m][1];
                *(u32x4*)(ActS + r * EDIM + u.pn * HALF + cl) = pack8(a0 * sig4(a0) * acc[ai][1][m][0], a1 * sig4(a1) * acc[ai][1][m][1]); }
            else { *(f32x4*)(Logits + r * 128 + cl) = acc[ai][0][m][0]; *(f32x4*)(Logits + r * 128 + cl + 4) = acc[ai][0][m][1]; } }
    }
};
constexpr float WQ_SCALE = 64.f, WQ_INV = 1.f / 64.f;
struct EpiAct {
    static constexpr bool PERM = true; static constexpr int NST = 0;
    unsigned char* Act;
    __device__ __forceinline__ void operator()(const f32x4 (&acc)[2][2][4][2], const Unit& u, int wr, int wc, int fr, int fq) const {
#pragma unroll
        EPI_LOOP_ROWS { const size_t r = (size_t)u.pm * BM + ai * HALF + wr * 64 + m * 16 + fr; const int cl = wc * 32 + 8 * fq;
            const f32x4 a0 = acc[ai][0][m][0], a1 = acc[ai][0][m][1];
            *(u32x2*)(Act + r * EDIM + u.pn * HALF + cl) = (u32x2){pack4_fp8(a0 * sig4(a0) * acc[ai][1][m][0]), pack4_fp8(a1 * sig4(a1) * acc[ai][1][m][1])}; }
    }
};
struct EpiS2 {
    static constexpr bool PERM = true; static constexpr int NST = 0; static constexpr int WIDE = 2;
    bf16_t* H;
    __device__ __forceinline__ void operator()(const f32x4 (&acc)[2][2][4][2], const Unit& u, int wr, int wc, int fr, int fq) const {
#pragma unroll
        EPI_LOOP_ROWS { const size_t r = (size_t)u.pm * BM + ai * HALF + wr * 64 + m * 16 + fr;
#pragma unroll
            for (int bj = 0; bj < 2; ++bj) { bf16_t* p = H + r * DM + u.pn * BM + bj * 32 + wc * 64 + 8 * fq; f32x4 h0, h1; unpack8(*(const u32x4*)p, h0, h1);
                *(u32x4*)p = pack8(h0 * ALPHA + acc[ai][bj][m][0], h1 * ALPHA + acc[ai][bj][m][1]); } }
    }
};
struct EpiY {
    static constexpr bool PERM = true; static constexpr int NST = 8; static constexpr int WIDE = 1;
    unsigned char* Y;
    __device__ __forceinline__ void operator()(const f32x4 (&acc)[2][2][4][2], const Unit& u, int wr, int wc, int fr, int fq) const {
#pragma unroll
        EPI_LOOP_ROWS { const size_t r = (size_t)u.pm * BM + ai * HALF + wr * 64 + m * 16 + fr;
            *(u32x4*)(Y + r * DM + u.pn * BM + wc * 64 + 16 * fq) = (u32x4){pack4_fp8(acc[ai][0][m][0]), pack4_fp8(acc[ai][0][m][1]), pack4_fp8(acc[ai][1][m][0]), pack4_fp8(acc[ai][1][m][1])}; }
    }
};
}

struct Frame {
    LAS unsigned char* lds; gu32* ctl; unsigned char* ws;
    int tid, lane, wave, G, c;
    const float* const* in; float* out;
};
#define WSP(T, off) ((T*)(F.ws + (off)))

struct CvtRegs { f32x4 v[16]; };
__device__ __forceinline__ void cvt_load(CvtRegs& R, const float* __restrict__ W, size_t ldw, int k0, int n0, int lane) {
    const float* src = W + (size_t)(k0 + 2 * (lane >> 4)) * ldw + n0 + 4 * (lane & 15);
#pragma unroll
    for (int ip = 0; ip < 8; ++ip) { R.v[2 * ip] = __builtin_nontemporal_load((const f32x4*)(src + (size_t)(8 * ip) * ldw)); R.v[2 * ip + 1] = __builtin_nontemporal_load((const f32x4*)(src + (size_t)(8 * ip + 1) * ldw)); }
}
template <bool LO>
__device__ __forceinline__ void cvt_store(const CvtRegs& R, int k0, bf16_t* Wt, size_t dpitch, size_t drow0, LAS unsigned* scr, int lane) {
    const int kq = lane >> 4, n4 = 4 * (lane & 15);
#pragma unroll
    for (int ip = 0; ip < 8; ++ip) { f32x4 a = R.v[2 * ip], b = R.v[2 * ip + 1];
        if (LO) {
#pragma unroll
            for (int j = 0; j < 4; ++j) { a[j] -= __builtin_bit_cast(float, f2bf(a[j]) << 16); b[j] -= __builtin_bit_cast(float, f2bf(b[j]) << 16); } }
#pragma unroll
        for (int j = 0; j < 4; ++j) scr[(n4 + j) * 33 + 4 * ip + kq] = pk2(a[j], b[j]); }
    LDS_WAIT();
    const int c = lane & 7;
#pragma unroll
    for (int j = 0; j < 8; ++j) { const int n = (lane >> 3) + 8 * j; const LAS unsigned* s = scr + n * 33 + 4 * c;
        u32x4 o; o.x = s[0]; o.y = s[1]; o.z = s[2]; o.w = s[3];
        __builtin_nontemporal_store(o, (u32x4*)(Wt + (drow0 + n) * dpitch + k0 + 8 * c)); }
    LDS_WAIT();
}
template <bool LO>
__device__ __forceinline__ void cvt_tile(const float* __restrict__ W, size_t ldw, int k0, int n0, bf16_t* Wt, size_t dpitch, size_t drow0, LAS unsigned* scr, int lane) {
    CvtRegs R; cvt_load(R, W, ldw, k0, n0, lane); cvt_store<LO>(R, k0, Wt, dpitch, drow0, scr, lane);
}
__device__ __forceinline__ void cvt_load8(CvtRegs& R, const float* __restrict__ W, size_t ldw, int k0, int n0, int lane) {
    const float* src = W + (size_t)(k0 + 4 * (lane >> 3)) * ldw + n0 + 4 * (lane & 7);
#pragma unroll
    for (int ip = 0; ip < 4; ++ip)
#pragma unroll
        for (int b = 0; b < 4; ++b) R.v[4 * ip + b] = __builtin_nontemporal_load((const f32x4*)(src + (size_t)(32 * ip + b) * ldw));
}
__device__ __forceinline__ void cvt_store8(const CvtRegs& R, int k0, unsigned char* Wt, size_t dpitch, size_t drow0, float scale, LAS unsigned* scr, int lane, bool nt = true) {
    const int kr = lane >> 3, n4 = 4 * (lane & 7);
#pragma unroll
    for (int ip = 0; ip < 4; ++ip)
#pragma unroll
        for (int j = 0; j < 4; ++j) { int w = __builtin_amdgcn_cvt_pk_fp8_f32(R.v[4 * ip][j] * scale, R.v[4 * ip + 1][j] * scale, 0, false); w = __builtin_amdgcn_cvt_pk_fp8_f32(R.v[4 * ip + 2][j] * scale, R.v[4 * ip + 3][j] * scale, w, true);
            scr[(n4 + j) * 33 + 8 * ip + kr] = (unsigned)w; }
    LDS_WAIT();
    const int c = lane & 7;
#pragma unroll
    for (int j = 0; j < 4; ++j) { const int n = (lane >> 3) + 8 * j; const LAS unsigned* sp = scr + n * 33 + 4 * c;
        u32x4 o; o.x = sp[0]; o.y = sp[1]; o.z = sp[2]; o.w = sp[3];
        if (nt) __builtin_nontemporal_store(o, (u32x4*)(Wt + (drow0 + n) * dpitch + k0 + 16 * c)); else *(u32x4*)(Wt + (drow0 + n) * dpitch + k0 + 16 * c) = o; }
    LDS_WAIT();
}
struct CvtJob { const float* W; void* Wt; int K, N, mode, nmat; size_t wstride, dstride; int fp8; int ldw; };
__device__ __forceinline__ int cvt_job_tiles(const CvtJob& j) { return j.nmat * (j.K / 64) * (j.N / 64); }
struct CvtTile { const float* W; void* Wt; size_t ldw, dpitch, drow0; int k0, n0; };
__device__ __forceinline__ CvtTile cvt_job_tile(const CvtJob& j, int it) {
    const int tn = j.fp8 ? 32 : 64, tk = j.fp8 ? 128 : 64;
    const int nnb = j.N / tn, per = (j.K / tk) * nnb, mat = it / per, r = it % per, kb = r / nnb, nb = r % nnb, n0 = nb * tn;
    const size_t drow0 = j.mode == 0 ? (size_t)n0 : (size_t)(n0 >> 7) * 256 + (j.mode - 1) * 128 + (n0 & 127);
    void* wt = j.fp8 ? (void*)((unsigned char*)j.Wt + (size_t)mat * j.dstride) : (void*)((bf16_t*)j.Wt + (size_t)mat * j.dstride);
    return CvtTile{j.W + (size_t)mat * j.wstride, wt, (size_t)(j.ldw ? j.ldw : j.N), (size_t)j.K, drow0, kb * tk, n0};
}
__device__ __forceinline__ void ln_row(const float* xrow, const LAS f32x4* g, const LAS f32x4* b, int lane, f32x4 (&v)[16], float& mean, float& rstd) {
    const f32x4* xr = (const f32x4*)xrow + lane; float s = 0.f;
#pragma unroll
    for (int j = 0; j < 16; ++j) { v[j] = __builtin_nontemporal_load(xr + 64 * j); s += (v[j][0] + v[j][1]) + (v[j][2] + v[j][3]); }
    mean = wave_sum(s) * (1.f / DM); float s2 = 0.f;
#pragma unroll
    for (int j = 0; j < 16; ++j) { v[j] = v[j] - mean; s2 += (v[j][0] * v[j][0] + v[j][1] * v[j][1]) + (v[j][2] * v[j][2] + v[j][3] * v[j][3]); }
    rstd = 1.f / sqrtf(wave_sum(s2) * (1.f / DM) + LN_EPS);
    asm volatile("" ::: "memory");
#pragma unroll
    for (int j = 0; j < 16; ++j) { const f32x4 gg = g[lane + 64 * j], bb = b[lane + 64 * j]; v[j] = v[j] * rstd * gg + bb; }
}

__device__ __forceinline__ void cvt_run(const Frame& F, int j0, int j1, int gw, int NGW, LAS unsigned* scr, int tlo = 0, int thi = 0x7fffffff) {
    int done = 0;
#pragma unroll 1
    for (int jn = j0; jn < j1; ++jn) {
        CvtJob j;
        switch (jn) {
            case 0: j = CvtJob{F.in[4] + 2048, WSP(unsigned char, WS_WING) + (size_t)10240 * DM, DM, 1536, 0, 1, 0, 0, 1, NZ}; break;
            case 11: j = CvtJob{F.in[4] + 3584, WSP(unsigned char, WS_WING) + (size_t)2048 * DM, DM, 2 * DM, 0, 1, 0, 0, 1, NZ}; break;
            case 12: j = CvtJob{F.in[4], WSP(unsigned char, WS_WING), DM, 2048, 0, 1, 0, 0, 1, NZ}; break;
            case 1: j = CvtJob{F.in[6], WSP(unsigned char, WS_WAO), AW, DM, 0, 1, 0, 0, 1, 0}; break;
            case 2: j = CvtJob{F.in[15], WSP(bf16_t, WS_WGLU), SW, SW, 0, 1, 0, 0, 0, 0}; break;
            case 3: j = CvtJob{F.in[16], WSP(unsigned char, WS_WSO), SW, DM, 0, 1, 0, 0, 1, 0}; break;
            case 4: j = CvtJob{F.in[17], WSP(unsigned char, WS_WOUT), DM, DM, 0, 1, 0, 0, 1, 0}; break;
            case 5: j = CvtJob{F.in[25], WSP(bf16_t, WS_WS13), DM, EDIM, 1, 1, 0, 0, 0, 0}; break;
            case 6: j = CvtJob{F.in[26], WSP(bf16_t, WS_WS13), DM, EDIM, 2, 1, 0, 0, 0, 0}; break;
            case 7: j = CvtJob{F.in[27], WSP(bf16_t, WS_WS2), EDIM, DM, 0, 1, 0, 0, 0, 0}; break;
            case 8: j = CvtJob{F.in[22], WSP(unsigned char, WS_WE13), DM, EDIM, 1, NE, (size_t)DM * EDIM, (size_t)1024 * DM, 1, 0}; break;
            case 9: j = CvtJob{F.in[23], WSP(unsigned char, WS_WE13), DM, EDIM, 2, NE, (size_t)DM * EDIM, (size_t)1024 * DM, 1, 0}; break;
            default: j = CvtJob{F.in[24], WSP(unsigned char, WS_WE2), EDIM, DM, 0, NE, (size_t)EDIM * DM, (size_t)DM * EDIM, 1, 0}; break;
        }
        const int nt0 = cvt_job_tiles(j);
        const int nt = (thi - done) < nt0 ? (thi - done) : nt0;
        int it = (tlo - done) > 0 ? (tlo - done) : 0;
        { const int gfirst = done + it; const int r = (gw - (gfirst - tlo) % NGW + NGW) % NGW; it += r; }
        if (it < nt) {
            CvtTile tc = cvt_job_tile(j, it); CvtRegs Ra;
            if (j.fp8) cvt_load8(Ra, tc.W, tc.ldw, tc.k0, tc.n0, F.lane); else cvt_load(Ra, tc.W, tc.ldw, tc.k0, tc.n0, F.lane);
#pragma unroll 1
            for (;;) {
                const int itn = it + NGW; const bool more = itn < nt;
                CvtTile tn = tc; CvtRegs Rb;
                if (more) { tn = cvt_job_tile(j, itn); if (j.fp8) cvt_load8(Rb, tn.W, tn.ldw, tn.k0, tn.n0, F.lane); else cvt_load(Rb, tn.W, tn.ldw, tn.k0, tn.n0, F.lane); }
                if (j.fp8) cvt_store8(Ra, tc.k0, (unsigned char*)tc.Wt, tc.dpitch, tc.drow0, pg8::WQ_SCALE, scr, F.lane, j.ldw == 0); else cvt_store<false>(Ra, tc.k0, (bf16_t*)tc.Wt, tc.dpitch, tc.drow0, scr, F.lane);
                if (!more) break;
                Ra = Rb; tc = tn; it = itn;
            }
        }
        done += nt0;
    }
}
__device__ __forceinline__ void stage_gb(Frame& F, const float* g, const float* b) {
    __syncthreads();
    for (int i = F.tid; i < DM / 4; i += 512) { ((LAS f32x4*)F.lds)[i] = ((const f32x4*)g)[i]; ((LAS f32x4*)(F.lds + 16384))[i] = ((const f32x4*)b)[i]; }
    __syncthreads();
}
__device__ __forceinline__ void p0_prologue(Frame& F) {
    LAS unsigned* scr = (LAS unsigned*)(F.lds + 32768 + F.wave * 8704);
    const int gw = F.c * 8 + F.wave, NGW = F.G * 8;
    stage_gb(F, F.in[2], F.in[3]);
    { bf16_t* H0B = WSP(bf16_t, WS_H0B); f32x2* St0 = WSP(f32x2, WS_STATS0);
      for (int r = gw; r < ROWS_Z; r += NGW) {
          u32x2* o = (u32x2*)(H0B + (size_t)r * DM) + F.lane;
          if (r < KVROWS) { const float* src = r < T_TOK ? F.in[0] + (size_t)r * DM : F.in[1] + (size_t)(r - T_TOK) * DM;
              f32x4 v[16]; float mean, rstd; ln_row(src, (const LAS f32x4*)F.lds, (const LAS f32x4*)(F.lds + 16384), F.lane, v, mean, rstd);
              if (r < T_TOK && F.lane == 0) St0[r] = (f32x2){mean, rstd};
#pragma unroll
              for (int j = 0; j < 16; ++j) __builtin_nontemporal_store((u32x2){pk2(v[j][0], v[j][1]), pk2(v[j][2], v[j][3])}, o + 64 * j);
              { unsigned* oq = (unsigned*)(WSP(unsigned char, WS_H0Q) + (size_t)r * DM) + F.lane;
#pragma unroll
                  for (int j = 0; j < 16; ++j) oq[64 * j] = pg8::pack4_fp8(v[j]); }
          } else { unsigned* oq = (unsigned*)(WSP(unsigned char, WS_H0Q) + (size_t)r * DM) + F.lane;
#pragma unroll
              for (int j = 0; j < 16; ++j) { o[64 * j] = (u32x2){0u, 0u}; oq[64 * j] = 0u; }
          } } }
    cvt_run(F, 0, 8, gw, NGW, scr); cvt_run(F, 11, 13, gw, NGW, scr);
    { bf16_t* Wr = WSP(bf16_t, WS_WS13);
      for (int kb = gw; kb < DM / 64; kb += NGW) { cvt_tile<false>(F.in[20], NE, kb * 64, 0, Wr, DM, 1024, scr, F.lane); cvt_tile<true>(F.in[20], NE, kb * 64, 0, Wr, DM, 1088, scr, F.lane); }
      u32x4* z = (u32x4*)(Wr + (size_t)1152 * DM);
      for (int i = (F.c * 512 + F.tid); i < 128 * DM * 2 / 16; i += F.G * 512) z[i] = (u32x4){0u, 0u, 0u, 0u}; }
}

typedef float f32x16 __attribute__((ext_vector_type(16)));
constexpr int ATT_KP = 144, ATT_VP = 584, ATT_V_OFF = 288 * ATT_KP;
static_assert(ATT_V_OFF + 64 * ATT_VP <= RING_BYTES, "attention LDS");
__device__ __forceinline__ int att_src_pos(int key, int n) {
    if (key < 128) return n > 0 ? NMETA + 128 * (n - 1) + key : -1;
    if (key < 256) return NMETA + 128 * n + (key - 128);
    if (key < 272) return key - 256;
    return -1;
}
__device__ __forceinline__ void attn_unit(Frame& F, int n, int kh) {
    const bf16_t* Qb = WSP(bf16_t, WS_QB); const bf16_t* Kb = WSP(bf16_t, WS_KB); const bf16_t* Vt = WSP(bf16_t, WS_VB); unsigned char* At = WSP(unsigned char, WS_ATT);
    LAS unsigned char* Ks = F.lds; LAS unsigned char* Vs = F.lds + ATT_V_OFF;
    __syncthreads();
    for (int p = F.tid; p < 288 * 8; p += 512) { const int j = p >> 3, c8 = p & 7, sp = att_src_pos(j, n);
        u32x4 v = (u32x4){0u, 0u, 0u, 0u};
        if (sp >= 0) v = *(const u32x4*)(Kb + (size_t)sp * KVW + kh * 64 + c8 * 8);
        *(LAS u32x4*)(Ks + j * ATT_KP + c8 * 16) = v; }
    for (int p = F.tid; p < 64 * 36; p += 512) { const int d = p / 36, q = p % 36, sp = att_src_pos(q * 8, n);
        u32x4 v = (u32x4){0u, 0u, 0u, 0u};
        if (sp >= 0) v = *(const u32x4*)(Vt + (size_t)(kh * 64 + d) * KVROWS + sp);
        LAS u32x2* dst = (LAS u32x2*)(Vs + d * ATT_VP + q * 16); dst[0] = (u32x2){v.x, v.y}; dst[1] = (u32x2){v.z, v.w}; }
    __syncthreads();
    const int hq = kh * 8 + F.wave, r32 = F.lane & 31, hh = F.lane >> 5;
    const float sink2 = F.in[5][hq] * LOG2E;
    const bool prevok = n > 0;
#pragma unroll 1
    for (int qt = 0; qt < 4; ++qt) {
        const bf16_t* qrow = Qb + (size_t)(128 * n + 32 * qt + r32) * AW + hq * 64 + 8 * hh;
        bf16x8 qf[4];
#pragma unroll
        for (int t = 0; t < 4; ++t) qf[t] = *(const bf16x8*)(qrow + 16 * t);
        f32x16 sacc[6];
#pragma unroll
        for (int x = 0; x < 6; ++x) {
            const int kb = x < 4 - qt ? 32 * (qt + x) : (x < 5 ? 128 + 32 * (x - (4 - qt)) : 256);
            f32x16 acc;
#pragma unroll
            for (int i = 0; i < 16; ++i) acc[i] = 0.f;
#pragma unroll
            for (int t = 0; t < 4; ++t) { const bf16x8 kf = *(const LAS bf16x8*)(Ks + (kb + r32) * ATT_KP + (16 * t + 8 * hh) * 2); acc = __builtin_amdgcn_mfma_f32_32x32x16_bf16(kf, qf[t], acc, 0, 0, 0); }
#pragma unroll
            for (int i = 0; i < 16; ++i) { const int m = (i & 3) + 8 * (i >> 2) + 4 * hh;
                bool vis;
                if (x < 4 - qt) vis = prevok && (x > 0 || m > r32);
                else if (x < 5) vis = (x < 4) || (m <= r32);
                else vis = m < 16;
                acc[i] = vis ? acc[i] : -1e30f; }
            sacc[x] = acc;
        }
        float mx = sink2;
#pragma unroll
        for (int x = 0; x < 6; ++x)
#pragma unroll
            for (int i = 0; i < 16; ++i) mx = fmaxf(mx, sacc[x][i]);
        mx = fmaxf(mx, __shfl_xor(mx, 32));
        float l = 0.f;
#pragma unroll
        for (int x = 0; x < 6; ++x)
#pragma unroll
            for (int i = 0; i < 16; ++i) { const float p = __builtin_amdgcn_exp2f(sacc[x][i] - mx); sacc[x][i] = p; l += p; }
        l += __shfl_xor(l, 32); l += __builtin_amdgcn_exp2f(sink2 - mx);
        f32x16 oacc[2];
#pragma unroll
        for (int dt = 0; dt < 2; ++dt)
#pragma unroll
            for (int i = 0; i < 16; ++i) oacc[dt][i] = 0.f;
#pragma unroll
        for (int x = 0; x < 6; ++x) {
            const int kb = x < 4 - qt ? 32 * (qt + x) : (x < 5 ? 128 + 32 * (x - (4 - qt)) : 256);
#pragma unroll
            for (int t2 = 0; t2 < 2; ++t2) {
                u32x4 pw; pw.x = pg8::cvt_pk_bf16(sacc[x][8 * t2 + 0], sacc[x][8 * t2 + 1]); pw.y = pg8::cvt_pk_bf16(sacc[x][8 * t2 + 2], sacc[x][8 * t2 + 3]);
                pw.z = pg8::cvt_pk_bf16(sacc[x][8 * t2 + 4], sacc[x][8 * t2 + 5]); pw.w = pg8::cvt_pk_bf16(sacc[x][8 * t2 + 6], sacc[x][8 * t2 + 7]);
                const bf16x8 pf = __builtin_bit_cast(bf16x8, pw);
#pragma unroll
                for (int dt = 0; dt < 2; ++dt) { const LAS u32x2* vp = (const LAS u32x2*)(Vs + (32 * dt + r32) * ATT_VP + (kb + 16 * t2 + 4 * hh) * 2);
                    const u32x2 a = vp[0], b = vp[2]; u32x4 vw; vw.x = a.x; vw.y = a.y; vw.z = b.x; vw.w = b.y;
                    oacc[dt] = __builtin_amdgcn_mfma_f32_32x32x16_bf16(__builtin_bit_cast(bf16x8, vw), pf, oacc[dt], 0, 0, 0); }
            }
        }
        const float inv = 1.f / l;
        unsigned char* orow = At + (size_t)(128 * n + 32 * qt + r32) * AW + hq * 64 + 4 * hh;
#pragma unroll
        for (int dt = 0; dt < 2; ++dt)
#pragma unroll
            for (int g = 0; g < 4; ++g) *(unsigned*)(orow + 32 * dt + 8 * g) = pg8::pack4_fp8((f32x4){oacc[dt][4 * g] * inv, oacc[dt][4 * g + 1] * inv, oacc[dt][4 * g + 2] * inv, oacc[dt][4 * g + 3] * inv});
    }
}

constexpr int SSM_NCH = KVROWS / 8, SSM_NBLK = (SSM_NCH + 63) / 64, SSM_EP = 132, SSM_SP = 272, SSM_UP = 272;
constexpr int SSM_UB = 0  , SSM_EB = 3 * 64 * SSM_UP  , SSM_SB = SSM_EB + 2 * 64 * SSM_EP * 4  ;
constexpr int SSM_APOW = SSM_EB, SSM_BBAR = SSM_APOW + 4608, SSM_KD = SSM_BBAR + 8192;
static_assert(SSM_KD + 16384 <= SSM_SB && SSM_SB + 64 * SSM_SP <= LUT_OFF, "SSM LDS");
__device__ __forceinline__ bf16x8 pack_frag(const float (&v)[8]) { u32x4 w; w.x = pk2(v[0], v[1]); w.y = pk2(v[2], v[3]); w.z = pk2(v[4], v[5]); w.w = pk2(v[6], v[7]); return __builtin_bit_cast(bf16x8, w); }
__device__ __forceinline__ f32x2 gelu_pk(f32x2 v) {
    const f32x2 av = __builtin_elementwise_abs(v), d = av * 0.2316418882f + 1.0f;
    f32x2 t; t.x = __builtin_amdgcn_rcpf(d.x); t.y = __builtin_amdgcn_rcpf(d.y);
    f32x2 q = t * 0.5307027145f + (-0.7265760135f); q = q * t + 0.7107068705f; q = q * t + (-0.142248368f); q = q * t + 0.127414796f; q = q * t;
    const f32x2 sq = (v * v) * (-0.72134752044f);
    f32x2 e; e.x = __builtin_amdgcn_exp2f(sq.x); e.y = __builtin_amdgcn_exp2f(sq.y);
    const f32x2 m = v * (q * e), r = v - m;
    f32x2 o; o.x = v.x < 0.f ? m.x : r.x; o.y = v.y < 0.f ? m.y : r.y; return o;
}
__device__ __forceinline__ void ssm_unit(Frame& F, int g, int bfull, int bend) {
    const int tid = F.tid, lane = F.lane, w = F.wave, nl = lane & 15, kg = lane >> 4;
    LAS f32x2* apow = (LAS f32x2*)(F.lds + SSM_APOW);
    LAS f32x2* bbar = (LAS f32x2*)(F.lds + SSM_BBAR);
    LAS float* Kd = (LAS float*)(F.lds + SSM_KD);
    LAS f32x2* clds = (LAS f32x2*)(F.lds + SSM_KD + 8192);
    LAS float* eb = (LAS float*)(F.lds + SSM_EB);
    LAS unsigned char* sb = F.lds + SSM_SB;
    LAS unsigned char* ub = F.lds + SSM_UB;
    const float* Cre = F.in[12] + (size_t)g * 16 * 64; const float* Cim = F.in[13] + (size_t)g * 16 * 64;
    const bf16_t* Ub = WSP(bf16_t, WS_UG) + (size_t)g * KVROWS * 16;
    const int ur0 = tid >> 4, uc0 = tid & 15;
#define SSM_ULOAD(b, r0, r1) do { r0 = *(const u32x4*)(Ub + (size_t)(64 * (b) + ur0) * 128 + uc0 * 8); r1 = *(const u32x4*)(Ub + (size_t)(64 * (b) + 32 + ur0) * 128 + uc0 * 8); } while (0)
#define SSM_USTORE(b, r0, r1) do { LAS unsigned char* u_ = ub + ((b) % 3) * 64 * SSM_UP; *(LAS u32x4*)(u_ + ur0 * SSM_UP + uc0 * 16) = r0; *(LAS u32x4*)(u_ + (32 + ur0) * SSM_UP + uc0 * 16) = r1; } while (0)
    u32x4 ua0, ua1, ub0, ub1;
    __syncthreads();
    SSM_ULOAD(0, ua0, ua1); SSM_ULOAD(1, ub0, ub1);
    { const int p = tid & 63, d = tid >> 6; const float dt = expf(F.in[9][g]), lr = F.in[7][g * 64 + p], li = F.in[8][g * 64 + p];
      { const float mg = expf(d * dt * lr); float sn, cs; sincosf(d * dt * li, &sn, &cs); apow[d * 64 + p] = (f32x2){mg * cs, mg * sn}; }
      if (d == 0) { const float mg = expf(8.f * dt * lr); float sn, cs; sincosf(8.f * dt * li, &sn, &cs); apow[8 * 64 + p] = (f32x2){mg * cs, mg * sn}; }
      if (d == 1) {
        const float em1 = expm1f(dt * lr), th = dt * li; float sn, cs; sincosf(th, &sn, &cs);
        const float ai = (em1 + 1.f) * sn, sh = sinf(0.5f * th), num_re = em1 * cs - 2.f * sh * sh;
        const float den = lr * lr + li * li, cre = (num_re * lr + ai * li) / den, cim = (ai * lr - num_re * li) / den;
        const float* br = F.in[10] + (size_t)(g * 64 + p) * 16; const float* bi = F.in[11] + (size_t)(g * 64 + p) * 16;
#pragma unroll
        for (int h = 0; h < 16; ++h) bbar[p * 16 + h] = (f32x2){cre * br[h] - cim * bi[h], cre * bi[h] + cim * br[h]};
      }
      for (int i = tid; i < 1024; i += 512) clds[i] = (f32x2){Cre[i], Cim[i]};
    }
    SSM_USTORE(0, ua0, ua1); SSM_USTORE(1, ub0, ub1);
    __syncthreads();
    { const int d = tid >> 6, ho = (tid >> 2) & 15, hq = tid & 3; float k0 = 0.f, k1 = 0.f, k2 = 0.f, k3 = 0.f;
#pragma unroll 8
      for (int p = 0; p < 64; ++p) { const f32x2 cc = clds[ho * 64 + p]; const float cr = cc.x, ci = cc.y; const f32x2 a = apow[d * 64 + p]; const float wr = cr * a.x - ci * a.y, wi = cr * a.y + ci * a.x;
          const f32x2 b0 = bbar[p * 16 + 4 * hq], b1 = bbar[p * 16 + 4 * hq + 1], b2 = bbar[p * 16 + 4 * hq + 2], b3 = bbar[p * 16 + 4 * hq + 3];
          k0 += wr * b0.x - wi * b0.y; k1 += wr * b1.x - wi * b1.y; k2 += wr * b2.x - wi * b2.y; k3 += wr * b3.x - wi * b3.y; }
      *(LAS f32x4*)(Kd + (d * 16 + ho) * 16 + 4 * hq) = (f32x4){k0, k1, k2, k3}; }
    __syncthreads();
    bf16x8 bE[4], bT[4], bC[4];
    { const int p = (16 * w + nl) & 63; const bool im = w >= 4;
#pragma unroll
      for (int t = 0; t < 4; ++t) { const int j = 2 * t + (kg >> 1); const f32x2 a = apow[(7 - j) * 64 + p]; float v[8];
#pragma unroll
          for (int jj = 0; jj < 8; ++jj) { const f32x2 b = bbar[p * 16 + 8 * (kg & 1) + jj]; v[jj] = im ? (a.x * b.y + a.y * b.x) : (a.x * b.x - a.y * b.y); }
          bE[t] = pack_frag(v); } }
#pragma unroll
    for (int t = 0; t < 4; ++t) { const int j = 2 * t + (kg >> 1); float v[8];
#pragma unroll
        for (int jj = 0; jj < 8; ++jj) v[jj] = (j <= w) ? Kd[(((w - j) & 7) * 16 + nl) * 16 + 8 * (kg & 1) + jj] : 0.f;
        bT[t] = pack_frag(v); }
#pragma unroll
    for (int t = 0; t < 4; ++t) { float v[8];
#pragma unroll
        for (int jj = 0; jj < 8; ++jj) { const int p = 16 * t + 4 * kg + (jj >> 1); const f32x2 a = apow[(w + 1) * 64 + p]; const f32x2 cc = clds[nl * 64 + p]; const float cr = cc.x, ci = cc.y;
            v[jj] = (jj & 1) == 0 ? (cr * a.x - ci * a.y) : (-cr * a.y - ci * a.x); }
        bC[t] = pack_frag(v); }
    const f32x2 a8 = apow[8 * 64 + lane];
    const int ecol = 2 * ((16 * w + nl) & 63) + (w >> 2);
    bf16_t* Y1 = WSP(bf16_t, WS_Y1); const float dsk = F.in[14][g * 16 + nl];
#define SSM_UFRAG(b, mt, t) (*(const LAS bf16x8*)(ub + ((b) % 3) * 64 * SSM_UP + (16 * (mt) + nl) * SSM_UP + (32 * (t) + 8 * kg) * 2))
#define SSM_EGEMM(b) do { LAS float* e_ = eb + ((b) & 1) * 64 * SSM_EP; _Pragma("unroll") for (int mt = 0; mt < 4; ++mt) { f32x4 c_ = (f32x4){0.f, 0.f, 0.f, 0.f}; \
        _Pragma("unroll") for (int t = 0; t < 4; ++t) c_ = __builtin_amdgcn_mfma_f32_16x16x32_bf16(SSM_UFRAG(b, mt, t), bE[t], c_, 0, 0, 0); \
        _Pragma("unroll") for (int r = 0; r < 4; ++r) e_[(16 * mt + 4 * kg + r) * SSM_EP + ecol] = c_[r]; } } while (0)
    __syncthreads();
    SSM_EGEMM(0);
    f32x2 xs = (f32x2){0.f, 0.f};
    __syncthreads();
#pragma unroll 1
    for (int b = 0; b < bend; ++b) {
        const bool full = b >= bfull;
        if (b + 2 < bend) SSM_ULOAD(b + 2, ua0, ua1);
        if (w == 0) {
            const LAS f32x2* e_ = (const LAS f32x2*)(eb + (b & 1) * 64 * SSM_EP) + lane;
            const f32x2 aa = (f32x2){a8.x, a8.x}, ab = (f32x2){-a8.y, a8.y};
#pragma unroll
            for (int hf = 0; hf < 2; ++hf) { f32x2 ev[32];
#pragma unroll
                for (int c = 0; c < 32; ++c) ev[c] = e_[(32 * hf + c) * (SSM_EP / 2)];
#pragma unroll
                for (int c = 0; c < 32; ++c) { *(LAS unsigned*)(sb + (32 * hf + c) * SSM_SP + lane * 4) = pk2(xs.x, xs.y);
                    xs = aa * xs + (ab * (f32x2){xs.y, xs.x} + ev[c]); } }
        }
        f32x4 acc[4];
        if (full) {
#pragma unroll
            for (int mt = 0; mt < 4; ++mt) { acc[mt] = (f32x4){0.f, 0.f, 0.f, 0.f};
#pragma unroll
                for (int t = 0; t < 4; ++t) acc[mt] = __builtin_amdgcn_mfma_f32_16x16x32_bf16(SSM_UFRAG(b, mt, t), bT[t], acc[mt], 0, 0, 0); }
        }
        if (b + 1 < bend) SSM_EGEMM(b + 1);
        if (b + 2 < bend) SSM_USTORE(b + 2, ua0, ua1);
        __syncthreads();
        if (full) {
#pragma unroll
            for (int mt = 0; mt < 4; ++mt) {
#pragma unroll
                for (int t = 0; t < 4; ++t) { const bf16x8 sf = *(const LAS bf16x8*)(sb + (16 * mt + nl) * SSM_SP + (32 * t + 8 * kg) * 2); acc[mt] = __builtin_amdgcn_mfma_f32_16x16x32_bf16(sf, bC[t], acc[mt], 0, 0, 0); }
            }
            { const LAS unsigned char* u_ = ub + (b % 3) * 64 * SSM_UP;
#pragma unroll
              for (int mt = 0; mt < 4; ++mt)
#pragma unroll
                for (int r2 = 0; r2 < 2; ++r2) { const int row = 16 * mt + 4 * kg + 2 * r2, ch = 64 * b + row, pos = 8 * ch + w;
                    const float u0 = bf2f(*(const LAS bf16_t*)(u_ + row * SSM_UP + (w * 16 + nl) * 2)), u1 = bf2f(*(const LAS bf16_t*)(u_ + (row + 1) * SSM_UP + (w * 16 + nl) * 2));
                    const f32x2 ge = gelu_pk((f32x2){acc[mt][2 * r2] + dsk * u0, acc[mt][2 * r2 + 1] + dsk * u1});
                    if (ch < SSM_NCH && pos >= NMETA) Y1[(size_t)(pos - NMETA) * SW + g * 16 + nl] = (bf16_t)f2bf(ge.x);
                    if (ch + 1 < SSM_NCH && pos + 8 >= NMETA) Y1[(size_t)(pos + 8 - NMETA) * SW + g * 16 + nl] = (bf16_t)f2bf(ge.y); } }
            __syncthreads();
        }
    }
#undef SSM_ULOAD
#undef SSM_USTORE
#undef SSM_UFRAG
#undef SSM_EGEMM
}

__device__ __forceinline__ void ln1_pass(Frame& F) {
    const int gw = F.c * 8 + F.wave, NGW = F.G * 8;
    const bf16_t* H = WSP(bf16_t, WS_H1F); const bf16_t* H0 = WSP(bf16_t, WS_H0B); bf16_t* Hb = WSP(bf16_t, WS_H1B); unsigned char* Hq = WSP(unsigned char, WS_H1LO);
    stage_gb(F, F.in[18], F.in[19]);
    const LAS f32x4* gl = (const LAS f32x4*)F.lds; const LAS f32x4* bl = (const LAS f32x4*)(F.lds + 16384);
#pragma unroll 1
    for (int r = gw; r < T_TOK; r += NGW) {
        const u32x2* x = (const u32x2*)(H + (size_t)r * DM) + F.lane; const u32x2* x0 = (const u32x2*)(H0 + (size_t)r * DM) + F.lane;
        u32x2* ob = (u32x2*)(Hb + (size_t)r * DM) + F.lane; unsigned* oq = (unsigned*)(Hq + (size_t)r * DM) + F.lane;
        float s = 0.f, q = 0.f;
#pragma unroll
        for (int j = 0; j < 16; ++j) { const u32x2 w = x[64 * j], w0 = x0[64 * j];
            const f32x4 v = (f32x4){bf_lo(w0.x), bf_hi(w0.x), bf_lo(w0.y), bf_hi(w0.y)} * ALPHA + (f32x4){bf_lo(w.x), bf_hi(w.x), bf_lo(w.y), bf_hi(w.y)};
            s += (v[0] + v[1]) + (v[2] + v[3]); q += (v[0] * v[0] + v[1] * v[1]) + (v[2] * v[2] + v[3] * v[3]); }
        const float mean = wave_sum(s) * (1.f / DM), var = fmaxf(wave_sum(q) * (1.f / DM) - mean * mean, 0.f), rstd = 1.f / sqrtf(var + LN_EPS);
        asm volatile("" ::: "memory");
#pragma unroll
        for (int j = 0; j < 16; ++j) { const u32x2 w = __builtin_nontemporal_load(x + 64 * j), w0 = __builtin_nontemporal_load(x0 + 64 * j);
            const f32x4 v = (f32x4){bf_lo(w0.x), bf_hi(w0.x), bf_lo(w0.y), bf_hi(w0.y)} * ALPHA + (f32x4){bf_lo(w.x), bf_hi(w.x), bf_lo(w.y), bf_hi(w.y)};
            const f32x4 y = (v - mean) * rstd * gl[F.lane + 64 * j] + bl[F.lane + 64 * j];
            ob[64 * j] = (u32x2){pk2(y[0], y[1]), pk2(y[2], y[3])}; __builtin_nontemporal_store(pg8::pack4_fp8(y), oq + 64 * j);
            if ((j & 3) == 3) asm volatile("" ::: "memory"); }
    }
}

__device__ __forceinline__ void route_pass(Frame& F) {
    const int gw = F.c * 8 + F.wave, NGW = F.G * 8, lane = F.lane;
    LAS unsigned* hist = (LAS unsigned*)F.lds;
    __syncthreads();
    if (F.tid < NE) hist[F.tid] = 0u;
    __syncthreads();
    const float* Lg = WSP(float, WS_LOGITS); int* TI = WSP(int, WS_TOPI); float* TW = WSP(float, WS_TOPW);
    const float bias = F.in[21][lane];
    constexpr int RT = 4;
    for (int t = gw; t < T_TOK; t += RT * NGW) {
        float score[RT], sel[RT], val[RT], myw[RT], wsum[RT]; int myi[RT];
#pragma unroll
        for (int q = 0; q < RT; ++q) { const int tq = (t + q * NGW < T_TOK) ? t + q * NGW : t;
            const float lg = Lg[(size_t)tq * 128 + lane] + Lg[(size_t)tq * 128 + 64 + lane];
            score[q] = 1.f / (1.f + expf(-lg)); sel[q] = score[q] + bias; }
#pragma unroll
        for (int q = 0; q < RT; ++q) {
            int rk = 0;
#pragma unroll
            for (int x = 1; x < 8; ++x) { const float o = __shfl_xor(sel[q], x); const int pl = lane ^ x; rk += (o > sel[q] || (o == sel[q] && pl < lane)) ? 1 : 0; }
            float gs = rk < 2 ? sel[q] : 0.f; gs += __shfl_xor(gs, 1); gs += __shfl_xor(gs, 2); gs += __shfl_xor(gs, 4);
            int grk = 0; const int mg = lane >> 3;
#pragma unroll
            for (int x = 1; x < 8; ++x) { const float o = __shfl_xor(gs, 8 * x); const int og = mg ^ x; grk += (o > gs || (o == gs && og < mg)) ? 1 : 0; }
            val[q] = grk < 4 ? sel[q] : -1e30f; myi[q] = 0; myw[q] = 0.f; wsum[q] = 0.f; }
#pragma unroll
        for (int k = 0; k < TOPK; ++k)
#pragma unroll
            for (int q = 0; q < RT; ++q) {
                const float mx = wave_max(val[q]); const unsigned long long bal = __ballot(val[q] == mx); const int win = __builtin_ctzll(bal);
                const float ws = __shfl(score[q], win); wsum[q] += ws;
                if (lane == k) { myi[q] = win; myw[q] = ws; }
                if (lane == win) val[q] = -3e38f; }
#pragma unroll
        for (int q = 0; q < RT; ++q) { const int tq = t + q * NGW;
            if (tq < T_TOK && lane < TOPK) { TI[tq * TOPK + lane] = myi[q]; TW[tq * TOPK + lane] = myw[q] / wsum[q] * 2.5f; __hip_atomic_fetch_add(&hist[myi[q]], 1u, __ATOMIC_RELAXED, __HIP_MEMORY_SCOPE_WORKGROUP); } }
    }
    __syncthreads();
    if (F.tid < NE && hist[F.tid]) __hip_atomic_fetch_add(F.ctl + CW_CNT + F.tid, hist[F.tid], RLX_AGENT);
    __syncthreads();
}

__device__ __forceinline__ void lists_pass(Frame& F) {
    LAS int* sh = (LAS int*)F.lds;
    const int* TI = WSP(int, WS_TOPI); int* POS = WSP(int, WS_POS); int* RT = WSP(int, WS_ROWTOK); int* TE = WSP(int, WS_TILEE); int* UT = WSP(int, WS_UTAB);
    for (int e = F.c; e < NE; e += F.G) {
        __syncthreads();
        if (F.tid < NE) sh[F.tid] = (int)__hip_atomic_load(F.ctl + CW_CNT + F.tid, RLX_AGENT);
        __syncthreads();
        int tb = 0; for (int j = 0; j < e; ++j) tb += (sh[j] + 255) >> 8;
        const int cnt = sh[e], mytiles = (cnt + 255) >> 8, base = tb * 256;
        if (e == NE - 1 && F.tid == 0) __hip_atomic_store(F.ctl + CW_NTILES, (unsigned)(tb + mytiles), RLX_AGENT);
        int kk[16]; int loc = 0;
#pragma unroll
        for (int j = 0; j < 16; ++j) { const int t = F.tid * 16 + j; const u32x4 a = *(const u32x4*)(TI + t * 8), b = *(const u32x4*)(TI + t * 8 + 4);
            int k = -1; k = (int)a.x == e ? 0 : k; k = (int)a.y == e ? 1 : k; k = (int)a.z == e ? 2 : k; k = (int)a.w == e ? 3 : k; k = (int)b.x == e ? 4 : k; k = (int)b.y == e ? 5 : k; k = (int)b.z == e ? 6 : k; k = (int)b.w == e ? 7 : k;
            kk[j] = k; loc += (k >= 0) ? 1 : 0; }
        int inc = loc;
#pragma unroll
        for (int o = 1; o < 64; o <<= 1) { const int v = __shfl_up(inc, o); if (F.lane >= o) inc += v; }
        if (F.lane == 63) sh[64 + F.wave] = inc;
        __syncthreads();
        int woff = 0; for (int w = 0; w < F.wave; ++w) woff += sh[64 + w];
        int rank = woff + inc - loc;
#pragma unroll
        for (int j = 0; j < 16; ++j) if (kk[j] >= 0) { const int t = F.tid * 16 + j; RT[base + rank] = t; POS[t * 8 + kk[j]] = base + rank; ++rank; }
        for (int i = cnt + F.tid; i < mytiles * 256; i += 512) RT[base + i] = 0;
        if (F.tid < mytiles) TE[tb + F.tid] = e;
        for (int idx = F.tid; idx < mytiles * 16; idx += 512) { const int pb = idx / (mytiles * 8), rem = idx % (mytiles * 8), t = rem >> 3, pn = pb * 8 + (rem & 7);
            UT[tb * 16 + idx] = (tb + t) | (pn << 16) | (e << 24); }
    }
}

__device__ __forceinline__ void combine_pass(Frame& F) {
    const int gw = F.c * 8 + F.wave, NGW = F.G * 8;
    const bf16_t* H = WSP(bf16_t, WS_H1B); const unsigned char* Y = WSP(unsigned char, WS_YB); const int* POS = WSP(int, WS_POS); const float* TW = WSP(float, WS_TOPW);
    stage_gb(F, F.in[28], F.in[29]);
    for (int t = gw; t < T_TOK; t += NGW) {
        f32x4 v[16]; const u32x2* hr = (const u32x2*)(H + (size_t)t * DM) + F.lane;
#pragma unroll
        for (int j = 0; j < 16; ++j) { const u32x2 h = __builtin_nontemporal_load(hr + 64 * j); v[j] = (f32x4){bf_lo(h.x), bf_hi(h.x), bf_lo(h.y), bf_hi(h.y)}; }
#pragma unroll 2
        for (int k = 0; k < TOPK; ++k) { const int row = POS[t * TOPK + k]; const float w = TW[t * TOPK + k]; const unsigned* yr = (const unsigned*)(Y + (size_t)row * DM) + F.lane;
#pragma unroll
            for (int j = 0; j < 16; ++j) { const int y = (int)__builtin_nontemporal_load(yr + 64 * j); const f32x2 lo = __builtin_amdgcn_cvt_pk_f32_fp8(y, false), hi = __builtin_amdgcn_cvt_pk_f32_fp8(y, true); v[j] += (f32x4){lo.x, lo.y, hi.x, hi.y} * w; } }
        float s = 0.f;
#pragma unroll
        for (int j = 0; j < 16; ++j) s += (v[j][0] + v[j][1]) + (v[j][2] + v[j][3]);
        const float mean = wave_sum(s) * (1.f / DM); float s2 = 0.f;
#pragma unroll
        for (int j = 0; j < 16; ++j) { v[j] = v[j] - mean; s2 += (v[j][0] * v[j][0] + v[j][1] * v[j][1]) + (v[j][2] * v[j][2] + v[j][3] * v[j][3]); }
        const float rstd = 1.f / sqrtf(wave_sum(s2) * (1.f / DM) + LN_EPS);
        f32x4* o = (f32x4*)(F.out + (size_t)t * DM) + F.lane;
        asm volatile("" ::: "memory");
#pragma unroll
        for (int j = 0; j < 16; ++j) { const f32x4 gg = ((const LAS f32x4*)F.lds)[F.lane + 64 * j], bb = ((const LAS f32x4*)(F.lds + 16384))[F.lane + 64 * j]; __builtin_nontemporal_store(v[j] * rstd * gg + bb, o + 64 * j); }
    }
}

#ifndef DUMP
#define DUMP 0
#endif
__device__ __forceinline__ void dump_f32(Frame& F, const float* src) {
    for (size_t i = (size_t)F.c * 512 + F.tid; i < (size_t)T_TOK * DM / 4; i += (size_t)F.G * 512) ((f32x4*)F.out)[i] = ((const f32x4*)src)[i];
}
__device__ __forceinline__ void dump_bf16(Frame& F, const bf16_t* src, int ld, int ncols, int colofs, size_t nrows) {
    for (size_t i = (size_t)F.c * 512 + F.tid; i < nrows * ncols; i += (size_t)F.G * 512) { const size_t r = i / ncols, c = i % ncols; if (r < T_TOK) F.out[r * DM + colofs + c] = bf2f(src[r * ld + c]); }
}
__device__ __forceinline__ void dump_zero(Frame& F) {
    for (size_t i = (size_t)F.c * 512 + F.tid; i < (size_t)T_TOK * DM / 4; i += (size_t)F.G * 512) ((f32x4*)F.out)[i] = (f32x4){0.f, 0.f, 0.f, 0.f};
}
__device__ __forceinline__ void p1_convert(Frame& F, int when) {
    int c = F.c; asm volatile("" : "+s"(c));
    LAS unsigned* scr = (LAS unsigned*)(F.lds + F.wave * 8704);
    const bool split = (F.G == 256);
    const int NT = split ? CVT_P1_TILES : 3 * NE * 64 * 8;
    if (!split) { if (when == 0) cvt_run(F, 8, 11, c * 8 + F.wave, F.G * 8, scr); return; }
    const int nA = 58, sB = 312, sA = 372;
    const int kc = (c >> 3) & 1;
    if (kc != when) return;
    int tlo, thi;
    if (c < 256 - nA) { tlo = c * sB; thi = tlo + sB; } else { tlo = (256 - nA) * sB + (c - (256 - nA)) * sA; thi = tlo + sA; }
    if (thi > NT) thi = NT; if (tlo > NT) tlo = NT;
    cvt_run(F, 8, 11, F.wave, 8, scr, tlo, thi);
}
struct Args { const float* in[30]; float* out; unsigned char* ws; int ph_lo, ph_hi, one, pad; };
__global__ void __launch_bounds__(512, 2) mk_fwd(Args args) {
    extern __shared__ __attribute__((aligned(16))) unsigned char lds[];
    Frame F;
    F.lds = (LAS unsigned char*)lds; F.ws = args.ws; F.ctl = (gu32*)(args.ws + WS_CTL);
    F.tid = threadIdx.x; F.lane = F.tid & 63; F.wave = __builtin_amdgcn_readfirstlane(F.tid >> 6); F.G = gridDim.x; F.c = blockIdx.x;
    F.in = args.in; F.out = args.out;
    volatile LAS unsigned* MISC = (volatile LAS unsigned*)(F.lds + MISC_OFF);
    for (int u = F.tid; u < (LDS_BYTES - RING_BYTES) / 4; u += 512) ((LAS unsigned*)(F.lds + RING_BYTES))[u] = 0u;
    __syncthreads();
    XcdBarrier bar; bar.bar = (unsigned*)(F.ctl + CW_BAR); bar.x = 0; bar.st = nullptr;
    if (args.one) bar = xcd_barrier_post((unsigned*)(F.ctl + CW_BAR), MISC + 8);
    const int lo = args.ph_lo, hi = args.ph_hi;
#ifndef PH_MASK
#define PH_MASK 0xffffffffu
#endif
#define IN(k) (((PH_MASK >> (k)) & 1u) && lo <= (k) && (k) < hi)
#define SEAM(k) do { if (IN(k) && IN((k) + 1)) xcd_barrier(bar); REFRESH(); } while (0)
#define REFRESH() do { int t_ = threadIdx.x; asm volatile("" : "+v"(t_)); F.tid = t_; F.lane = t_ & 63; F.wave = __builtin_amdgcn_readfirstlane(t_ >> 6); } while (0)
#ifndef HOT12
#define HOT12 0
#endif
#ifndef PROBE_REP
#define PROBE_REP 0u
#endif
#define RUN(k, ...) if (IN(k)) { __VA_ARGS__ if ((PROBE_REP >> (k)) & 1u) { xcd_barrier(bar); REFRESH(); __VA_ARGS__ } }
    LAS unsigned char* ring = F.lds;

    RUN(0, { p0_prologue(F);  }) SEAM(0);
    RUN(1, {
        p1_convert(F, 0); __syncthreads();
        { pg8::DenseSched S{(const char*)WSP(unsigned char, WS_H0Q), (const char*)(WSP(unsigned char, WS_WING) + (size_t)10240 * DM), DM / 2, 33, 6, F.G, F.c, 0, 0, 0};
          pg8::EpiZ E{WSP(bf16_t, WS_KB), WSP(bf16_t, WS_VB), WSP(bf16_t, WS_UG)};
          pg8::gemm_phase<pg8::EpiZ, pg8::DenseSched, true>(ring, F.tid, DM / 2, DM / 2, S, E); }
        __syncthreads(); REFRESH();
        { pg8::DenseSched S{(const char*)WSP(unsigned char, WS_H0Q), (const char*)WSP(unsigned char, WS_WING), DM / 2, 32, 40, F.G, F.c, 0, 0, 0};
          pg8::EpiGate EG{WSP(bf16_t, WS_QB), WSP(bf16_t, WS_GA), WSP(bf16_t, WS_GS)};
          pg8::gemm_phase<pg8::EpiGate, pg8::DenseSched, true>(ring, F.tid, DM / 2, DM / 2, S, EG); }
        __syncthreads(); p1_convert(F, 1);
    }) SEAM(1);
    RUN(2, {
        const bool big = F.G >= 256; const int ntask = big ? 128 : 64;
        for (int t = F.c; t < ntask; t += F.G) { const int g = big ? t >> 1 : t, hf = big ? (t & 1) : 0; ssm_unit(F, g, hf ? 11 : 0, (big && !hf) ? 11 : SSM_NBLK); }
        const int a0 = big ? F.c - 128 : F.c, astep = big ? F.G - 128 : F.G;
        if (a0 >= 0) for (int u = a0; u < 256; u += astep) attn_unit(F, u >> 2, u & 3);
    }) SEAM(2);
    RUN(3, {
        pg8::DenseSched S{(const char*)WSP(unsigned char, WS_ATT), (const char*)WSP(unsigned char, WS_WAO), AW / 2, 32, 16, F.G, F.c, 0, 0, 0};
        pg8::EpiMix<false> E{WSP(bf16_t, WS_GA), WSP(bf16_t, WS_MIX), nullptr};
        pg8::gemm_phase<pg8::EpiMix<false>, pg8::DenseSched, true>(ring, F.tid, AW / 2, AW / 2, S, E);
    }) REFRESH();
    RUN(4, {
        if (F.G == 256 && F.c >= 128) { LAS unsigned* scr = (LAS unsigned*)(F.lds + F.wave * 8704); const int t0 = CVT_P1_TILES + (F.c - 128) * CVT_P4_PER; cvt_run(F, 8, 11, F.wave, 8, scr, t0, t0 + CVT_P4_PER); }
        pg8::DenseSched S{(const char*)WSP(bf16_t, WS_Y1), (const char*)WSP(bf16_t, WS_WGLU), SW, 32, 4, F.G, F.c, 0, 0, 0};
        pg8::EpiGlu E{WSP(bf16_t, WS_Y1), WSP(unsigned char, WS_Y2)};
        pg8::gemm_phase(ring, F.tid, SW, SW, S, E);
    }) SEAM(4);
    RUN(5, {
        pg8::DenseSched S{(const char*)WSP(unsigned char, WS_Y2), (const char*)WSP(unsigned char, WS_WSO), SW / 2, 32, 16, F.G, F.c, 0, 0, 0};
        pg8::EpiMix<true> E{WSP(bf16_t, WS_GS), WSP(bf16_t, WS_MIX), WSP(unsigned char, WS_H0Q)};
        pg8::gemm_phase<pg8::EpiMix<true>, pg8::DenseSched, true>(ring, F.tid, SW / 2, SW / 2, S, E);
    }) SEAM(5);
    RUN(6, {
        pg8::DenseSched S{(const char*)WSP(unsigned char, WS_H0Q), (const char*)WSP(unsigned char, WS_WOUT), DM / 2, 32, 16, F.G, F.c, 0, 0, 0};
        pg8::EpiWout E{WSP(bf16_t, WS_H1F)};
        pg8::gemm_phase<pg8::EpiWout, pg8::DenseSched, true>(ring, F.tid, DM / 2, DM / 2, S, E);
    }) SEAM(6);
    RUN(7, { ln1_pass(F);  }) SEAM(7);
    RUN(8, {
        if (F.G == 256 && F.c >= 160) { LAS unsigned* scr = (LAS unsigned*)(F.lds + F.wave * 8704); const int t0 = CVT_P1_TILES + CVT_P4_TILES + (F.c - 160) * CVT_P8_PER; cvt_run(F, 8, 11, F.wave, 8, scr, t0, t0 + CVT_P8_PER); }
        pg8::DenseSched S{(const char*)WSP(bf16_t, WS_H1B), (const char*)WSP(bf16_t, WS_WS13), DM, 32, 5, F.G, F.c, 0, 0, 0};
        pg8::EpiS13R E{WSP(bf16_t, WS_ACTS), WSP(float, WS_LOGITS)};
        pg8::gemm_phase(ring, F.tid, DM, DM, S, E);
    }) SEAM(8);
    RUN(9, { route_pass(F);  }) SEAM(9);
    RUN(10, { lists_pass(F);
        if (F.G == 256 && args.one && F.c >= 64) { pg8::DenseSched S{(const char*)WSP(bf16_t, WS_ACTS), (const char*)WSP(bf16_t, WS_WS2), EDIM, 32, 16, 192, F.c - 64, 0, 0, 0}; S.i1 = 2;
            pg8::EpiS2 E{WSP(bf16_t, WS_H1B)};
            pg8::gemm_phase(ring, F.tid, EDIM, EDIM, S, E); }
    }) SEAM(10);
    RUN(11, {
        const int ntiles = __builtin_amdgcn_readfirstlane((int)__hip_atomic_load(F.ctl + CW_NTILES, RLX_AGENT));
        { pg8::MoeSched S{(const char*)WSP(unsigned char, WS_H1LO), (const char*)WSP(unsigned char, WS_WE13), DM / 2, WSP(int, WS_ROWTOK), WSP(int, WS_TILEE), 4, (size_t)1024 * DM, ntiles * 4, F.G, F.c};
          pg8::EpiAct E{WSP(unsigned char, WS_ACT)};
          pg8::gemm_phase<pg8::EpiAct, pg8::MoeSched, true>(ring, F.tid, DM / 2, DM / 2, S, E); }
        { const bool early = (F.G == 256 && args.one);
          const int rem = (ntiles * 4) % F.G, nl = F.G - rem; const bool lite = early && rem > 0 && nl >= 64;
          if (!lite || F.c >= rem) {
          pg8::DenseSched S{(const char*)WSP(bf16_t, WS_ACTS), (const char*)WSP(bf16_t, WS_WS2), EDIM, 32, 16, lite ? nl : F.G, lite ? F.c - rem : F.c, 0, 0, 0}; S.l0 = early ? 384 : 0;
          pg8::EpiS2 E{WSP(bf16_t, WS_H1B)};
          pg8::gemm_phase(ring, F.tid, EDIM, EDIM, S, E); } }
    }) SEAM(11);
    RUN(12, {
        const int ntiles = __builtin_amdgcn_readfirstlane((int)__hip_atomic_load(F.ctl + CW_NTILES, RLX_AGENT)); const int nunits = ntiles * 16;
        LAS int* lut = (LAS int*)(F.lds + LUT_OFF);
#if HOT12
        __syncthreads();
        if (F.tid < 64) lut[F.tid] = (F.c & 3) | (((F.c >> 2) & 15) << 16);
        __syncthreads();
        { pg8::MoeTabSched S{(const char*)WSP(unsigned char, WS_ACT), (const char*)WSP(unsigned char, WS_WE2), EDIM / 2, lut, (size_t)DM * EDIM, nunits, F.G, F.c};
          pg8::EpiY E{WSP(unsigned char, WS_YB)};
          pg8::gemm_phase<pg8::EpiY, pg8::MoeTabSched, true>(ring, F.tid, EDIM / 2, EDIM / 2, S, E); }
        xcd_barrier(bar); REFRESH();
#endif
        __syncthreads();
        if (F.tid < 64) { const int L = F.tid * F.G + F.c; lut[F.tid] = L < nunits ? WSP(int, WS_UTAB)[pg8::xcd_remap(L, nunits)] : 0; }
        __syncthreads();
        pg8::MoeTabSched S{(const char*)WSP(unsigned char, WS_ACT), (const char*)WSP(unsigned char, WS_WE2), EDIM / 2, lut, (size_t)DM * EDIM, nunits, F.G, F.c};
        pg8::EpiY E{WSP(unsigned char, WS_YB)};
        pg8::gemm_phase<pg8::EpiY, pg8::MoeTabSched, true>(ring, F.tid, EDIM / 2, EDIM / 2, S, E);
    }) SEAM(12);
    RUN(13, { combine_pass(F);  })
#if DUMP
    if (lo <= 14 && 14 < hi) {
#if DUMP == 1
        dump_f32(F, WSP(float, WS_H1F));
#elif DUMP == 2
        dump_bf16(F, WSP(bf16_t, WS_MIX), DM, DM, 0, T_TOK);
#elif DUMP == 3
        dump_zero(F); __syncthreads();
        dump_bf16(F, WSP(bf16_t, WS_ATT), AW, AW, 0, T_TOK); dump_bf16(F, WSP(bf16_t, WS_Y1), SW, SW, AW, T_TOK);
#elif DUMP == 4
        dump_zero(F); __syncthreads();
        dump_bf16(F, WSP(bf16_t, WS_QB), AW, AW, 0, T_TOK); dump_bf16(F, WSP(bf16_t, WS_KB), KVW, KVW, AW, T_TOK); dump_bf16(F, WSP(bf16_t, WS_VB), KVW, KVW, AW + KVW, T_TOK);
        dump_bf16(F, WSP(bf16_t, WS_UG), 1026, 1026, AW + 2 * KVW, T_TOK);
#elif DUMP == 5
        dump_bf16(F, WSP(bf16_t, WS_GA), DM, DM, 0, T_TOK);
#elif DUMP == 7
        dump_bf16(F, WSP(bf16_t, WS_WIN) + (size_t)3584 * DM, DM, DM, 0, T_TOK);
#elif DUMP == 6
        dump_bf16(F, WSP(bf16_t, WS_H0B), DM, DM, 0, T_TOK);
#endif
    }
#endif
#undef IN
#undef SEAM
}

#ifndef PH_MASK
#define PH_MASK_HOST 0xffffffffu
#else
#define PH_MASK_HOST (PH_MASK)
#endif
extern "C" void kernel_launch(void* const* d_in, const int* in_sizes, int n_in, void* d_out, int out_size, void* d_ws, size_t ws_size, hipStream_t stream) {
    static int grid = 0;
    if (grid == 0) {
        if (n_in != 30 || in_sizes[0] != T_TOK * DM || out_size != T_TOK * DM || ws_size < WS_END) { fprintf(stderr, "kernel_launch: unexpected shapes / workspace (n_in %d, ws %zu, need %zu)\n", n_in, ws_size, (size_t)WS_END); grid = -1; return; }
        int dev = 0, cus = 0, per_cu = 0;
        if (hipGetDevice(&dev) != hipSuccess || hipDeviceGetAttribute(&cus, hipDeviceAttributeMultiprocessorCount, dev) != hipSuccess) { grid = -1; return; }
        if (hipFuncSetAttribute((const void*)mk_fwd, hipFuncAttributeMaxDynamicSharedMemorySize, LDS_BYTES) != hipSuccess) { fprintf(stderr, "kernel_launch: hipFuncSetAttribute failed\n"); grid = -1; return; }
        if (hipOccupancyMaxActiveBlocksPerMultiprocessor(&per_cu, (const void*)mk_fwd, 512, LDS_BYTES) != hipSuccess || per_cu < 1) fprintf(stderr, "kernel_launch: occupancy query reports %d\n", per_cu);
        (void)hipGetLastError();
        grid = cus;
    }
    if (grid < 0) return;
    if (hipMemsetAsync((char*)d_ws + WS_CTL, 0, CTL_ZERO_BYTES, stream) != hipSuccess) return;
    Args a{};
    for (int i = 0; i < 30; ++i) a.in[i] = (const float*)d_in[i];
    a.out = (float*)d_out; a.ws = (unsigned char*)d_ws; a.pad = 0;
#if MK_ONE_LAUNCH
    a.ph_lo = 0; a.ph_hi = NPHASE; a.one = 1;
    hipLaunchKernelGGL(mk_fwd, dim3(grid), dim3(512), LDS_BYTES, stream, a);
#else
    for (int p = 0; p < NPHASE + (DUMP ? 1 : 0); ++p) { a.ph_lo = p; a.ph_hi = p + 1; a.one = 0;
        if (!((PH_MASK_HOST >> p) & 1u)) continue;
        hipLaunchKernelGGL(mk_fwd, dim3(grid), dim3(512), LDS_BYTES, stream, a); }
#endif
}
```

```cpp
#include <hip/hip_runtime.h>
#include <cstdio>
#include <cstdint>

#define LAS __attribute__((address_space(3)))
#define GAS __attribute__((address_space(1)))
typedef unsigned short bf16_t;
typedef short bf16x8 __attribute__((ext_vector_type(8)));
typedef float f32x4 __attribute__((ext_vector_type(4)));
typedef float f32x2 __attribute__((ext_vector_type(2)));
typedef unsigned u32x4 __attribute__((ext_vector_type(4)));
typedef unsigned u32x2 __attribute__((ext_vector_type(2)));
typedef GAS unsigned gu32;

#ifndef MK_ONE_LAUNCH
#define MK_ONE_LAUNCH 1
#endif

constexpr int T_TOK = 8192, DM = 4096, NMETA = 16, ROWS_Z = 8448, KVROWS = 8208;
constexpr int NZ = 11776, AW = 2048, KVW = 256, SW = 1024;
constexpr int NE = 64, TOPK = 8, EDIM = 512;
constexpr float ALPHA = 1.189207115002721f;
constexpr float LN_EPS = 1e-5f;
constexpr float LOG2E = 1.4426950408889634f;
constexpr float QSCALE = 0.125f * LOG2E;
constexpr int MAXTILES = 320;
constexpr int NPHASE = 14;
constexpr int CVT_P8_PER = 120, CVT_P4_PER = 28, CVT_P8_TILES = 96 * CVT_P8_PER, CVT_P4_TILES = 128 * CVT_P4_PER, CVT_P1_TILES = 3 * NE * 64 * 8 - CVT_P8_TILES - CVT_P4_TILES;

constexpr size_t MiB = 1u << 20;
constexpr size_t WS_CTL = 0, CTL_ZERO_BYTES = 32768;
constexpr size_t WS_TOPI = 1 * MiB, WS_TOPW = WS_TOPI + 256 * 1024, WS_POS = WS_TOPW + 256 * 1024;
constexpr size_t WS_ROWTOK = 2 * MiB, WS_TILEE = 2 * MiB + 512 * 1024, WS_UTAB = WS_TILEE + 8192  , WS_STATS0 = 2 * MiB + 768 * 1024;
constexpr size_t WS_SSME = 3 * MiB, WS_LOGITS = 4 * MiB;
constexpr size_t WS_H1F = 8 * MiB, WS_H1B = 136 * MiB, WS_H1LO = 200 * MiB, WS_ACT = 264 * MiB, WS_ACTS = 344 * MiB;
constexpr size_t WS_WE2 = 352 * MiB, WS_WS2 = 608 * MiB, WS_WS13 = 612 * MiB;
constexpr size_t WS_WE13 = 640 * MiB, WS_WIN = 1152 * MiB, WS_WAO = 1244 * MiB, WS_WGLU = 1260 * MiB, WS_WSO = 1262 * MiB, WS_WOUT = 1270 * MiB;
constexpr size_t WS_H0B = 1302 * MiB, WS_QB = 1368 * MiB, WS_KB = 1400 * MiB, WS_VB = 1405 * MiB, WS_UG = 1410 * MiB;
constexpr size_t WS_GA = 1427 * MiB, WS_GS = 1491 * MiB, WS_ATT = 1555 * MiB, WS_Y1 = 1587 * MiB, WS_Y2 = 1603 * MiB, WS_MIX = 1619 * MiB;
constexpr size_t WS_END = 1683 * MiB;
constexpr size_t WS_WING = WS_WIN + 16 * MiB;
constexpr size_t WS_H0Q = WS_ACT + 40 * MiB;
constexpr size_t WS_YB = 640 * MiB;
static_assert(WS_YB + (size_t)MAXTILES * 256 * DM * 2 <= WS_H0B, "YB overlay");
constexpr int CW_TMO = 0, CW_CODE = 1, CW_NTILES = 64, CW_CNT = 128  , CW_BAR = 4096;

constexpr int RING_BYTES = 131072, LDS_BYTES = 147456, MISC_OFF = LDS_BYTES - 256, LUT_OFF = LDS_BYTES - 1024;

#define RLX_AGENT __ATOMIC_RELAXED, __HIP_MEMORY_SCOPE_AGENT
#define LDS_WAIT() asm volatile("s_waitcnt lgkmcnt(0)" ::: "memory")
#define VM_WAIT() asm volatile("s_waitcnt vmcnt(0)" ::: "memory")
__device__ __forceinline__ unsigned f2bf(float f) { unsigned u = __builtin_bit_cast(unsigned, f); return (u + 0x7fffu + ((u >> 16) & 1u)) >> 16; }
typedef __bf16 bf16x2_t __attribute__((ext_vector_type(2)));
__device__ __forceinline__ unsigned pk2(float lo, float hi) { f32x2 v = {lo, hi}; bf16x2_t b = __builtin_convertvector(v, bf16x2_t); return __builtin_bit_cast(unsigned, b); }
__device__ __forceinline__ float bf_lo(unsigned w) { return __builtin_bit_cast(float, w << 16); }
__device__ __forceinline__ float bf_hi(unsigned w) { return __builtin_bit_cast(float, w & 0xffff0000u); }
__device__ __forceinline__ float bf2f(bf16_t h) { return __builtin_bit_cast(float, ((unsigned)h) << 16); }
__device__ __forceinline__ float fast_sigmoid(float x) { return __builtin_amdgcn_rcpf(1.0f + __builtin_amdgcn_exp2f(-x * LOG2E)); }
__device__ __forceinline__ float wave_sum(float v) {
#pragma unroll
    for (int o = 1; o < 64; o <<= 1) v += __shfl_xor(v, o);
    return v;
}
__device__ __forceinline__ float wave_max(float v) {
#pragma unroll
    for (int o = 1; o < 64; o <<= 1) v = fmaxf(v, __shfl_xor(v, o));
    return v;
}

#define XB_TMO      128
#define XB_XCNT(j)  (256  + 64 * (j))
#define XB_XSUB(j)  (1280 + 64 * (j))
#define XB_XGEN(j)  (2304 + 64 * (j))
#define XB_TOP      3328
#define XB_TOPGEN   3392
#define XCD_BAR_WORDS 3456
#define XB_SPIN_CAP (1u << 18)
__device__ __forceinline__ unsigned xb_ld(unsigned* p)              { return __hip_atomic_load(p, __ATOMIC_RELAXED, __HIP_MEMORY_SCOPE_AGENT); }
__device__ __forceinline__ unsigned xb_add(unsigned* p, unsigned v) { return __hip_atomic_fetch_add(p, v, __ATOMIC_RELAXED, __HIP_MEMORY_SCOPE_AGENT); }
__device__ __forceinline__ unsigned xb_xcc_id() { return (unsigned)__builtin_amdgcn_s_getreg((3 << 11) | 20) & 0xFu; }
#define XB_SPIN(cond, bar) do { unsigned _sp = 0; while (cond) { __builtin_amdgcn_s_sleep(1); \
    if ((++_sp & 255u) == 0u) { if (xb_ld(&(bar)[XB_TMO])) break; if (_sp > XB_SPIN_CAP) { atomicAdd(&(bar)[XB_TMO], 1u); break; } } } } while (0)
struct XcdBarrier { unsigned* bar; unsigned x; volatile LAS unsigned* st; };
__device__ __forceinline__ XcdBarrier xcd_barrier_post(unsigned* bar, volatile LAS unsigned* st) {
    XcdBarrier b; b.bar = bar; b.x = xb_xcc_id(); b.st = st;
    if (threadIdx.x == 0) (void)xb_add(&bar[XB_XCNT(b.x)], 1u);
    return b;
}
__device__ __forceinline__ void xcd_barrier_complete(unsigned* bar, unsigned x, unsigned& nloc, unsigned& nx) {
    const unsigned G = gridDim.x * gridDim.y * gridDim.z;
    unsigned sum, cnt, mine, sp = 0u;
    for (;;) {
        sum = 0u; cnt = 0u; mine = 0u;
#pragma unroll
        for (unsigned j = 0; j < 16; ++j) { const unsigned c = xb_ld(&bar[XB_XCNT(j)]); sum += c; cnt += (c > 0u) ? 1u : 0u; mine = (j == x) ? c : mine; }
        if (sum == G) break;
        __builtin_amdgcn_s_sleep(1);
        if ((++sp & 255u) == 0u) { if (xb_ld(&bar[XB_TMO])) break; if (sp > XB_SPIN_CAP) { atomicAdd(&bar[XB_TMO], 1u); break; } }
    }
    nloc = mine > 0u ? mine : 1u; nx = cnt > 0u ? cnt : 1u;
}
__device__ __forceinline__ void xcd_barrier(const XcdBarrier& b) {
    asm volatile("s_waitcnt vmcnt(0)" ::: "memory");
    __syncthreads();
    if (threadIdx.x == 0) {
        unsigned* bar = b.bar;
        __builtin_amdgcn_s_waitcnt(0);
        unsigned nloc = b.st[0], nx = b.st[1];
        if (nloc == 0u) { xcd_barrier_complete(bar, b.x, nloc, nx); b.st[0] = nloc; b.st[1] = nx; }
        const unsigned old = xb_add(&bar[XB_XSUB(b.x)], 1u);
        const unsigned gen = old / nloc;
        if (old + 1u == (gen + 1u) * nloc) {
            __builtin_amdgcn_fence(__ATOMIC_RELEASE, "agent");
            asm volatile("s_waitcnt vmcnt(0)" ::: "memory");
            const unsigned og = xb_add(&bar[XB_TOP], 1u);
            const unsigned tg = og / nx;
            if (og + 1u == (tg + 1u) * nx) xb_add(&bar[XB_TOPGEN], 1u);
            else XB_SPIN(xb_ld(&bar[XB_TOPGEN]) == tg, bar);
            __builtin_amdgcn_fence(__ATOMIC_ACQUIRE, "agent");
            xb_add(&bar[XB_XGEN(b.x)], 1u);
            asm volatile("s_waitcnt vmcnt(0)" ::: "memory");
        } else {
            XB_SPIN(xb_ld(&bar[XB_XGEN(b.x)]) == gen, bar);
            __builtin_amdgcn_fence(__ATOMIC_ACQUIRE, "agent");
            asm volatile("s_waitcnt vmcnt(0)" ::: "memory");
        }
    }
    __syncthreads();
}

namespace pg8 {
constexpr int BM = 256, BK = 64, HALF = 128, HTB = HALF * BK * 2, NXCD = 8, WGM = 8;
__device__ __forceinline__ int lds_byte(int r, int c) { const int st = (r >> 4) * 2 + (c >> 5), rr = r & 15, cc = c & 31, ob = rr * 64 + cc * 2; return st * 1024 + (ob ^ (((ob >> 9) & 1) << 5)); }
__device__ __forceinline__ void stage_rc(int b, int& R, int& C) { const int st = b / 1024, sb = b % 1024, swz = sb ^ (((sb >> 9) & 1) << 5); R = (st >> 1) * 16 + swz / 64; C = (st & 1) * 32 + (swz % 64) / 2; }
__device__ __forceinline__ int perm32(int rho) { const int n = rho >> 4, i = rho & 15; return 8 * (i >> 2) + 4 * n + (i & 3); }
struct Unit { int pm, pn, e; };
__device__ __forceinline__ unsigned cvt_pk_bf16(float lo, float hi) { f32x2 v = {lo, hi}; bf16x2_t b = __builtin_convertvector(v, bf16x2_t); return __builtin_bit_cast(unsigned, b); }

__device__ __forceinline__ void tile_of(int L, int nM, int nN, int& pm, int& pn) {
    const int nwg = nM * nN; int wgid = L;
    { const int q = nwg / NXCD, r = nwg % NXCD, xcd = wgid % NXCD, off = wgid / NXCD; wgid = (xcd < r ? xcd * (q + 1) : r * (q + 1) + (xcd - r) * q) + off; }
    const int nig = WGM * nN, gid = wgid / nig, fm = gid * WGM, gsz = (nM - fm) < WGM ? (nM - fm) : WGM;
    pm = fm + ((wgid % nig) % gsz); pn = (wgid % nig) / gsz;
}
struct DenseSched {
    const char* A; const char* Bt; int K, nM, nN, G, c, xpm, xpn0, xn, i0 = 0, i1 = 0x7fffffff, l0 = 0;
    __device__ __forceinline__ bool next(int i, Unit& u) const {
        if (i + i0 >= i1) return false;
        const int L = (i + i0) * G + c + l0, nwg = nM * nN;
        if (L >= nwg) { const int x = L - nwg; if (x < xn) { u.pm = xpm; u.pn = xpn0 + x; u.e = 0; return true; } return false; }
        tile_of(L, nM, nN, u.pm, u.pn); u.e = 0; return true;
    }
    __device__ __forceinline__ int arow(const Unit& u, int r) const { return u.pm * BM + r; }
    __device__ __forceinline__ const char* abase(const Unit&) const { return A; }
    __device__ __forceinline__ const char* bbase(const Unit& u) const { return Bt + (size_t)u.pn * BM * K * 2; }
};
struct MoeSched {
    const char* A; const char* Bt; int K; const int* rowlist; const int* tile_e; int nN; size_t bstride; int nunits, G, c;
    __device__ __forceinline__ bool next(int i, Unit& u) const {
        const int L = i * G + c; if (L >= nunits) return false;
        const int q = nunits / NXCD, r = nunits % NXCD, xcd = L % NXCD, off = L / NXCD;
        const int wgid = (xcd < r ? xcd * (q + 1) : r * (q + 1) + (xcd - r) * q) + off;
        u.pm = wgid / nN; u.pn = wgid % nN;
        u.e = __builtin_amdgcn_readfirstlane((int)__hip_atomic_load((const unsigned*)tile_e + u.pm, RLX_AGENT));
        return true;
    }
    __device__ __forceinline__ int arow(const Unit& u, int r) const { return rowlist ? rowlist[u.pm * BM + r] : u.pm * BM + r; }
    __device__ __forceinline__ const char* abase(const Unit&) const { return A; }
    __device__ __forceinline__ const char* bbase(const Unit& u) const { return Bt + (size_t)u.e * bstride + (size_t)u.pn * BM * K * 2; }
};

struct MoeTabSched {
    const char* A; const char* Bt; int K; const LAS int* lut; size_t bstride; int nunits, G, c;
    __device__ __forceinline__ bool next(int i, Unit& u) const {
        if (i * G + c >= nunits) return false;
        const int v = __builtin_amdgcn_readfirstlane(lut[i]);
        u.pm = v & 0xffff; u.pn = (v >> 16) & 0xff; u.e = (v >> 24) & 0xff; return true;
    }
    __device__ __forceinline__ int arow(const Unit& u, int r) const { return u.pm * BM + r; }
    __device__ __forceinline__ const char* abase(const Unit&) const { return A; }
    __device__ __forceinline__ const char* bbase(const Unit& u) const { return Bt + (size_t)u.e * bstride + (size_t)u.pn * BM * K * 2; }
};
__device__ __forceinline__ int xcd_remap(int L, int nunits) { const int q = nunits / NXCD, r = nunits % NXCD, xcd = L % NXCD, off = L / NXCD; return (xcd < r ? xcd * (q + 1) : r * (q + 1) + (xcd - r) * q) + off; }

typedef int v8i __attribute__((ext_vector_type(8)));
typedef int v4i __attribute__((ext_vector_type(4)));
template <class E, class = void> struct epi_wide { static constexpr int v = 0; };
template <class E> struct epi_wide<E, decltype((void)E::WIDE)> { static constexpr int v = E::WIDE; };
template <bool FP8> struct Frag;
template <> struct Frag<false> { bf16x8 bh[2]; };
template <> struct Frag<true> { v8i q; };
template <class Epi, class Sched, bool FP8 = false>
__device__ __forceinline__ void gemm_phase(LAS unsigned char* lds, const int tid, const int K, const int lda, const Sched& S, const Epi& E) {
    const int wid = __builtin_amdgcn_readfirstlane(tid >> 6), lane = tid & 63, wr = wid >> 2, wc = wid & 3, fr = lane & 15, fq = lane >> 4;
    int nt = K / BK; asm volatile("" : "+s"(nt));
    int sc1 = 0x7f7f7f7f, scw = 0x79797979; asm volatile("" : "+v"(sc1), "+v"(scw));
    int Rr[2]; unsigned Cb[2], voffB[2];
    constexpr int WIDE = epi_wide<Epi>::v;
#pragma unroll
    for (int i = 0; i < 2; ++i) { int R, C; stage_rc(tid * 16 + i * 8192, R, C);
        const int Rb = WIDE == 1 ? (64 * (R >> 5) + 16 * ((R >> 2) & 3) + 4 * ((R >> 4) & 1) + (R & 3)) : WIDE == 2 ? (64 * (R >> 5) + 8 * ((R >> 2) & 3) + 4 * ((R >> 4) & 1) + (R & 3))
                     : Epi::PERM ? ((R & ~31) + perm32(R & 31)) : R;
        Rr[i] = R; Cb[i] = (unsigned)C * 2u; voffB[i] = (unsigned)(Rb * K + C) * 2u; }
    const unsigned lda2 = (unsigned)lda * 2u;
    const size_t kstep = (size_t)(BK * 2);
    const size_t hstepB = (size_t)(WIDE == 1 ? 8 : WIDE == 2 ? 32 : HALF) * K * 2;
    const unsigned ldsw = (unsigned)wid * 1024u;
    const int aoff = lds_byte(wr * 64 + fr, fq * 8), boff = lds_byte(wc * 32 + fr, fq * 8);
    const LAS unsigned char* pA = lds + aoff; const LAS unsigned char* pB = lds + 65536 + boff;
#define PG8_SA(b, h) (((b) * 2 + (h)) * HTB)
#define PG8_SB(b, h) ((4 + (b) * 2 + (h)) * HTB)
#define PG8_STAGE(bufoff, gbase, voff) do { _Pragma("unroll") for (int _i = 0; _i < 2; ++_i) \
        __builtin_amdgcn_global_load_lds((const unsigned*)((const char*)(gbase) + (voff)[_i]), (LAS unsigned*)(lds + (bufoff) + ldsw + _i * 8192), 16, 0, 0); } while (0)
#define PG8_LD32(p, off) __builtin_shufflevector(*(const LAS v4i*)((p) + (off)), *(const LAS v4i*)((p) + (off) + 1024), 0, 1, 2, 3, 4, 5, 6, 7)
#define PG8_LDA(dst, b, h) do { _Pragma("unroll") for (int m = 0; m < 4; ++m) { if constexpr (FP8) dst[m].q = PG8_LD32(pA, PG8_SA(b, h) + m * 2048); \
        else { dst[m].bh[0] = *(const LAS bf16x8*)(pA + PG8_SA(b, h) + m * 2048); dst[m].bh[1] = *(const LAS bf16x8*)(pA + PG8_SA(b, h) + m * 2048 + 1024); } } } while (0)
#define PG8_LDB(dst, b, h) do { _Pragma("unroll") for (int n = 0; n < 2; ++n) { if constexpr (FP8) dst[n].q = PG8_LD32(pB, PG8_SB(b, h) - 65536 + n * 2048); \
        else { dst[n].bh[0] = *(const LAS bf16x8*)(pB + PG8_SB(b, h) - 65536 + n * 2048); dst[n].bh[1] = *(const LAS bf16x8*)(pB + PG8_SB(b, h) - 65536 + n * 2048 + 1024); } } } while (0)
#define PG8_MMA(ai, bj, At, Bt) do { __builtin_amdgcn_s_setprio(1); _Pragma("unroll") for (int m = 0; m < 4; ++m) _Pragma("unroll") for (int n = 0; n < 2; ++n) { \
        if constexpr (FP8) asm volatile("v_mfma_scale_f32_16x16x128_f8f6f4 %0, %1, %2, %0, %3, %4 op_sel_hi:[0,0,0]" : "+v"(acc[ai][bj][m][n]) : "v"(Bt[n].q), "v"(At[m].q), "v"(scw), "v"(sc1)); \
        else { acc[ai][bj][m][n] = __builtin_amdgcn_mfma_f32_16x16x32_bf16(Bt[n].bh[0], At[m].bh[0], acc[ai][bj][m][n], 0, 0, 0); acc[ai][bj][m][n] = __builtin_amdgcn_mfma_f32_16x16x32_bf16(Bt[n].bh[1], At[m].bh[1], acc[ai][bj][m][n], 0, 0, 0); } } \
        __builtin_amdgcn_s_setprio(0); } while (0)
#define PG8_MMAZ(ai, bj, At, Bt) do { __builtin_amdgcn_s_setprio(1); _Pragma("unroll") for (int m = 0; m < 4; ++m) _Pragma("unroll") for (int n = 0; n < 2; ++n) \
        asm volatile("v_mfma_scale_f32_16x16x128_f8f6f4 %0, %1, %2, 0, %3, %4 op_sel_hi:[0,0,0]" : "+v"(acc[ai][bj][m][n]) : "v"(Bt[n].q), "v"(At[m].q), "v"(scw), "v"(sc1)); \
        __builtin_amdgcn_s_setprio(0); } while (0)
#define PG8_WAIT_V(n) asm volatile("s_waitcnt vmcnt(" #n ")" ::: "memory")
#define PG8_WAIT_V8E(c) do { if (Epi::NST > 0 && (c)) asm volatile("s_waitcnt vmcnt(%0)" :: "n"(8 + Epi::NST) : "memory"); else PG8_WAIT_V(8); } while (0)
#define PG8_WAIT_L(n) asm volatile("s_waitcnt lgkmcnt(" #n ")" ::: "memory")
#define PG8_BAR __builtin_amdgcn_s_barrier()
#define PG8_SCHED __builtin_amdgcn_sched_barrier(0)
    Unit cur, nxt; int ui = 0;
    if (!S.next(0, cur)) return;
    f32x4 acc[2][2][4][2];
#pragma unroll
    for (int a = 0; a < 2; ++a)
#pragma unroll
        for (int b = 0; b < 2; ++b)
#pragma unroll
            for (int m = 0; m < 4; ++m)
#pragma unroll
                for (int n = 0; n < 2; ++n) acc[a][b][m][n] = (f32x4){0.f, 0.f, 0.f, 0.f};
    Frag<FP8> At[4], B0[2], B1[2];
    const char* cA = S.abase(cur); const char* cB = S.bbase(cur);
    unsigned ofA0[2], ofA1[2];
#pragma unroll
    for (int i = 0; i < 2; ++i) { ofA0[i] = (unsigned)S.arow(cur, Rr[i]) * lda2 + Cb[i]; ofA1[i] = (unsigned)S.arow(cur, HALF + Rr[i]) * lda2 + Cb[i]; }
    PG8_STAGE(PG8_SB(0, 0), cB, voffB); PG8_STAGE(PG8_SB(0, 1), cB + hstepB, voffB); PG8_STAGE(PG8_SA(0, 0), cA, ofA0); PG8_STAGE(PG8_SA(0, 1), cA, ofA1);
    if (wr == 1) PG8_BAR;
    PG8_WAIT_V(2); PG8_BAR;
    PG8_STAGE(PG8_SB(1, 0), cB + kstep, voffB); PG8_STAGE(PG8_SA(1, 0), cA + kstep, ofA0); PG8_STAGE(PG8_SB(1, 1), cB + hstepB + kstep, voffB);
    PG8_WAIT_V(6); PG8_BAR;
    for (;;) {
        const bool has_next = S.next(ui + 1, nxt);
        const char* nA = has_next ? S.abase(nxt) : cA; const char* nB = has_next ? S.bbase(nxt) : cB;
        unsigned ofN0[2], ofN1[2];
#pragma unroll
        for (int i = 0; i < 2; ++i) { ofN0[i] = has_next ? (unsigned)S.arow(nxt, Rr[i]) * lda2 + Cb[i] : ofA0[i]; ofN1[i] = has_next ? (unsigned)S.arow(nxt, HALF + Rr[i]) * lda2 + Cb[i] : ofA1[i]; }
        for (int t = 0; t < nt; t += 2) {
            const bool last = (t == nt - 2);
            const char* a1 = cA + (size_t)(t + 1) * kstep;
            const char* a2 = last ? nA : cA + (size_t)(t + 2) * kstep; const char* b2 = last ? nB : cB + (size_t)(t + 2) * kstep;
            const char* a3 = a2 + kstep; const char* b3 = b2 + kstep;
            unsigned o20[2], o21[2];
#pragma unroll
            for (int i = 0; i < 2; ++i) { o20[i] = last ? ofN0[i] : ofA0[i]; o21[i] = last ? ofN1[i] : ofA1[i]; }
            const bool after_epi = (t == 0) && (ui > 0);
            PG8_LDB(B0, 0, 0); PG8_LDB(B1, 0, 1); PG8_SCHED; PG8_LDA(At, 0, 0); PG8_STAGE(PG8_SA(1, 1), a1, ofA1);
            PG8_WAIT_V8E(after_epi); PG8_WAIT_L(0); PG8_BAR;
            if constexpr (FP8) { if (t == 0) { PG8_MMAZ(0, 0, At, B0); PG8_MMAZ(0, 1, At, B1); } else { PG8_MMA(0, 0, At, B0); PG8_MMA(0, 1, At, B1); } } else { PG8_MMA(0, 0, At, B0); PG8_MMA(0, 1, At, B1); }
            PG8_BAR; PG8_SCHED;
            PG8_LDA(At, 0, 1); PG8_STAGE(PG8_SB(0, 0), b2, voffB); PG8_STAGE(PG8_SB(0, 1), b2 + hstepB, voffB); PG8_STAGE(PG8_SA(0, 0), a2, o20);
            PG8_WAIT_V8E(after_epi); PG8_WAIT_L(0); PG8_BAR;
            if constexpr (FP8) { if (t == 0) { PG8_MMAZ(1, 0, At, B0); PG8_MMAZ(1, 1, At, B1); } else { PG8_MMA(1, 0, At, B0); PG8_MMA(1, 1, At, B1); } } else { PG8_MMA(1, 0, At, B0); PG8_MMA(1, 1, At, B1); }
            PG8_BAR; PG8_SCHED;
            PG8_LDB(B0, 1, 0); PG8_LDB(B1, 1, 1); PG8_SCHED; PG8_LDA(At, 1, 0); PG8_STAGE(PG8_SA(0, 1), a2, o21);
            PG8_WAIT_V(8); PG8_WAIT_L(0); PG8_BAR; PG8_MMA(0, 0, At, B0); PG8_MMA(0, 1, At, B1); PG8_BAR; PG8_SCHED;
            PG8_LDA(At, 1, 1); PG8_STAGE(PG8_SB(1, 0), b3, voffB); PG8_STAGE(PG8_SB(1, 1), b3 + hstepB, voffB); PG8_STAGE(PG8_SA(1, 0), a3, o20);
            PG8_WAIT_V(8); PG8_WAIT_L(0); PG8_BAR; PG8_MMA(1, 0, At, B0); PG8_MMA(1, 1, At, B1); PG8_BAR; PG8_SCHED;
        }
        if (wr == 0) PG8_BAR;
        if constexpr (FP8) asm volatile("s_nop 15\n\ts_nop 15" ::: "memory");
        E(acc, cur, wr, wc, fr, fq);
        if (!has_next) break;
        if constexpr (!FP8) {
#pragma unroll
        for (int a = 0; a < 2; ++a)
#pragma unroll
            for (int b = 0; b < 2; ++b)
#pragma unroll
                for (int m = 0; m < 4; ++m)
#pragma unroll
                    for (int n = 0; n < 2; ++n) acc[a][b][m][n] = (f32x4){0.f, 0.f, 0.f, 0.f};
        }
        cur = nxt; cA = nA; cB = nB; ++ui;
#pragma unroll
        for (int i = 0; i < 2; ++i) { ofA0[i] = ofN0[i]; ofA1[i] = ofN1[i]; }
        if (wr == 1) PG8_BAR;
    }
    PG8_WAIT_V(0);
    PG8_BAR;
#undef PG8_SA
#undef PG8_SB
#undef PG8_STAGE
#undef PG8_LDA
#undef PG8_LD32
#undef PG8_LDB
#undef PG8_MMA
#undef PG8_MMAZ
#undef PG8_WAIT_V
#undef PG8_WAIT_V8E
#undef PG8_WAIT_L
#undef PG8_BAR
#undef PG8_SCHED
}

#define EPI_LOOP_ROWS for (int ai = 0; ai < 2; ++ai) _Pragma("unroll") for (int m = 0; m < 4; ++m)
__device__ __forceinline__ u32x4 pack8(const f32x4& v0, const f32x4& v1) { u32x4 w; w.x = cvt_pk_bf16(v0[0], v0[1]); w.y = cvt_pk_bf16(v0[2], v0[3]); w.z = cvt_pk_bf16(v1[0], v1[1]); w.w = cvt_pk_bf16(v1[2], v1[3]); return w; }
__device__ __forceinline__ void unpack8(const u32x4& w, f32x4& v0, f32x4& v1) { v0 = (f32x4){bf_lo(w.x), bf_hi(w.x), bf_lo(w.y), bf_hi(w.y)}; v1 = (f32x4){bf_lo(w.z), bf_hi(w.z), bf_lo(w.w), bf_hi(w.w)}; }
__device__ __forceinline__ unsigned pack4_fp8(const f32x4& v) { int w = __builtin_amdgcn_cvt_pk_fp8_f32(v[0], v[1], 0, false); w = __builtin_amdgcn_cvt_pk_fp8_f32(v[2], v[3], w, true); return (unsigned)w; }
__device__ __forceinline__ f32x4 sig4(const f32x4& v) { return (f32x4){fast_sigmoid(v[0]), fast_sigmoid(v[1]), fast_sigmoid(v[2]), fast_sigmoid(v[3])}; }

struct EpiZ {
    static constexpr bool PERM = true; static constexpr int NST = 0;
    bf16_t *Kb, *Vb, *Ug;
    __device__ __forceinline__ void operator()(const f32x4 (&acc)[2][2][4][2], const Unit& u, int wr, int wc, int fr, int fq) const {
        const int pn = u.pn;
#pragma unroll
        EPI_LOOP_ROWS {
            const int r = u.pm * BM + ai * HALF + wr * 64 + m * 16 + fr;
            if (r < KVROWS) { const int sp = r < T_TOK ? r + NMETA : r - T_TOK;
#pragma unroll
              for (int bj = 0; bj < 2; ++bj) {
                const int cl = bj * HALF + wc * 32 + 8 * fq;
                const f32x4 v0 = acc[ai][bj][m][0], v1 = acc[ai][bj][m][1];
                if (pn == 0) *(u32x4*)(Kb + (size_t)sp * KVW + cl) = pack8(v0, v1);
                else if (pn == 1) { bf16_t* vp = Vb + (size_t)cl * KVROWS + sp;
#pragma unroll
                    for (int j = 0; j < 4; ++j) { vp[(size_t)j * KVROWS] = (bf16_t)f2bf(v0[j]); vp[(size_t)(4 + j) * KVROWS] = (bf16_t)f2bf(v1[j]); } }
                else { const int col = (pn - 2) * BM + cl;
                    *(u32x4*)(Ug + ((size_t)(col >> 4) * KVROWS + sp) * 16 + (col & 15)) = pack8(v0, v1); }
              } }
        }
    }
};
struct EpiGate {
    static constexpr bool PERM = true; static constexpr int NST = 0; static constexpr int WIDE = 2;
    bf16_t *Q, *Ga, *Gs;
    __device__ __forceinline__ void operator()(const f32x4 (&acc)[2][2][4][2], const Unit& u, int wr, int wc, int fr, int fq) const {
        const int row0 = u.pm * BM + wr * 64 + fr, cl = wc * 64 + 8 * fq;
        if (u.pn < 8) {
            bf16_t* base = Q + (size_t)row0 * AW + u.pn * BM + cl;
#pragma unroll
            EPI_LOOP_ROWS {
#pragma unroll
                for (int bj = 0; bj < 2; ++bj) *(u32x4*)(base + (size_t)(ai * HALF + m * 16) * AW + bj * 32) = pack8(acc[ai][bj][m][0] * QSCALE, acc[ai][bj][m][1] * QSCALE); }
        } else {
            bf16_t* base = (u.pn < 24 ? Ga : Gs) + (size_t)row0 * DM + ((u.pn - 8) & 15) * BM + cl;
#pragma unroll
            EPI_LOOP_ROWS {
#pragma unroll
                for (int bj = 0; bj < 2; ++bj) __builtin_nontemporal_store(pack8(sig4(acc[ai][bj][m][0]), sig4(acc[ai][bj][m][1])), (u32x4*)(base + (size_t)(ai * HALF + m * 16) * DM + bj * 32)); }
        }
    }
};
struct EpiGlu {
    static constexpr bool PERM = true; static constexpr int NST = 0;
    const bf16_t* Y1; unsigned char* Y2;
    __device__ __forceinline__ void operator()(const f32x4 (&acc)[2][2][4][2], const Unit& u, int wr, int wc, int fr, int fq) const {
#pragma unroll
        EPI_LOOP_ROWS { const size_t r = (size_t)u.pm * BM + ai * HALF + wr * 64 + m * 16 + fr;
#pragma unroll
            for (int bj = 0; bj < 2; ++bj) { const size_t off = r * SW + u.pn * BM + bj * HALF + wc * 32 + 8 * fq;
                f32x4 y0, y1; unpack8(*(const u32x4*)(Y1 + off), y0, y1);
                *(u32x2*)(Y2 + off) = (u32x2){pack4_fp8(y0 * sig4(acc[ai][bj][m][0])), pack4_fp8(y1 * sig4(acc[ai][bj][m][1]))}; } }
    }
};
template <bool ADD> struct EpiMix {
    static constexpr bool PERM = true; static constexpr int NST = 0; static constexpr int WIDE = ADD ? 1 : 2;
    const bf16_t* Gt; bf16_t* Mix; unsigned char* MixQ;
    __device__ __forceinline__ void operator()(const f32x4 (&acc)[2][2][4][2], const Unit& u, int wr, int wc, int fr, int fq) const {
#pragma unroll
        EPI_LOOP_ROWS { const size_t r = (size_t)u.pm * BM + ai * HALF + wr * 64 + m * 16 + fr;
            const size_t off0 = r * DM + u.pn * BM + wc * 64 + (ADD ? 16 : 8) * fq; unsigned q[4];
#pragma unroll
            for (int bj = 0; bj < 2; ++bj) { const size_t off = off0 + bj * (ADD ? 8 : 32);
                f32x4 g0, g1; unpack8(*(const u32x4*)(Gt + off), g0, g1);
                f32x4 o0 = g0 * acc[ai][bj][m][0], o1 = g1 * acc[ai][bj][m][1];
                if (ADD) { f32x4 p0, p1; unpack8(*(const u32x4*)(Mix + off), p0, p1); o0 += p0; o1 += p1; q[2 * bj] = pack4_fp8(o0); q[2 * bj + 1] = pack4_fp8(o1); }
                else *(u32x4*)(Mix + off) = pack8(o0, o1); }
            if (ADD) *(u32x4*)(MixQ + off0) = (u32x4){q[0], q[1], q[2], q[3]};
        }
    }
};
struct EpiWout {
    static constexpr bool PERM = true; static constexpr int NST = 0; static constexpr int WIDE = 2;
    bf16_t* Out;
    __device__ __forceinline__ void operator()(const f32x4 (&acc)[2][2][4][2], const Unit& u, int wr, int wc, int fr, int fq) const {
        const int col0 = u.pn * BM + wc * 64 + 8 * fq;
#pragma unroll
        EPI_LOOP_ROWS { const size_t r = (size_t)u.pm * BM + ai * HALF + wr * 64 + m * 16 + fr; const size_t off = r * DM + col0;
#pragma unroll
            for (int bj = 0; bj < 2; ++bj) *(u32x4*)(Out + off + bj * 32) = pack8(acc[ai][bj][m][0], acc[ai][bj][m][1]); }
    }
};
struct EpiS13R {
    static constexpr bool PERM = true; static constexpr int NST = 0;
    bf16_t* ActS; float* Logits;
    __device__ __forceinline__ void operator()(const f32x4 (&acc)[2][2][4][2], const Unit& u, int wr, int wc, int fr, int fq) const {
#pragma unroll
        EPI_LOOP_ROWS { const size_t r = (size_t)u.pm * BM + ai * HALF + wr * 64 + m * 16 + fr; const int cl = wc * 32 + 8 * fq;
            if (u.pn < 4) { const f32x4 a0 = acc[ai][0][m][0], a1 = acc[ai][0][m][1];
                *(u32x4*)(ActS + r * EDIM + u.pn * HALF + cl) = pack8(a0 * sig4(a0) * acc[ai][1][m][0], a1 * sig4(a1) * acc[ai][1][m][1]); }
            else { *(f32x4*)(Logits + r * 128 + cl) = acc[ai][0][m][0]; *(f32x4*)(Logits + r * 128 + cl + 4) = acc[ai][0][m][1]; } }
    }
};
constexpr float WQ_SCALE = 64.f, WQ_INV = 1.f / 64.f;
struct EpiAct {
    static constexpr bool PERM = true; static constexpr int NST = 0;
    unsigned char* Act;
    __device__ __forceinline__ void operator()(const f32x4 (&acc)[2][2][4][2], const Unit& u, int wr, int wc, int fr, int fq) const {
#pragma unroll
        EPI_LOOP_ROWS { const size_t r = (size_t)u.pm * BM + ai * HALF + wr * 64 + m * 16 + fr; const int cl = wc * 32 + 8 * fq;
            const f32x4 a0 = acc[ai][0][m][0], a1 = acc[ai][0][m][1];
            *(u32x2*)(Act + r * EDIM + u.pn * HALF + cl) = (u32x2){pack4_fp8(a0 * sig4(a0) * acc[ai][1][m][0]), pack4_fp8(a1 * sig4(a1) * acc[ai][1][m][1])}; }
    }
};
struct EpiS2 {
    static constexpr bool PERM = true; static constexpr int NST = 0; static constexpr int WIDE = 2;
    bf16_t* H;
    __device__ __forceinline__ void operator()(const f32x4 (&acc)[2][2][4][2], const Unit& u, int wr, int wc, int fr, int fq) const {
#pragma unroll
        EPI_LOOP_ROWS { const size_t r = (size_t)u.pm * BM + ai * HALF + wr * 64 + m * 16 + fr;
#pragma unroll
            for (int bj = 0; bj < 2; ++bj) { bf16_t* p = H + r * DM + u.pn * BM + bj * 32 + wc * 64 + 8 * fq; f32x4 h0, h1; unpack8(*(const u32x4*)p, h0, h1);
                *(u32x4*)p = pack8(h0 * ALPHA + acc[ai][bj][m][0], h1 * ALPHA + acc[ai][bj][m][1]); } }
    }
};
struct EpiY {
    static constexpr bool PERM = true; static constexpr int NST = 8; static constexpr int WIDE = 1;
    unsigned char* Y;
    __device__ __forceinline__ void operator()(const f32x4 (&acc)[2][2][4][2], const Unit& u, int wr, int wc, int fr, int fq) const {
#pragma unroll
        EPI_LOOP_ROWS { const size_t r = (size_t)u.pm * BM + ai * HALF + wr * 64 + m * 16 + fr;
            *(u32x4*)(Y + r * DM + u.pn * BM + wc * 64 + 16 * fq) = (u32x4){pack4_fp8(acc[ai][0][m][0]), pack4_fp8(acc[ai][0][m][1]), pack4_fp8(acc[ai][1][m][0]), pack4_fp8(acc[ai][1][m][1])}; }
    }
};
}

struct Frame {
    LAS unsigned char* lds; gu32* ctl; unsigned char* ws;
    int tid, lane, wave, G, c;
    const float* const* in; float* out;
};
#define WSP(T, off) ((T*)(F.ws + (off)))

struct CvtRegs { f32x4 v[16]; };
__device__ __forceinline__ void cvt_load(CvtRegs& R, const float* __restrict__ W, size_t ldw, int k0, int n0, int lane) {
    const float* src = W + (size_t)(k0 + 2 * (lane >> 4)) * ldw + n0 + 4 * (lane & 15);
#pragma unroll
    for (int ip = 0; ip < 8; ++ip) { R.v[2 * ip] = __builtin_nontemporal_load((const f32x4*)(src + (size_t)(8 * ip) * ldw)); R.v[2 * ip + 1] = __builtin_nontemporal_load((const f32x4*)(src + (size_t)(8 * ip + 1) * ldw)); }
}
template <bool LO>
__device__ __forceinline__ void cvt_store(const CvtRegs& R, int k0, bf16_t* Wt, size_t dpitch, size_t drow0, LAS unsigned* scr, int lane) {
    const int kq = lane >> 4, n4 = 4 * (lane & 15);
#pragma unroll
    for (int ip = 0; ip < 8; ++ip) { f32x4 a = R.v[2 * ip], b = R.v[2 * ip + 1];
        if (LO) {
#pragma unroll
            for (int j = 0; j < 4; ++j) { a[j] -= __builtin_bit_cast(float, f2bf(a[j]) << 16); b[j] -= __builtin_bit_cast(float, f2bf(b[j]) << 16); } }
#pragma unroll
        for (int j = 0; j < 4; ++j) scr[(n4 + j) * 33 + 4 * ip + kq] = pk2(a[j], b[j]); }
    LDS_WAIT();
    const int c = lane & 7;
#pragma unroll
    for (int j = 0; j < 8; ++j) { const int n = (lane >> 3) + 8 * j; const LAS unsigned* s = scr + n * 33 + 4 * c;
        u32x4 o; o.x = s[0]; o.y = s[1]; o.z = s[2]; o.w = s[3];
        __builtin_nontemporal_store(o, (u32x4*)(Wt + (drow0 + n) * dpitch + k0 + 8 * c)); }
    LDS_WAIT();
}
template <bool LO>
__device__ __forceinline__ void cvt_tile(const float* __restrict__ W, size_t ldw, int k0, int n0, bf16_t* Wt, size_t dpitch, size_t drow0, LAS unsigned* scr, int lane) {
    CvtRegs R; cvt_load(R, W, ldw, k0, n0, lane); cvt_store<LO>(R, k0, Wt, dpitch, drow0, scr, lane);
}
__device__ __forceinline__ void cvt_load8(CvtRegs& R, const float* __restrict__ W, size_t ldw, int k0, int n0, int lane) {
    const float* src = W + (size_t)(k0 + 4 * (lane >> 3)) * ldw + n0 + 4 * (lane & 7);
#pragma unroll
    for (int ip = 0; ip < 4; ++ip)
#pragma unroll
        for (int b = 0; b < 4; ++b) R.v[4 * ip + b] = __builtin_nontemporal_load((const f32x4*)(src + (size_t)(32 * ip + b) * ldw));
}
__device__ __forceinline__ void cvt_store8(const CvtRegs& R, int k0, unsigned char* Wt, size_t dpitch, size_t drow0, float scale, LAS unsigned* scr, int lane, bool nt = true) {
    const int kr = lane >> 3, n4 = 4 * (lane & 7);
#pragma unroll
    for (int ip = 0; ip < 4; ++ip)
#pragma unroll
        for (int j = 0; j < 4; ++j) { int w = __builtin_amdgcn_cvt_pk_fp8_f32(R.v[4 * ip][j] * scale, R.v[4 * ip + 1][j] * scale, 0, false); w = __builtin_amdgcn_cvt_pk_fp8_f32(R.v[4 * ip + 2][j] * scale, R.v[4 * ip + 3][j] * scale, w, true);
            scr[(n4 + j) * 33 + 8 * ip + kr] = (unsigned)w; }
    LDS_WAIT();
    const int c = lane & 7;
#pragma unroll
    for (int j = 0; j < 4; ++j) { const int n = (lane >> 3) + 8 * j; const LAS unsigned* sp = scr + n * 33 + 4 * c;
        u32x4 o; o.x = sp[0]; o.y = sp[1]; o.z = sp[2]; o.w = sp[3];
        if (nt) __builtin_nontemporal_store(o, (u32x4*)(Wt + (drow0 + n) * dpitch + k0 + 16 * c)); else *(u32x4*)(Wt + (drow0 + n) * dpitch + k0 + 16 * c) = o; }
    LDS_WAIT();
}
struct CvtJob { const float* W; void* Wt; int K, N, mode, nmat; size_t wstride, dstride; int fp8; int ldw; };
__device__ __forceinline__ int cvt_job_tiles(const CvtJob& j) { return j.nmat * (j.K / 64) * (j.N / 64); }
struct CvtTile { const float* W; void* Wt; size_t ldw, dpitch, drow0; int k0, n0; };
__device__ __forceinline__ CvtTile cvt_job_tile(const CvtJob& j, int it) {
    const int tn = j.fp8 ? 32 : 64, tk = j.fp8 ? 128 : 64;
    const int nnb = j.N / tn, per = (j.K / tk) * nnb, mat = it / per, r = it % per, kb = r / nnb, nb = r % nnb, n0 = nb * tn;
    const size_t drow0 = j.mode == 0 ? (size_t)n0 : (size_t)(n0 >> 7) * 256 + (j.mode - 1) * 128 + (n0 & 127);
    void* wt = j.fp8 ? (void*)((unsigned char*)j.Wt + (size_t)mat * j.dstride) : (void*)((bf16_t*)j.Wt + (size_t)mat * j.dstride);
    return CvtTile{j.W + (size_t)mat * j.wstride, wt, (size_t)(j.ldw ? j.ldw : j.N), (size_t)j.K, drow0, kb * tk, n0};
}
__device__ __forceinline__ void ln_row(const float* xrow, const LAS f32x4* g, const LAS f32x4* b, int lane, f32x4 (&v)[16], float& mean, float& rstd) {
    const f32x4* xr = (const f32x4*)xrow + lane; float s = 0.f;
#pragma unroll
    for (int j = 0; j < 16; ++j) { v[j] = __builtin_nontemporal_load(xr + 64 * j); s += (v[j][0] + v[j][1]) + (v[j][2] + v[j][3]); }
    mean = wave_sum(s) * (1.f / DM); float s2 = 0.f;
#pragma unroll
    for (int j = 0; j < 16; ++j) { v[j] = v[j] - mean; s2 += (v[j][0] * v[j][0] + v[j][1] * v[j][1]) + (v[j][2] * v[j][2] + v[j][3] * v[j][3]); }
    rstd = 1.f / sqrtf(wave_sum(s2) * (1.f / DM) + LN_EPS);
    asm volatile("" ::: "memory");
#pragma unroll
    for (int j = 0; j < 16; ++j) { const f32x4 gg = g[lane + 64 * j], bb = b[lane + 64 * j]; v[j] = v[j] * rstd * gg + bb; }
}

__device__ __forceinline__ void cvt_run(const Frame& F, int j0, int j1, int gw, int NGW, LAS unsigned* scr, int tlo = 0, int thi = 0x7fffffff) {
    int done = 0;
#pragma unroll 1
    for (int jn = j0; jn < j1; ++jn) {
        CvtJob j;
        switch (jn) {
            case 0: j = CvtJob{F.in[4] + 2048, WSP(unsigned char, WS_WING) + (size_t)10240 * DM, DM, 1536, 0, 1, 0, 0, 1, NZ}; break;
            case 11: j = CvtJob{F.in[4] + 3584, WSP(unsigned char, WS_WING) + (size_t)2048 * DM, DM, 2 * DM, 0, 1, 0, 0, 1, NZ}; break;
            case 12: j = CvtJob{F.in[4], WSP(unsigned char, WS_WING), DM, 2048, 0, 1, 0, 0, 1, NZ}; break;
            case 1: j = CvtJob{F.in[6], WSP(unsigned char, WS_WAO), AW, DM, 0, 1, 0, 0, 1, 0}; break;
            case 2: j = CvtJob{F.in[15], WSP(bf16_t, WS_WGLU), SW, SW, 0, 1, 0, 0, 0, 0}; break;
            case 3: j = CvtJob{F.in[16], WSP(unsigned char, WS_WSO), SW, DM, 0, 1, 0, 0, 1, 0}; break;
            case 4: j = CvtJob{F.in[17], WSP(unsigned char, WS_WOUT), DM, DM, 0, 1, 0, 0, 1, 0}; break;
            case 5: j = CvtJob{F.in[25], WSP(bf16_t, WS_WS13), DM, EDIM, 1, 1, 0, 0, 0, 0}; break;
            case 6: j = CvtJob{F.in[26], WSP(bf16_t, WS_WS13), DM, EDIM, 2, 1, 0, 0, 0, 0}; break;
            case 7: j = CvtJob{F.in[27], WSP(bf16_t, WS_WS2), EDIM, DM, 0, 1, 0, 0, 0, 0}; break;
            case 8: j = CvtJob{F.in[22], WSP(unsigned char, WS_WE13), DM, EDIM, 1, NE, (size_t)DM * EDIM, (size_t)1024 * DM, 1, 0}; break;
            case 9: j = CvtJob{F.in[23], WSP(unsigned char, WS_WE13), DM, EDIM, 2, NE, (size_t)DM * EDIM, (size_t)1024 * DM, 1, 0}; break;
            default: j = CvtJob{F.in[24], WSP(unsigned char, WS_WE2), EDIM, DM, 0, NE, (size_t)EDIM * DM, (size_t)DM * EDIM, 1, 0}; break;
        }
        const int nt0 = cvt_job_tiles(j);
        const int nt = (thi - done) < nt0 ? (thi - done) : nt0;
        int it = (tlo - done) > 0 ? (tlo - done) : 0;
        { const int gfirst = done + it; const int r = (gw - (gfirst - tlo) % NGW + NGW) % NGW; it += r; }
        if (it < nt) {
            CvtTile tc = cvt_job_tile(j, it); CvtRegs Ra;
            if (j.fp8) cvt_load8(Ra, tc.W, tc.ldw, tc.k0, tc.n0, F.lane); else cvt_load(Ra, tc.W, tc.ldw, tc.k0, tc.n0, F.lane);
#pragma unroll 1
            for (;;) {
                const int itn = it + NGW; const bool more = itn < nt;
                CvtTile tn = tc; CvtRegs Rb;
                if (more) { tn = cvt_job_tile(j, itn); if (j.fp8) cvt_load8(Rb, tn.W, tn.ldw, tn.k0, tn.n0, F.lane); else cvt_load(Rb, tn.W, tn.ldw, tn.k0, tn.n0, F.lane); }
                if (j.fp8) cvt_store8(Ra, tc.k0, (unsigned char*)tc.Wt, tc.dpitch, tc.drow0, pg8::WQ_SCALE, scr, F.lane, j.ldw == 0); else cvt_store<false>(Ra, tc.k0, (bf16_t*)tc.Wt, tc.dpitch, tc.drow0, scr, F.lane);
                if (!more) break;
                Ra = Rb; tc = tn; it = itn;
            }
        }
        done += nt0;
    }
}
__device__ __forceinline__ void stage_gb(Frame& F, const float* g, const float* b) {
    __syncthreads();
    for (int i = F.tid; i < DM / 4; i += 512) { ((LAS f32x4*)F.lds)[i] = ((const f32x4*)g)[i]; ((LAS f32x4*)(F.lds + 16384))[i] = ((const f32x4*)b)[i]; }
    __syncthreads();
}
__device__ __forceinline__ void p0_prologue(Frame& F) {
    LAS unsigned* scr = (LAS unsigned*)(F.lds + 32768 + F.wave * 8704);
    const int gw = F.c * 8 + F.wave, NGW = F.G * 8;
    stage_gb(F, F.in[2], F.in[3]);
    { bf16_t* H0B = WSP(bf16_t, WS_H0B); f32x2* St0 = WSP(f32x2, WS_STATS0);
      for (int r = gw; r < ROWS_Z; r += NGW) {
          u32x2* o = (u32x2*)(H0B + (size_t)r * DM) + F.lane;
          if (r < KVROWS) { const float* src = r < T_TOK ? F.in[0] + (size_t)r * DM : F.in[1] + (size_t)(r - T_TOK) * DM;
              f32x4 v[16]; float mean, rstd; ln_row(src, (const LAS f32x4*)F.lds, (const LAS f32x4*)(F.lds + 16384), F.lane, v, mean, rstd);
              if (r < T_TOK && F.lane == 0) St0[r] = (f32x2){mean, rstd};
#pragma unroll
              for (int j = 0; j < 16; ++j) __builtin_nontemporal_store((u32x2){pk2(v[j][0], v[j][1]), pk2(v[j][2], v[j][3])}, o + 64 * j);
              { unsigned* oq = (unsigned*)(WSP(unsigned char, WS_H0Q) + (size_t)r * DM) + F.lane;
#pragma unroll
                  for (int j = 0; j < 16; ++j) oq[64 * j] = pg8::pack4_fp8(v[j]); }
          } else { unsigned* oq = (unsigned*)(WSP(unsigned char, WS_H0Q) + (size_t)r * DM) + F.lane;
#pragma unroll
              for (int j = 0; j < 16; ++j) { o[64 * j] = (u32x2){0u, 0u}; oq[64 * j] = 0u; }
          } } }
    cvt_run(F, 0, 1, gw, NGW, scr); cvt_run(F, 11, 13, gw, NGW, scr);
    { bf16_t* Wr = WSP(bf16_t, WS_WS13);
      for (int kb = gw; kb < DM / 64; kb += NGW) { cvt_tile<false>(F.in[20], NE, kb * 64, 0, Wr, DM, 1024, scr, F.lane); cvt_tile<true>(F.in[20], NE, kb * 64, 0, Wr, DM, 1088, scr, F.lane); }
      u32x4* z = (u32x4*)(Wr + (size_t)1152 * DM);
      for (int i = (F.c * 512 + F.tid); i < 128 * DM * 2 / 16; i += F.G * 512) z[i] = (u32x4){0u, 0u, 0u, 0u}; }
}

typedef float f32x16 __attribute__((ext_vector_type(16)));
constexpr int ATT_KP = 144, ATT_VP = 584, ATT_V_OFF = 288 * ATT_KP;
static_assert(ATT_V_OFF + 64 * ATT_VP <= RING_BYTES, "attention LDS");
__device__ __forceinline__ int att_src_pos(int key, int n) {
    if (key < 128) return n > 0 ? NMETA + 128 * (n - 1) + key : -1;
    if (key < 256) return NMETA + 128 * n + (key - 128);
    if (key < 272) return key - 256;
    return -1;
}
__device__ __forceinline__ void attn_unit(Frame& F, int n, int kh) {
    const bf16_t* Qb = WSP(bf16_t, WS_QB); const bf16_t* Kb = WSP(bf16_t, WS_KB); const bf16_t* Vt = WSP(bf16_t, WS_VB); unsigned char* At = WSP(unsigned char, WS_ATT);
    LAS unsigned char* Ks = F.lds; LAS unsigned char* Vs = F.lds + ATT_V_OFF;
    __syncthreads();
    for (int p = F.tid; p < 288 * 8; p += 512) { const int j = p >> 3, c8 = p & 7, sp = att_src_pos(j, n);
        u32x4 v = (u32x4){0u, 0u, 0u, 0u};
        if (sp >= 0) v = *(const u32x4*)(Kb + (size_t)sp * KVW + kh * 64 + c8 * 8);
        *(LAS u32x4*)(Ks + j * ATT_KP + c8 * 16) = v; }
    for (int p = F.tid; p < 64 * 36; p += 512) { const int d = p / 36, q = p % 36, sp = att_src_pos(q * 8, n);
        u32x4 v = (u32x4){0u, 0u, 0u, 0u};
        if (sp >= 0) v = *(const u32x4*)(Vt + (size_t)(kh * 64 + d) * KVROWS + sp);
        LAS u32x2* dst = (LAS u32x2*)(Vs + d * ATT_VP + q * 16); dst[0] = (u32x2){v.x, v.y}; dst[1] = (u32x2){v.z, v.w}; }
    __syncthreads();
    const int hq = kh * 8 + F.wave, r32 = F.lane & 31, hh = F.lane >> 5;
    const float sink2 = F.in[5][hq] * LOG2E;
    const bool prevok = n > 0;
#pragma unroll 1
    for (int qt = 0; qt < 4; ++qt) {
        const bf16_t* qrow = Qb + (size_t)(128 * n + 32 * qt + r32) * AW + hq * 64 + 8 * hh;
        bf16x8 qf[4];
#pragma unroll
        for (int t = 0; t < 4; ++t) qf[t] = *(const bf16x8*)(qrow + 16 * t);
        f32x16 sacc[6];
#pragma unroll
        for (int x = 0; x < 6; ++x) {
            const int kb = x < 4 - qt ? 32 * (qt + x) : (x < 5 ? 128 + 32 * (x - (4 - qt)) : 256);
            f32x16 acc;
#pragma unroll
            for (int i = 0; i < 16; ++i) acc[i] = 0.f;
#pragma unroll
            for (int t = 0; t < 4; ++t) { const bf16x8 kf = *(const LAS bf16x8*)(Ks + (kb + r32) * ATT_KP + (16 * t + 8 * hh) * 2); acc = __builtin_amdgcn_mfma_f32_32x32x16_bf16(kf, qf[t], acc, 0, 0, 0); }
#pragma unroll
            for (int i = 0; i < 16; ++i) { const int m = (i & 3) + 8 * (i >> 2) + 4 * hh;
                bool vis;
                if (x < 4 - qt) vis = prevok && (x > 0 || m > r32);
                else if (x < 5) vis = (x < 4) || (m <= r32);
                else vis = m < 16;
                acc[i] = vis ? acc[i] : -1e30f; }
            sacc[x] = acc;
        }
        float mx = sink2;
#pragma unroll
        for (int x = 0; x < 6; ++x)
#pragma unroll
            for (int i = 0; i < 16; ++i) mx = fmaxf(mx, sacc[x][i]);
        mx = fmaxf(mx, __shfl_xor(mx, 32));
        float l = 0.f;
#pragma unroll
        for (int x = 0; x < 6; ++x)
#pragma unroll
            for (int i = 0; i < 16; ++i) { const float p = __builtin_amdgcn_exp2f(sacc[x][i] - mx); sacc[x][i] = p; l += p; }
        l += __shfl_xor(l, 32); l += __builtin_amdgcn_exp2f(sink2 - mx);
        f32x16 oacc[2];
#pragma unroll
        for (int dt = 0; dt < 2; ++dt)
#pragma unroll
            for (int i = 0; i < 16; ++i) oacc[dt][i] = 0.f;
#pragma unroll
        for (int x = 0; x < 6; ++x) {
            const int kb = x < 4 - qt ? 32 * (qt + x) : (x < 5 ? 128 + 32 * (x - (4 - qt)) : 256);
#pragma unroll
            for (int t2 = 0; t2 < 2; ++t2) {
                u32x4 pw; pw.x = pg8::cvt_pk_bf16(sacc[x][8 * t2 + 0], sacc[x][8 * t2 + 1]); pw.y = pg8::cvt_pk_bf16(sacc[x][8 * t2 + 2], sacc[x][8 * t2 + 3]);
                pw.z = pg8::cvt_pk_bf16(sacc[x][8 * t2 + 4], sacc[x][8 * t2 + 5]); pw.w = pg8::cvt_pk_bf16(sacc[x][8 * t2 + 6], sacc[x][8 * t2 + 7]);
                const bf16x8 pf = __builtin_bit_cast(bf16x8, pw);
#pragma unroll
                for (int dt = 0; dt < 2; ++dt) { const LAS u32x2* vp = (const LAS u32x2*)(Vs + (32 * dt + r32) * ATT_VP + (kb + 16 * t2 + 4 * hh) * 2);
                    const u32x2 a = vp[0], b = vp[2]; u32x4 vw; vw.x = a.x; vw.y = a.y; vw.z = b.x; vw.w = b.y;
                    oacc[dt] = __builtin_amdgcn_mfma_f32_32x32x16_bf16(__builtin_bit_cast(bf16x8, vw), pf, oacc[dt], 0, 0, 0); }
            }
        }
        const float inv = 1.f / l;
        unsigned char* orow = At + (size_t)(128 * n + 32 * qt + r32) * AW + hq * 64 + 4 * hh;
#pragma unroll
        for (int dt = 0; dt < 2; ++dt)
#pragma unroll
            for (int g = 0; g < 4; ++g) *(unsigned*)(orow + 32 * dt + 8 * g) = pg8::pack4_fp8((f32x4){oacc[dt][4 * g] * inv, oacc[dt][4 * g + 1] * inv, oacc[dt][4 * g + 2] * inv, oacc[dt][4 * g + 3] * inv});
    }
}

constexpr int SSM_NCH = KVROWS / 8, SSM_NBLK = (SSM_NCH + 63) / 64, SSM_EP = 132, SSM_SP = 272, SSM_UP = 272;
constexpr int SSM_UB = 0  , SSM_EB = 3 * 64 * SSM_UP  , SSM_SB = SSM_EB + 2 * 64 * SSM_EP * 4  ;
constexpr int SSM_APOW = SSM_EB, SSM_BBAR = SSM_APOW + 4608, SSM_KD = SSM_BBAR + 8192;
static_assert(SSM_KD + 16384 <= SSM_SB && SSM_SB + 64 * SSM_SP <= LUT_OFF, "SSM LDS");
__device__ __forceinline__ bf16x8 pack_frag(const float (&v)[8]) { u32x4 w; w.x = pk2(v[0], v[1]); w.y = pk2(v[2], v[3]); w.z = pk2(v[4], v[5]); w.w = pk2(v[6], v[7]); return __builtin_bit_cast(bf16x8, w); }
__device__ __forceinline__ f32x2 gelu_pk(f32x2 v) {
    const f32x2 av = __builtin_elementwise_abs(v), d = av * 0.2316418882f + 1.0f;
    f32x2 t; t.x = __builtin_amdgcn_rcpf(d.x); t.y = __builtin_amdgcn_rcpf(d.y);
    f32x2 q = t * 0.5307027145f + (-0.7265760135f); q = q * t + 0.7107068705f; q = q * t + (-0.142248368f); q = q * t + 0.127414796f; q = q * t;
    const f32x2 sq = (v * v) * (-0.72134752044f);
    f32x2 e; e.x = __builtin_amdgcn_exp2f(sq.x); e.y = __builtin_amdgcn_exp2f(sq.y);
    const f32x2 m = v * (q * e), r = v - m;
    f32x2 o; o.x = v.x < 0.f ? m.x : r.x; o.y = v.y < 0.f ? m.y : r.y; return o;
}
__device__ __forceinline__ void ssm_unit(Frame& F, int g, int bfull, int bend) {
    const int tid = F.tid, lane = F.lane, w = F.wave, nl = lane & 15, kg = lane >> 4;
    LAS f32x2* apow = (LAS f32x2*)(F.lds + SSM_APOW);
    LAS f32x2* bbar = (LAS f32x2*)(F.lds + SSM_BBAR);
    LAS float* Kd = (LAS float*)(F.lds + SSM_KD);
    LAS f32x2* clds = (LAS f32x2*)(F.lds + SSM_KD + 8192);
    LAS float* eb = (LAS float*)(F.lds + SSM_EB);
    LAS unsigned char* sb = F.lds + SSM_SB;
    LAS unsigned char* ub = F.lds + SSM_UB;
    const float* Cre = F.in[12] + (size_t)g * 16 * 64; const float* Cim = F.in[13] + (size_t)g * 16 * 64;
    const bf16_t* Ub = WSP(bf16_t, WS_UG) + (size_t)g * KVROWS * 16;
    const int ur0 = tid >> 4, uc0 = tid & 15;
#define SSM_ULOAD(b, r0, r1) do { r0 = *(const u32x4*)(Ub + (size_t)(64 * (b) + ur0) * 128 + uc0 * 8); r1 = *(const u32x4*)(Ub + (size_t)(64 * (b) + 32 + ur0) * 128 + uc0 * 8); } while (0)
#define SSM_USTORE(b, r0, r1) do { LAS unsigned char* u_ = ub + ((b) % 3) * 64 * SSM_UP; *(LAS u32x4*)(u_ + ur0 * SSM_UP + uc0 * 16) = r0; *(LAS u32x4*)(u_ + (32 + ur0) * SSM_UP + uc0 * 16) = r1; } while (0)
    u32x4 ua0, ua1, ub0, ub1;
    __syncthreads();
    SSM_ULOAD(0, ua0, ua1); SSM_ULOAD(1, ub0, ub1);
    { const int p = tid & 63, d = tid >> 6; const float dt = expf(F.in[9][g]), lr = F.in[7][g * 64 + p], li = F.in[8][g * 64 + p];
      { const float mg = expf(d * dt * lr); float sn, cs; sincosf(d * dt * li, &sn, &cs); apow[d * 64 + p] = (f32x2){mg * cs, mg * sn}; }
      if (d == 0) { const float mg = expf(8.f * dt * lr); float sn, cs; sincosf(8.f * dt * li, &sn, &cs); apow[8 * 64 + p] = (f32x2){mg * cs, mg * sn}; }
      if (d == 1) {
        const float em1 = expm1f(dt * lr), th = dt * li; float sn, cs; sincosf(th, &sn, &cs);
        const float ai = (em1 + 1.f) * sn, sh = sinf(0.5f * th), num_re = em1 * cs - 2.f * sh * sh;
        const float den = lr * lr + li * li, cre = (num_re * lr + ai * li) / den, cim = (ai * lr - num_re * li) / den;
        const float* br = F.in[10] + (size_t)(g * 64 + p) * 16; const float* bi = F.in[11] + (size_t)(g * 64 + p) * 16;
#pragma unroll
        for (int h = 0; h < 16; ++h) bbar[p * 16 + h] = (f32x2){cre * br[h] - cim * bi[h], cre * bi[h] + cim * br[h]};
      }
      for (int i = tid; i < 1024; i += 512) clds[i] = (f32x2){Cre[i], Cim[i]};
    }
    SSM_USTORE(0, ua0, ua1); SSM_USTORE(1, ub0, ub1);
    __syncthreads();
    { const int d = tid >> 6, ho = (tid >> 2) & 15, hq = tid & 3; float k0 = 0.f, k1 = 0.f, k2 = 0.f, k3 = 0.f;
#pragma unroll 8
      for (int p = 0; p < 64; ++p) { const f32x2 cc = clds[ho * 64 + p]; const float cr = cc.x, ci = cc.y; const f32x2 a = apow[d * 64 + p]; const float wr = cr * a.x - ci * a.y, wi = cr * a.y + ci * a.x;
          const f32x2 b0 = bbar[p * 16 + 4 * hq], b1 = bbar[p * 16 + 4 * hq + 1], b2 = bbar[p * 16 + 4 * hq + 2], b3 = bbar[p * 16 + 4 * hq + 3];
          k0 += wr * b0.x - wi * b0.y; k1 += wr * b1.x - wi * b1.y; k2 += wr * b2.x - wi * b2.y; k3 += wr * b3.x - wi * b3.y; }
      *(LAS f32x4*)(Kd + (d * 16 + ho) * 16 + 4 * hq) = (f32x4){k0, k1, k2, k3}; }
    __syncthreads();
    bf16x8 bE[4], bT[4], bC[4];
    { const int p = (16 * w + nl) & 63; const bool im = w >= 4;
#pragma unroll
      for (int t = 0; t < 4; ++t) { const int j = 2 * t + (kg >> 1); const f32x2 a = apow[(7 - j) * 64 + p]; float v[8];
#pragma unroll
          for (int jj = 0; jj < 8; ++jj) { const f32x2 b = bbar[p * 16 + 8 * (kg & 1) + jj]; v[jj] = im ? (a.x * b.y + a.y * b.x) : (a.x * b.x - a.y * b.y); }
          bE[t] = pack_frag(v); } }
#pragma unroll
    for (int t = 0; t < 4; ++t) { const int j = 2 * t + (kg >> 1); float v[8];
#pragma unroll
        for (int jj = 0; jj < 8; ++jj) v[jj] = (j <= w) ? Kd[(((w - j) & 7) * 16 + nl) * 16 + 8 * (kg & 1) + jj] : 0.f;
        bT[t] = pack_frag(v); }
#pragma unroll
    for (int t = 0; t < 4; ++t) { float v[8];
#pragma unroll
        for (int jj = 0; jj < 8; ++jj) { const int p = 16 * t + 4 * kg + (jj >> 1); const f32x2 a = apow[(w + 1) * 64 + p]; const f32x2 cc = clds[nl * 64 + p]; const float cr = cc.x, ci = cc.y;
            v[jj] = (jj & 1) == 0 ? (cr * a.x - ci * a.y) : (-cr * a.y - ci * a.x); }
        bC[t] = pack_frag(v); }
    const f32x2 a8 = apow[8 * 64 + lane];
    const int ecol = 2 * ((16 * w + nl) & 63) + (w >> 2);
    bf16_t* Y1 = WSP(bf16_t, WS_Y1); const float dsk = F.in[14][g * 16 + nl];
#define SSM_UFRAG(b, mt, t) (*(const LAS bf16x8*)(ub + ((b) % 3) * 64 * SSM_UP + (16 * (mt) + nl) * SSM_UP + (32 * (t) + 8 * kg) * 2))
#define SSM_EGEMM(b) do { LAS float* e_ = eb + ((b) & 1) * 64 * SSM_EP; _Pragma("unroll") for (int mt = 0; mt < 4; ++mt) { f32x4 c_ = (f32x4){0.f, 0.f, 0.f, 0.f}; \
        _Pragma("unroll") for (int t = 0; t < 4; ++t) c_ = __builtin_amdgcn_mfma_f32_16x16x32_bf16(SSM_UFRAG(b, mt, t), bE[t], c_, 0, 0, 0); \
        _Pragma("unroll") for (int r = 0; r < 4; ++r) e_[(16 * mt + 4 * kg + r) * SSM_EP + ecol] = c_[r]; } } while (0)
    __syncthreads();
    SSM_EGEMM(0);
    f32x2 xs = (f32x2){0.f, 0.f};
    __syncthreads();
#pragma unroll 1
    for (int b = 0; b < bend; ++b) {
        const bool full = b >= bfull;
        if (b + 2 < bend) SSM_ULOAD(b + 2, ua0, ua1);
        if (w == 0) {
            const LAS f32x2* e_ = (const LAS f32x2*)(eb + (b & 1) * 64 * SSM_EP) + lane;
            const f32x2 aa = (f32x2){a8.x, a8.x}, ab = (f32x2){-a8.y, a8.y};
#pragma unroll
            for (int hf = 0; hf < 2; ++hf) { f32x2 ev[32];
#pragma unroll
                for (int c = 0; c < 32; ++c) ev[c] = e_[(32 * hf + c) * (SSM_EP / 2)];
#pragma unroll
                for (int c = 0; c < 32; ++c) { *(LAS unsigned*)(sb + (32 * hf + c) * SSM_SP + lane * 4) = pk2(xs.x, xs.y);
                    xs = aa * xs + (ab * (f32x2){xs.y, xs.x} + ev[c]); } }
        }
        f32x4 acc[4];
        if (full) {
#pragma unroll
            for (int mt = 0; mt < 4; ++mt) { acc[mt] = (f32x4){0.f, 0.f, 0.f, 0.f};
#pragma unroll
                for (int t = 0; t < 4; ++t) acc[mt] = __builtin_amdgcn_mfma_f32_16x16x32_bf16(SSM_UFRAG(b, mt, t), bT[t], acc[mt], 0, 0, 0); }
        }
        if (b + 1 < bend) SSM_EGEMM(b + 1);
        if (b + 2 < bend) SSM_USTORE(b + 2, ua0, ua1);
        __syncthreads();
        if (full) {
#pragma unroll
            for (int mt = 0; mt < 4; ++mt) {
#pragma unroll
                for (int t = 0; t < 4; ++t) { const bf16x8 sf = *(const LAS bf16x8*)(sb + (16 * mt + nl) * SSM_SP + (32 * t + 8 * kg) * 2); acc[mt] = __builtin_amdgcn_mfma_f32_16x16x32_bf16(sf, bC[t], acc[mt], 0, 0, 0); }
            }
            { const LAS unsigned char* u_ = ub + (b % 3) * 64 * SSM_UP;
#pragma unroll
              for (int mt = 0; mt < 4; ++mt)
#pragma unroll
                for (int r2 = 0; r2 < 2; ++r2) { const int row = 16 * mt + 4 * kg + 2 * r2, ch = 64 * b + row, pos = 8 * ch + w;
                    const float u0 = bf2f(*(const LAS bf16_t*)(u_ + row * SSM_UP + (w * 16 + nl) * 2)), u1 = bf2f(*(const LAS bf16_t*)(u_ + (row + 1) * SSM_UP + (w * 16 + nl) * 2));
                    const f32x2 ge = gelu_pk((f32x2){acc[mt][2 * r2] + dsk * u0, acc[mt][2 * r2 + 1] + dsk * u1});
                    if (ch < SSM_NCH && pos >= NMETA) Y1[(size_t)(pos - NMETA) * SW + g * 16 + nl] = (bf16_t)f2bf(ge.x);
                    if (ch + 1 < SSM_NCH && pos + 8 >= NMETA) Y1[(size_t)(pos + 8 - NMETA) * SW + g * 16 + nl] = (bf16_t)f2bf(ge.y); } }
            __syncthreads();
        }
    }
#undef SSM_ULOAD
#undef SSM_USTORE
#undef SSM_UFRAG
#undef SSM_EGEMM
}

__device__ __forceinline__ void ln1_pass(Frame& F) {
    const int gw = F.c * 8 + F.wave, NGW = F.G * 8;
    const bf16_t* H = WSP(bf16_t, WS_H1F); const bf16_t* H0 = WSP(bf16_t, WS_H0B); bf16_t* Hb = WSP(bf16_t, WS_H1B); unsigned char* Hq = WSP(unsigned char, WS_H1LO);
    stage_gb(F, F.in[18], F.in[19]);
    const LAS f32x4* gl = (const LAS f32x4*)F.lds; const LAS f32x4* bl = (const LAS f32x4*)(F.lds + 16384);
#pragma unroll 1
    for (int r = gw; r < T_TOK; r += NGW) {
        const u32x2* x = (const u32x2*)(H + (size_t)r * DM) + F.lane; const u32x2* x0 = (const u32x2*)(H0 + (size_t)r * DM) + F.lane;
        u32x2* ob = (u32x2*)(Hb + (size_t)r * DM) + F.lane; unsigned* oq = (unsigned*)(Hq + (size_t)r * DM) + F.lane;
        float s = 0.f, q = 0.f;
#pragma unroll
        for (int j = 0; j < 16; ++j) { const u32x2 w = x[64 * j], w0 = x0[64 * j];
            const f32x4 v = (f32x4){bf_lo(w0.x), bf_hi(w0.x), bf_lo(w0.y), bf_hi(w0.y)} * ALPHA + (f32x4){bf_lo(w.x), bf_hi(w.x), bf_lo(w.y), bf_hi(w.y)};
            s += (v[0] + v[1]) + (v[2] + v[3]); q += (v[0] * v[0] + v[1] * v[1]) + (v[2] * v[2] + v[3] * v[3]); }
        const float mean = wave_sum(s) * (1.f / DM), var = fmaxf(wave_sum(q) * (1.f / DM) - mean * mean, 0.f), rstd = 1.f / sqrtf(var + LN_EPS);
        asm volatile("" ::: "memory");
#pragma unroll
        for (int j = 0; j < 16; ++j) { const u32x2 w = __builtin_nontemporal_load(x + 64 * j), w0 = __builtin_nontemporal_load(x0 + 64 * j);
            const f32x4 v = (f32x4){bf_lo(w0.x), bf_hi(w0.x), bf_lo(w0.y), bf_hi(w0.y)} * ALPHA + (f32x4){bf_lo(w.x), bf_hi(w.x), bf_lo(w.y), bf_hi(w.y)};
            const f32x4 y = (v - mean) * rstd * gl[F.lane + 64 * j] + bl[F.lane + 64 * j];
            ob[64 * j] = (u32x2){pk2(y[0], y[1]), pk2(y[2], y[3])}; __builtin_nontemporal_store(pg8::pack4_fp8(y), oq + 64 * j);
            if ((j & 3) == 3) asm volatile("" ::: "memory"); }
    }
}

__device__ __forceinline__ void route_pass(Frame& F) {
    const int gw = F.c * 8 + F.wave, NGW = F.G * 8, lane = F.lane;
    LAS unsigned* hist = (LAS unsigned*)F.lds;
    __syncthreads();
    if (F.tid < NE) hist[F.tid] = 0u;
    __syncthreads();
    const float* Lg = WSP(float, WS_LOGITS); int* TI = WSP(int, WS_TOPI); float* TW = WSP(float, WS_TOPW);
    const float bias = F.in[21][lane];
    constexpr int RT = 4;
    for (int t = gw; t < T_TOK; t += RT * NGW) {
        float score[RT], sel[RT], val[RT], myw[RT], wsum[RT]; int myi[RT];
#pragma unroll
        for (int q = 0; q < RT; ++q) { const int tq = (t + q * NGW < T_TOK) ? t + q * NGW : t;
            const float lg = Lg[(size_t)tq * 128 + lane] + Lg[(size_t)tq * 128 + 64 + lane];
            score[q] = 1.f / (1.f + expf(-lg)); sel[q] = score[q] + bias; }
#pragma unroll
        for (int q = 0; q < RT; ++q) {
            int rk = 0;
#pragma unroll
            for (int x = 1; x < 8; ++x) { const float o = __shfl_xor(sel[q], x); const int pl = lane ^ x; rk += (o > sel[q] || (o == sel[q] && pl < lane)) ? 1 : 0; }
            float gs = rk < 2 ? sel[q] : 0.f; gs += __shfl_xor(gs, 1); gs += __shfl_xor(gs, 2); gs += __shfl_xor(gs, 4);
            int grk = 0; const int mg = lane >> 3;
#pragma unroll
            for (int x = 1; x < 8; ++x) { const float o = __shfl_xor(gs, 8 * x); const int og = mg ^ x; grk += (o > gs || (o == gs && og < mg)) ? 1 : 0; }
            val[q] = grk < 4 ? sel[q] : -1e30f; myi[q] = 0; myw[q] = 0.f; wsum[q] = 0.f; }
#pragma unroll
        for (int k = 0; k < TOPK; ++k)
#pragma unroll
            for (int q = 0; q < RT; ++q) {
                const float mx = wave_max(val[q]); const unsigned long long bal = __ballot(val[q] == mx); const int win = __builtin_ctzll(bal);
                const float ws = __shfl(score[q], win); wsum[q] += ws;
                if (lane == k) { myi[q] = win; myw[q] = ws; }
                if (lane == win) val[q] = -3e38f; }
#pragma unroll
        for (int q = 0; q < RT; ++q) { const int tq = t + q * NGW;
            if (tq < T_TOK && lane < TOPK) { TI[tq * TOPK + lane] = myi[q]; TW[tq * TOPK + lane] = myw[q] / wsum[q] * 2.5f; __hip_atomic_fetch_add(&hist[myi[q]], 1u, __ATOMIC_RELAXED, __HIP_MEMORY_SCOPE_WORKGROUP); } }
    }
    __syncthreads();
    if (F.tid < NE && hist[F.tid]) __hip_atomic_fetch_add(F.ctl + CW_CNT + F.tid, hist[F.tid], RLX_AGENT);
    __syncthreads();
}

__device__ __forceinline__ void lists_pass(Frame& F) {
    LAS int* sh = (LAS int*)F.lds;
    const int* TI = WSP(int, WS_TOPI); int* POS = WSP(int, WS_POS); int* RT = WSP(int, WS_ROWTOK); int* TE = WSP(int, WS_TILEE); int* UT = WSP(int, WS_UTAB);
    for (int e = F.c; e < NE; e += F.G) {
        __syncthreads();
        if (F.tid < NE) sh[F.tid] = (int)__hip_atomic_load(F.ctl + CW_CNT + F.tid, RLX_AGENT);
        __syncthreads();
        int tb = 0; for (int j = 0; j < e; ++j) tb += (sh[j] + 255) >> 8;
        const int cnt = sh[e], mytiles = (cnt + 255) >> 8, base = tb * 256;
        if (e == NE - 1 && F.tid == 0) __hip_atomic_store(F.ctl + CW_NTILES, (unsigned)(tb + mytiles), RLX_AGENT);
        int kk[16]; int loc = 0;
#pragma unroll
        for (int j = 0; j < 16; ++j) { const int t = F.tid * 16 + j; const u32x4 a = *(const u32x4*)(TI + t * 8), b = *(const u32x4*)(TI + t * 8 + 4);
            int k = -1; k = (int)a.x == e ? 0 : k; k = (int)a.y == e ? 1 : k; k = (int)a.z == e ? 2 : k; k = (int)a.w == e ? 3 : k; k = (int)b.x == e ? 4 : k; k = (int)b.y == e ? 5 : k; k = (int)b.z == e ? 6 : k; k = (int)b.w == e ? 7 : k;
            kk[j] = k; loc += (k >= 0) ? 1 : 0; }
        int inc = loc;
#pragma unroll
        for (int o = 1; o < 64; o <<= 1) { const int v = __shfl_up(inc, o); if (F.lane >= o) inc += v; }
        if (F.lane == 63) sh[64 + F.wave] = inc;
        __syncthreads();
        int woff = 0; for (int w = 0; w < F.wave; ++w) woff += sh[64 + w];
        int rank = woff + inc - loc;
#pragma unroll
        for (int j = 0; j < 16; ++j) if (kk[j] >= 0) { const int t = F.tid * 16 + j; RT[base + rank] = t; POS[t * 8 + kk[j]] = base + rank; ++rank; }
        for (int i = cnt + F.tid; i < mytiles * 256; i += 512) RT[base + i] = 0;
        if (F.tid < mytiles) TE[tb + F.tid] = e;
        for (int idx = F.tid; idx < mytiles * 16; idx += 512) { const int pb = idx / (mytiles * 8), rem = idx % (mytiles * 8), t = rem >> 3, pn = pb * 8 + (rem & 7);
            UT[tb * 16 + idx] = (tb + t) | (pn << 16) | (e << 24); }
    }
}

__device__ __forceinline__ void combine_pass(Frame& F) {
    const int gw = F.c * 8 + F.wave, NGW = F.G * 8;
    const bf16_t* H = WSP(bf16_t, WS_H1B); const unsigned char* Y = WSP(unsigned char, WS_YB); const int* POS = WSP(int, WS_POS); const float* TW = WSP(float, WS_TOPW);
    stage_gb(F, F.in[28], F.in[29]);
    for (int t = gw; t < T_TOK; t += NGW) {
        f32x4 v[16]; const u32x2* hr = (const u32x2*)(H + (size_t)t * DM) + F.lane;
#pragma unroll
        for (int j = 0; j < 16; ++j) { const u32x2 h = __builtin_nontemporal_load(hr + 64 * j); v[j] = (f32x4){bf_lo(h.x), bf_hi(h.x), bf_lo(h.y), bf_hi(h.y)}; }
#pragma unroll 2
        for (int k = 0; k < TOPK; ++k) { const int row = POS[t * TOPK + k]; const float w = TW[t * TOPK + k]; const unsigned* yr = (const unsigned*)(Y + (size_t)row * DM) + F.lane;
#pragma unroll
            for (int j = 0; j < 16; ++j) { const int y = (int)__builtin_nontemporal_load(yr + 64 * j); const f32x2 lo = __builtin_amdgcn_cvt_pk_f32_fp8(y, false), hi = __builtin_amdgcn_cvt_pk_f32_fp8(y, true); v[j] += (f32x4){lo.x, lo.y, hi.x, hi.y} * w; } }
        float s = 0.f;
#pragma unroll
        for (int j = 0; j < 16; ++j) s += (v[j][0] + v[j][1]) + (v[j][2] + v[j][3]);
        const float mean = wave_sum(s) * (1.f / DM); float s2 = 0.f;
#pragma unroll
        for (int j = 0; j < 16; ++j) { v[j] = v[j] - mean; s2 += (v[j][0] * v[j][0] + v[j][1] * v[j][1]) + (v[j][2] * v[j][2] + v[j][3] * v[j][3]); }
        const float rstd = 1.f / sqrtf(wave_sum(s2) * (1.f / DM) + LN_EPS);
        f32x4* o = (f32x4*)(F.out + (size_t)t * DM) + F.lane;
        asm volatile("" ::: "memory");
#pragma unroll
        for (int j = 0; j < 16; ++j) { const f32x4 gg = ((const LAS f32x4*)F.lds)[F.lane + 64 * j], bb = ((const LAS f32x4*)(F.lds + 16384))[F.lane + 64 * j]; __builtin_nontemporal_store(v[j] * rstd * gg + bb, o + 64 * j); }
    }
}

#ifndef DUMP
#define DUMP 0
#endif
__device__ __forceinline__ void dump_f32(Frame& F, const float* src) {
    for (size_t i = (size_t)F.c * 512 + F.tid; i < (size_t)T_TOK * DM / 4; i += (size_t)F.G * 512) ((f32x4*)F.out)[i] = ((const f32x4*)src)[i];
}
__device__ __forceinline__ void dump_bf16(Frame& F, const bf16_t* src, int ld, int ncols, int colofs, size_t nrows) {
    for (size_t i = (size_t)F.c * 512 + F.tid; i < nrows * ncols; i += (size_t)F.G * 512) { const size_t r = i / ncols, c = i % ncols; if (r < T_TOK) F.out[r * DM + colofs + c] = bf2f(src[r * ld + c]); }
}
__device__ __forceinline__ void dump_zero(Frame& F) {
    for (size_t i = (size_t)F.c * 512 + F.tid; i < (size_t)T_TOK * DM / 4; i += (size_t)F.G * 512) ((f32x4*)F.out)[i] = (f32x4){0.f, 0.f, 0.f, 0.f};
}
__device__ __forceinline__ void p1_convert(Frame& F, int when) {
    int c = F.c; asm volatile("" : "+s"(c));
    LAS unsigned* scr = (LAS unsigned*)(F.lds + F.wave * 8704);
    const bool split = (F.G == 256);
    const int NT = split ? CVT_P1_TILES : 3 * NE * 64 * 8;
    if (!split) { if (when == 0) { cvt_run(F, 1, 8, c * 8 + F.wave, F.G * 8, scr); cvt_run(F, 8, 11, c * 8 + F.wave, F.G * 8, scr); } return; }
    const int nA = 58, sB = 312, sA = 372;
    const int kc = (c >> 3) & 1;
    if (kc != when) return;
    int tlo, thi;
    if (c < 256 - nA) { tlo = c * sB; thi = tlo + sB; } else { tlo = (256 - nA) * sB + (c - (256 - nA)) * sA; thi = tlo + sA; }
    if (thi > NT) thi = NT; if (tlo > NT) tlo = NT;
    cvt_run(F, 8, 11, F.wave, 8, scr, tlo, thi);
    cvt_run(F, 1, 8, c * 8 + F.wave, F.G * 8, scr);
}
struct Args { const float* in[30]; float* out; unsigned char* ws; int ph_lo, ph_hi, one, pad; };
__global__ void __launch_bounds__(512, 2) mk_fwd(Args args) {
    extern __shared__ __attribute__((aligned(16))) unsigned char lds[];
    Frame F;
    F.lds = (LAS unsigned char*)lds; F.ws = args.ws; F.ctl = (gu32*)(args.ws + WS_CTL);
    F.tid = threadIdx.x; F.lane = F.tid & 63; F.wave = __builtin_amdgcn_readfirstlane(F.tid >> 6); F.G = gridDim.x; F.c = blockIdx.x;
    F.in = args.in; F.out = args.out;
    volatile LAS unsigned* MISC = (volatile LAS unsigned*)(F.lds + MISC_OFF);
    for (int u = F.tid; u < (LDS_BYTES - RING_BYTES) / 4; u += 512) ((LAS unsigned*)(F.lds + RING_BYTES))[u] = 0u;
    __syncthreads();
    XcdBarrier bar; bar.bar = (unsigned*)(F.ctl + CW_BAR); bar.x = 0; bar.st = nullptr;
    if (args.one) bar = xcd_barrier_post((unsigned*)(F.ctl + CW_BAR), MISC + 8);
    const int lo = args.ph_lo, hi = args.ph_hi;
#ifndef PH_MASK
#define PH_MASK 0xffffffffu
#endif
#define IN(k) (((PH_MASK >> (k)) & 1u) && lo <= (k) && (k) < hi)
#define SEAM(k) do { if (IN(k) && IN((k) + 1)) xcd_barrier(bar); REFRESH(); } while (0)
#define REFRESH() do { int t_ = threadIdx.x; asm volatile("" : "+v"(t_)); F.tid = t_; F.lane = t_ & 63; F.wave = __builtin_amdgcn_readfirstlane(t_ >> 6); } while (0)
#ifndef HOT12
#define HOT12 0
#endif
#ifndef PROBE_REP
#define PROBE_REP 0u
#endif
#define RUN(k, ...) if (IN(k)) { __VA_ARGS__ if ((PROBE_REP >> (k)) & 1u) { xcd_barrier(bar); REFRESH(); __VA_ARGS__ } }
    LAS unsigned char* ring = F.lds;

    RUN(0, { p0_prologue(F);  }) SEAM(0);
    RUN(1, {
        p1_convert(F, 0); __syncthreads();
        { pg8::DenseSched S{(const char*)WSP(unsigned char, WS_H0Q), (const char*)(WSP(unsigned char, WS_WING) + (size_t)10240 * DM), DM / 2, 33, 6, F.G, F.c, 0, 0, 0};
          pg8::EpiZ E{WSP(bf16_t, WS_KB), WSP(bf16_t, WS_VB), WSP(bf16_t, WS_UG)};
          pg8::gemm_phase<pg8::EpiZ, pg8::DenseSched, true>(ring, F.tid, DM / 2, DM / 2, S, E); }
        __syncthreads(); REFRESH();
        { pg8::DenseSched S{(const char*)WSP(unsigned char, WS_H0Q), (const char*)WSP(unsigned char, WS_WING), DM / 2, 32, 40, F.G, F.c, 0, 0, 0};
          pg8::EpiGate EG{WSP(bf16_t, WS_QB), WSP(bf16_t, WS_GA), WSP(bf16_t, WS_GS)};
          pg8::gemm_phase<pg8::EpiGate, pg8::DenseSched, true>(ring, F.tid, DM / 2, DM / 2, S, EG); }
        __syncthreads(); p1_convert(F, 1);
    }) SEAM(1);
    RUN(2, {
        const bool big = F.G >= 256; const int ntask = big ? 128 : 64;
        for (int t = F.c; t < ntask; t += F.G) { const int g = big ? t >> 1 : t, hf = big ? (t & 1) : 0; ssm_unit(F, g, hf ? 11 : 0, (big && !hf) ? 11 : SSM_NBLK); }
        const int a0 = big ? F.c - 128 : F.c, astep = big ? F.G - 128 : F.G;
        if (a0 >= 0) for (int u = a0; u < 256; u += astep) attn_unit(F, u >> 2, u & 3);
    }) SEAM(2);
    RUN(3, {
        pg8::DenseSched S{(const char*)WSP(unsigned char, WS_ATT), (const char*)WSP(unsigned char, WS_WAO), AW / 2, 32, 16, F.G, F.c, 0, 0, 0};
        pg8::EpiMix<false> E{WSP(bf16_t, WS_GA), WSP(bf16_t, WS_MIX), nullptr};
        pg8::gemm_phase<pg8::EpiMix<false>, pg8::DenseSched, true>(ring, F.tid, AW / 2, AW / 2, S, E);
    }) REFRESH();
    RUN(4, {
        if (F.G == 256 && F.c >= 128) { LAS unsigned* scr = (LAS unsigned*)(F.lds + F.wave * 8704); const int t0 = CVT_P1_TILES + (F.c - 128) * CVT_P4_PER; cvt_run(F, 8, 11, F.wave, 8, scr, t0, t0 + CVT_P4_PER); }
        pg8::DenseSched S{(const char*)WSP(bf16_t, WS_Y1), (const char*)WSP(bf16_t, WS_WGLU), SW, 32, 4, F.G, F.c, 0, 0, 0};
        pg8::EpiGlu E{WSP(bf16_t, WS_Y1), WSP(unsigned char, WS_Y2)};
        pg8::gemm_phase(ring, F.tid, SW, SW, S, E);
    }) SEAM(4);
    RUN(5, {
        pg8::DenseSched S{(const char*)WSP(unsigned char, WS_Y2), (const char*)WSP(unsigned char, WS_WSO), SW / 2, 32, 16, F.G, F.c, 0, 0, 0};
        pg8::EpiMix<true> E{WSP(bf16_t, WS_GS), WSP(bf16_t, WS_MIX), WSP(unsigned char, WS_H0Q)};
        pg8::gemm_phase<pg8::EpiMix<true>, pg8::DenseSched, true>(ring, F.tid, SW / 2, SW / 2, S, E);
    }) SEAM(5);
    RUN(6, {
        pg8::DenseSched S{(const char*)WSP(unsigned char, WS_H0Q), (const char*)WSP(unsigned char, WS_WOUT), DM / 2, 32, 16, F.G, F.c, 0, 0, 0};
        pg8::EpiWout E{WSP(bf16_t, WS_H1F)};
        pg8::gemm_phase<pg8::EpiWout, pg8::DenseSched, true>(ring, F.tid, DM / 2, DM / 2, S, E);
    }) SEAM(6);
    RUN(7, { ln1_pass(F);  }) SEAM(7);
    RUN(8, {
        if (F.G == 256 && F.c >= 160) { LAS unsigned* scr = (LAS unsigned*)(F.lds + F.wave * 8704); const int t0 = CVT_P1_TILES + CVT_P4_TILES + (F.c - 160) * CVT_P8_PER; cvt_run(F, 8, 11, F.wave, 8, scr, t0, t0 + CVT_P8_PER); }
        pg8::DenseSched S{(const char*)WSP(bf16_t, WS_H1B), (const char*)WSP(bf16_t, WS_WS13), DM, 32, 5, F.G, F.c, 0, 0, 0};
        pg8::EpiS13R E{WSP(bf16_t, WS_ACTS), WSP(float, WS_LOGITS)};
        pg8::gemm_phase(ring, F.tid, DM, DM, S, E);
    }) SEAM(8);
    RUN(9, { route_pass(F);  }) SEAM(9);
    RUN(10, { lists_pass(F);
        if (F.G == 256 && args.one && F.c >= 64) { pg8::DenseSched S{(const char*)WSP(bf16_t, WS_ACTS), (const char*)WSP(bf16_t, WS_WS2), EDIM, 32, 16, 192, F.c - 64, 0, 0, 0}; S.i1 = 2;
            pg8::EpiS2 E{WSP(bf16_t, WS_H1B)};
            pg8::gemm_phase(ring, F.tid, EDIM, EDIM, S, E); }
    }) SEAM(10);
    RUN(11, {
        const int ntiles = __builtin_amdgcn_readfirstlane((int)__hip_atomic_load(F.ctl + CW_NTILES, RLX_AGENT));
        { pg8::MoeSched S{(const char*)WSP(unsigned char, WS_H1LO), (const char*)WSP(unsigned char, WS_WE13), DM / 2, WSP(int, WS_ROWTOK), WSP(int, WS_TILEE), 4, (size_t)1024 * DM, ntiles * 4, F.G, F.c};
          pg8::EpiAct E{WSP(unsigned char, WS_ACT)};
          pg8::gemm_phase<pg8::EpiAct, pg8::MoeSched, true>(ring, F.tid, DM / 2, DM / 2, S, E); }
        { const bool early = (F.G == 256 && args.one);
          const int rem = (ntiles * 4) % F.G, nl = F.G - rem; const bool lite = early && rem > 0 && nl >= 64;
          if (!lite || F.c >= rem) {
          pg8::DenseSched S{(const char*)WSP(bf16_t, WS_ACTS), (const char*)WSP(bf16_t, WS_WS2), EDIM, 32, 16, lite ? nl : F.G, lite ? F.c - rem : F.c, 0, 0, 0}; S.l0 = early ? 384 : 0;
          pg8::EpiS2 E{WSP(bf16_t, WS_H1B)};
          pg8::gemm_phase(ring, F.tid, EDIM, EDIM, S, E); } }
    }) SEAM(11);
    RUN(12, {
        const int ntiles = __builtin_amdgcn_readfirstlane((int)__hip_atomic_load(F.ctl + CW_NTILES, RLX_AGENT)); const int nunits = ntiles * 16;
        LAS int* lut = (LAS int*)(F.lds + LUT_OFF);
#if HOT12
        __syncthreads();
        if (F.tid < 64) lut[F.tid] = (F.c & 3) | (((F.c >> 2) & 15) << 16);
        __syncthreads();
        { pg8::MoeTabSched S{(const char*)WSP(unsigned char, WS_ACT), (const char*)WSP(unsigned char, WS_WE2), EDIM / 2, lut, (size_t)DM * EDIM, nunits, F.G, F.c};
          pg8::EpiY E{WSP(unsigned char, WS_YB)};
          pg8::gemm_phase<pg8::EpiY, pg8::MoeTabSched, true>(ring, F.tid, EDIM / 2, EDIM / 2, S, E); }
        xcd_barrier(bar); REFRESH();
#endif
        __syncthreads();
        if (F.tid < 64) { const int L = F.tid * F.G + F.c; lut[F.tid] = L < nunits ? WSP(int, WS_UTAB)[pg8::xcd_remap(L, nunits)] : 0; }
        __syncthreads();
        pg8::MoeTabSched S{(const char*)WSP(unsigned char, WS_ACT), (const char*)WSP(unsigned char, WS_WE2), EDIM / 2, lut, (size_t)DM * EDIM, nunits, F.G, F.c};
        pg8::EpiY E{WSP(unsigned char, WS_YB)};
        pg8::gemm_phase<pg8::EpiY, pg8::MoeTabSched, true>(ring, F.tid, EDIM / 2, EDIM / 2, S, E);
    }) SEAM(12);
    RUN(13, { combine_pass(F);  })
#if DUMP
    if (lo <= 14 && 14 < hi) {
#if DUMP == 1
        dump_f32(F, WSP(float, WS_H1F));
#elif DUMP == 2
        dump_bf16(F, WSP(bf16_t, WS_MIX), DM, DM, 0, T_TOK);
#elif DUMP == 3
        dump_zero(F); __syncthreads();
        dump_bf16(F, WSP(bf16_t, WS_ATT), AW, AW, 0, T_TOK); dump_bf16(F, WSP(bf16_t, WS_Y1), SW, SW, AW, T_TOK);
#elif DUMP == 4
        dump_zero(F); __syncthreads();
        dump_bf16(F, WSP(bf16_t, WS_QB), AW, AW, 0, T_TOK); dump_bf16(F, WSP(bf16_t, WS_KB), KVW, KVW, AW, T_TOK); dump_bf16(F, WSP(bf16_t, WS_VB), KVW, KVW, AW + KVW, T_TOK);
        dump_bf16(F, WSP(bf16_t, WS_UG), 1026, 1026, AW + 2 * KVW, T_TOK);
#elif DUMP == 5
        dump_bf16(F, WSP(bf16_t, WS_GA), DM, DM, 0, T_TOK);
#elif DUMP == 7
        dump_bf16(F, WSP(bf16_t, WS_WIN) + (size_t)3584 * DM, DM, DM, 0, T_TOK);
#elif DUMP == 6
        dump_bf16(F, WSP(bf16_t, WS_H0B), DM, DM, 0, T_TOK);
#endif
    }
#endif
#undef IN
#undef SEAM
}

#ifndef PH_MASK
#define PH_MASK_HOST 0xffffffffu
#else
#define PH_MASK_HOST (PH_MASK)
#endif
extern "C" void kernel_launch(void* const* d_in, const int* in_sizes, int n_in, void* d_out, int out_size, void* d_ws, size_t ws_size, hipStream_t stream) {
    static int grid = 0;
    if (grid == 0) {
        if (n_in != 30 || in_sizes[0] != T_TOK * DM || out_size != T_TOK * DM || ws_size < WS_END) { fprintf(stderr, "kernel_launch: unexpected shapes / workspace (n_in %d, ws %zu, need %zu)\n", n_in, ws_size, (size_t)WS_END); grid = -1; return; }
        int dev = 0, cus = 0, per_cu = 0;
        if (hipGetDevice(&dev) != hipSuccess || hipDeviceGetAttribute(&cus, hipDeviceAttributeMultiprocessorCount, dev) != hipSuccess) { grid = -1; return; }
        if (hipFuncSetAttribute((const void*)mk_fwd, hipFuncAttributeMaxDynamicSharedMemorySize, LDS_BYTES) != hipSuccess) { fprintf(stderr, "kernel_launch: hipFuncSetAttribute failed\n"); grid = -1; return; }
        if (hipOccupancyMaxActiveBlocksPerMultiprocessor(&per_cu, (const void*)mk_fwd, 512, LDS_BYTES) != hipSuccess || per_cu < 1) fprintf(stderr, "kernel_launch: occupancy query reports %d\n", per_cu);
        (void)hipGetLastError();
        grid = cus;
    }
    if (grid < 0) return;
    if (hipMemsetAsync((char*)d_ws + WS_CTL, 0, CTL_ZERO_BYTES, stream) != hipSuccess) return;
    Args a{};
    for (int i = 0; i < 30; ++i) a.in[i] = (const float*)d_in[i];
    a.out = (float*)d_out; a.ws = (unsigned char*)d_ws; a.pad = 0;
#if MK_ONE_LAUNCH
    a.ph_lo = 0; a.ph_hi = NPHASE; a.one = 1;
    hipLaunchKernelGGL(mk_fwd, dim3(grid), dim3(512), LDS_BYTES, stream, a);
#else
    for (int p = 0; p < NPHASE + (DUMP ? 1 : 0); ++p) { a.ph_lo = p; a.ph_hi = p + 1; a.one = 0;
        if (!((PH_MASK_HOST >> p) & 1u)) continue;
        hipLaunchKernelGGL(mk_fwd, dim3(grid), dim3(512), LDS_BYTES, stream, a); }
#endif
}
```

```cpp
#include <hip/hip_runtime.h>
#include <cstdio>
#include <cstdint>

#define LAS __attribute__((address_space(3)))
#define GAS __attribute__((address_space(1)))
typedef unsigned short bf16_t;
typedef short bf16x8 __attribute__((ext_vector_type(8)));
typedef float f32x4 __attribute__((ext_vector_type(4)));
typedef float f32x2 __attribute__((ext_vector_type(2)));
typedef unsigned u32x4 __attribute__((ext_vector_type(4)));
typedef unsigned u32x2 __attribute__((ext_vector_type(2)));
typedef GAS unsigned gu32;

#ifndef MK_ONE_LAUNCH
#define MK_ONE_LAUNCH 1
#endif

constexpr int T_TOK = 8192, DM = 4096, NMETA = 16, ROWS_Z = 8448, KVROWS = 8208;
constexpr int NZ = 11776, AW = 2048, KVW = 256, SW = 1024;
constexpr int NE = 64, TOPK = 8, EDIM = 512;
constexpr float ALPHA = 1.189207115002721f;
constexpr float LN_EPS = 1e-5f;
constexpr float LOG2E = 1.4426950408889634f;
constexpr float QSCALE = 0.125f * LOG2E;
constexpr int MAXTILES = 320;
constexpr int NPHASE = 14;
constexpr int CVT_P11_TILES = 4608;
constexpr int CVT_P8_PER = 120, CVT_P4_PER = 28, CVT_P8_TILES = 96 * CVT_P8_PER, CVT_P4_TILES = 128 * CVT_P4_PER, CVT_P1_TILES = 3 * NE * 64 * 8 - CVT_P8_TILES - CVT_P4_TILES - CVT_P11_TILES;

constexpr size_t MiB = 1u << 20;
constexpr size_t WS_CTL = 0, CTL_ZERO_BYTES = 32768;
constexpr size_t WS_TOPI = 1 * MiB, WS_TOPW = WS_TOPI + 256 * 1024, WS_POS = WS_TOPW + 256 * 1024;
constexpr size_t WS_ROWTOK = 2 * MiB, WS_TILEE = 2 * MiB + 512 * 1024, WS_UTAB = WS_TILEE + 8192  , WS_STATS0 = 2 * MiB + 768 * 1024;
constexpr size_t WS_SSME = 3 * MiB, WS_LOGITS = 4 * MiB;
constexpr size_t WS_H1F = 8 * MiB, WS_H1B = 136 * MiB, WS_H1LO = 200 * MiB, WS_ACT = 264 * MiB, WS_ACTS = 344 * MiB;
constexpr size_t WS_WE2 = 352 * MiB, WS_WS2 = 608 * MiB, WS_WS13 = 612 * MiB;
constexpr size_t WS_WE13 = 640 * MiB, WS_WIN = 1152 * MiB, WS_WAO = 1244 * MiB, WS_WGLU = 1260 * MiB, WS_WSO = 1262 * MiB, WS_WOUT = 1270 * MiB;
constexpr size_t WS_H0B = 1302 * MiB, WS_QB = 1368 * MiB, WS_KB = 1400 * MiB, WS_VB = 1405 * MiB, WS_UG = 1410 * MiB;
constexpr size_t WS_GA = 1427 * MiB, WS_GS = 1491 * MiB, WS_ATT = 1555 * MiB, WS_Y1 = 1587 * MiB, WS_Y2 = 1603 * MiB, WS_MIX = 1619 * MiB;
constexpr size_t WS_END = 1683 * MiB;
constexpr size_t WS_WING = WS_WIN + 16 * MiB;
constexpr size_t WS_H0Q = WS_ACT + 40 * MiB;
constexpr size_t WS_YB = 640 * MiB;
static_assert(WS_YB + (size_t)MAXTILES * 256 * DM * 2 <= WS_H0B, "YB overlay");
constexpr int CW_TMO = 0, CW_CODE = 1, CW_NTILES = 64, CW_CNT = 128  , CW_BAR = 4096;

constexpr int RING_BYTES = 131072, LDS_BYTES = 147456, MISC_OFF = LDS_BYTES - 256, LUT_OFF = LDS_BYTES - 1024;

#define RLX_AGENT __ATOMIC_RELAXED, __HIP_MEMORY_SCOPE_AGENT
#define LDS_WAIT() asm volatile("s_waitcnt lgkmcnt(0)" ::: "memory")
#define VM_WAIT() asm volatile("s_waitcnt vmcnt(0)" ::: "memory")
__device__ __forceinline__ unsigned f2bf(float f) { unsigned u = __builtin_bit_cast(unsigned, f); return (u + 0x7fffu + ((u >> 16) & 1u)) >> 16; }
typedef __bf16 bf16x2_t __attribute__((ext_vector_type(2)));
__device__ __forceinline__ unsigned pk2(float lo, float hi) { f32x2 v = {lo, hi}; bf16x2_t b = __builtin_convertvector(v, bf16x2_t); return __builtin_bit_cast(unsigned, b); }
__device__ __forceinline__ float bf_lo(unsigned w) { return __builtin_bit_cast(float, w << 16); }
__device__ __forceinline__ float bf_hi(unsigned w) { return __builtin_bit_cast(float, w & 0xffff0000u); }
__device__ __forceinline__ float bf2f(bf16_t h) { return __builtin_bit_cast(float, ((unsigned)h) << 16); }
__device__ __forceinline__ float fast_sigmoid(float x) { return __builtin_amdgcn_rcpf(1.0f + __builtin_amdgcn_exp2f(-x * LOG2E)); }
__device__ __forceinline__ float wave_sum(float v) {
#pragma unroll
    for (int o = 1; o < 64; o <<= 1) v += __shfl_xor(v, o);
    return v;
}
__device__ __forceinline__ float wave_max(float v) {
#pragma unroll
    for (int o = 1; o < 64; o <<= 1) v = fmaxf(v, __shfl_xor(v, o));
    return v;
}

#define XB_TMO      128
#define XB_XCNT(j)  (256  + 64 * (j))
#define XB_XSUB(j)  (1280 + 64 * (j))
#define XB_XGEN(j)  (2304 + 64 * (j))
#define XB_TOP      3328
#define XB_TOPGEN   3392
#define XCD_BAR_WORDS 3456
#define XB_SPIN_CAP (1u << 18)
__device__ __forceinline__ unsigned xb_ld(unsigned* p)              { return __hip_atomic_load(p, __ATOMIC_RELAXED, __HIP_MEMORY_SCOPE_AGENT); }
__device__ __forceinline__ unsigned xb_add(unsigned* p, unsigned v) { return __hip_atomic_fetch_add(p, v, __ATOMIC_RELAXED, __HIP_MEMORY_SCOPE_AGENT); }
__device__ __forceinline__ unsigned xb_xcc_id() { return (unsigned)__builtin_amdgcn_s_getreg((3 << 11) | 20) & 0xFu; }
#define XB_SPIN(cond, bar) do { unsigned _sp = 0; while (cond) { __builtin_amdgcn_s_sleep(1); \
    if ((++_sp & 255u) == 0u) { if (xb_ld(&(bar)[XB_TMO])) break; if (_sp > XB_SPIN_CAP) { atomicAdd(&(bar)[XB_TMO], 1u); break; } } } } while (0)
struct XcdBarrier { unsigned* bar; unsigned x; volatile LAS unsigned* st; };
__device__ __forceinline__ XcdBarrier xcd_barrier_post(unsigned* bar, volatile LAS unsigned* st) {
    XcdBarrier b; b.bar = bar; b.x = xb_xcc_id(); b.st = st;
    if (threadIdx.x == 0) (void)xb_add(&bar[XB_XCNT(b.x)], 1u);
    return b;
}
__device__ __forceinline__ void xcd_barrier_complete(unsigned* bar, unsigned x, unsigned& nloc, unsigned& nx) {
    const unsigned G = gridDim.x * gridDim.y * gridDim.z;
    unsigned sum, cnt, mine, sp = 0u;
    for (;;) {
        sum = 0u; cnt = 0u; mine = 0u;
#pragma unroll
        for (unsigned j = 0; j < 16; ++j) { const unsigned c = xb_ld(&bar[XB_XCNT(j)]); sum += c; cnt += (c > 0u) ? 1u : 0u; mine = (j == x) ? c : mine; }
        if (sum == G) break;
        __builtin_amdgcn_s_sleep(1);
        if ((++sp & 255u) == 0u) { if (xb_ld(&bar[XB_TMO])) break; if (sp > XB_SPIN_CAP) { atomicAdd(&bar[XB_TMO], 1u); break; } }
    }
    nloc = mine > 0u ? mine : 1u; nx = cnt > 0u ? cnt : 1u;
}
__device__ __forceinline__ void xcd_barrier(const XcdBarrier& b) {
    asm volatile("s_waitcnt vmcnt(0)" ::: "memory");
    __syncthreads();
    if (threadIdx.x == 0) {
        unsigned* bar = b.bar;
        __builtin_amdgcn_s_waitcnt(0);
        unsigned nloc = b.st[0], nx = b.st[1];
        if (nloc == 0u) { xcd_barrier_complete(bar, b.x, nloc, nx); b.st[0] = nloc; b.st[1] = nx; }
        const unsigned old = xb_add(&bar[XB_XSUB(b.x)], 1u);
        const unsigned gen = old / nloc;
        if (old + 1u == (gen + 1u) * nloc) {
            __builtin_amdgcn_fence(__ATOMIC_RELEASE, "agent");
            asm volatile("s_waitcnt vmcnt(0)" ::: "memory");
            const unsigned og = xb_add(&bar[XB_TOP], 1u);
            const unsigned tg = og / nx;
            if (og + 1u == (tg + 1u) * nx) xb_add(&bar[XB_TOPGEN], 1u);
            else XB_SPIN(xb_ld(&bar[XB_TOPGEN]) == tg, bar);
            __builtin_amdgcn_fence(__ATOMIC_ACQUIRE, "agent");
            xb_add(&bar[XB_XGEN(b.x)], 1u);
            asm volatile("s_waitcnt vmcnt(0)" ::: "memory");
        } else {
            XB_SPIN(xb_ld(&bar[XB_XGEN(b.x)]) == gen, bar);
            __builtin_amdgcn_fence(__ATOMIC_ACQUIRE, "agent");
            asm volatile("s_waitcnt vmcnt(0)" ::: "memory");
        }
    }
    __syncthreads();
}

namespace pg8 {
constexpr int BM = 256, BK = 64, HALF = 128, HTB = HALF * BK * 2, NXCD = 8, WGM = 8;
__device__ __forceinline__ int lds_byte(int r, int c) { const int st = (r >> 4) * 2 + (c >> 5), rr = r & 15, cc = c & 31, ob = rr * 64 + cc * 2; return st * 1024 + (ob ^ (((ob >> 9) & 1) << 5)); }
__device__ __forceinline__ void stage_rc(int b, int& R, int& C) { const int st = b / 1024, sb = b % 1024, swz = sb ^ (((sb >> 9) & 1) << 5); R = (st >> 1) * 16 + swz / 64; C = (st & 1) * 32 + (swz % 64) / 2; }
__device__ __forceinline__ int perm32(int rho) { const int n = rho >> 4, i = rho & 15; return 8 * (i >> 2) + 4 * n + (i & 3); }
struct Unit { int pm, pn, e; };
__device__ __forceinline__ unsigned cvt_pk_bf16(float lo, float hi) { f32x2 v = {lo, hi}; bf16x2_t b = __builtin_convertvector(v, bf16x2_t); return __builtin_bit_cast(unsigned, b); }

__device__ __forceinline__ void tile_of(int L, int nM, int nN, int& pm, int& pn) {
    const int nwg = nM * nN; int wgid = L;
    { const int q = nwg / NXCD, r = nwg % NXCD, xcd = wgid % NXCD, off = wgid / NXCD; wgid = (xcd < r ? xcd * (q + 1) : r * (q + 1) + (xcd - r) * q) + off; }
    const int nig = WGM * nN, gid = wgid / nig, fm = gid * WGM, gsz = (nM - fm) < WGM ? (nM - fm) : WGM;
    pm = fm + ((wgid % nig) % gsz); pn = (wgid % nig) / gsz;
}
struct DenseSched {
    const char* A; const char* Bt; int K, nM, nN, G, c, xpm, xpn0, xn, i0 = 0, i1 = 0x7fffffff, l0 = 0;
    __device__ __forceinline__ bool next(int i, Unit& u) const {
        if (i + i0 >= i1) return false;
        const int L = (i + i0) * G + c + l0, nwg = nM * nN;
        if (L >= nwg) { const int x = L - nwg; if (x < xn) { u.pm = xpm; u.pn = xpn0 + x; u.e = 0; return true; } return false; }
        tile_of(L, nM, nN, u.pm, u.pn); u.e = 0; return true;
    }
    __device__ __forceinline__ int arow(const Unit& u, int r) const { return u.pm * BM + r; }
    __device__ __forceinline__ const char* abase(const Unit&) const { return A; }
    __device__ __forceinline__ const char* bbase(const Unit& u) const { return Bt + (size_t)u.pn * BM * K * 2; }
};
struct MoeSched {
    const char* A; const char* Bt; int K; const int* rowlist; const int* tile_e; int nN; size_t bstride; int nunits, G, c;
    __device__ __forceinline__ bool next(int i, Unit& u) const {
        const int L = i * G + c; if (L >= nunits) return false;
        const int q = nunits / NXCD, r = nunits % NXCD, xcd = L % NXCD, off = L / NXCD;
        const int wgid = (xcd < r ? xcd * (q + 1) : r * (q + 1) + (xcd - r) * q) + off;
        u.pm = wgid / nN; u.pn = wgid % nN;
        u.e = __builtin_amdgcn_readfirstlane((int)__hip_atomic_load((const unsigned*)tile_e + u.pm, RLX_AGENT));
        return true;
    }
    __device__ __forceinline__ int arow(const Unit& u, int r) const { return rowlist ? rowlist[u.pm * BM + r] : u.pm * BM + r; }
    __device__ __forceinline__ const char* abase(const Unit&) const { return A; }
    __device__ __forceinline__ const char* bbase(const Unit& u) const { return Bt + (size_t)u.e * bstride + (size_t)u.pn * BM * K * 2; }
};

struct MoeTabSched {
    const char* A; const char* Bt; int K; const LAS int* lut; size_t bstride; int nunits, G, c;
    __device__ __forceinline__ bool next(int i, Unit& u) const {
        if (i * G + c >= nunits) return false;
        const int v = __builtin_amdgcn_readfirstlane(lut[i]);
        u.pm = v & 0xffff; u.pn = (v >> 16) & 0xff; u.e = (v >> 24) & 0xff; return true;
    }
    __device__ __forceinline__ int arow(const Unit& u, int r) const { return u.pm * BM + r; }
    __device__ __forceinline__ const char* abase(const Unit&) const { return A; }
    __device__ __forceinline__ const char* bbase(const Unit& u) const { return Bt + (size_t)u.e * bstride + (size_t)u.pn * BM * K * 2; }
};
__device__ __forceinline__ int xcd_remap(int L, int nunits) { const int q = nunits / NXCD, r = nunits % NXCD, xcd = L % NXCD, off = L / NXCD; return (xcd < r ? xcd * (q + 1) : r * (q + 1) + (xcd - r) * q) + off; }

typedef int v8i __attribute__((ext_vector_type(8)));
typedef int v4i __attribute__((ext_vector_type(4)));
template <class E, class = void> struct epi_wide { static constexpr int v = 0; };
template <class E> struct epi_wide<E, decltype((void)E::WIDE)> { static constexpr int v = E::WIDE; };
template <bool FP8> struct Frag;
template <> struct Frag<false> { bf16x8 bh[2]; };
template <> struct Frag<true> { v8i q; };
template <class Epi, class Sched, bool FP8 = false>
__device__ __forceinline__ void gemm_phase(LAS unsigned char* lds, const int tid, const int K, const int lda, const Sched& S, const Epi& E) {
    const int wid = __builtin_amdgcn_readfirstlane(tid >> 6), lane = tid & 63, wr = wid >> 2, wc = wid & 3, fr = lane & 15, fq = lane >> 4;
    int nt = K / BK; asm volatile("" : "+s"(nt));
    int sc1 = 0x7f7f7f7f, scw = 0x79797979; asm volatile("" : "+v"(sc1), "+v"(scw));
    int Rr[2]; unsigned Cb[2], voffB[2];
    constexpr int WIDE = epi_wide<Epi>::v;
#pragma unroll
    for (int i = 0; i < 2; ++i) { int R, C; stage_rc(tid * 16 + i * 8192, R, C);
        const int Rb = WIDE == 1 ? (64 * (R >> 5) + 16 * ((R >> 2) & 3) + 4 * ((R >> 4) & 1) + (R & 3)) : WIDE == 2 ? (64 * (R >> 5) + 8 * ((R >> 2) & 3) + 4 * ((R >> 4) & 1) + (R & 3))
                     : Epi::PERM ? ((R & ~31) + perm32(R & 31)) : R;
        Rr[i] = R; Cb[i] = (unsigned)C * 2u; voffB[i] = (unsigned)(Rb * K + C) * 2u; }
    const unsigned lda2 = (unsigned)lda * 2u;
    const size_t kstep = (size_t)(BK * 2);
    const size_t hstepB = (size_t)(WIDE == 1 ? 8 : WIDE == 2 ? 32 : HALF) * K * 2;
    const unsigned ldsw = (unsigned)wid * 1024u;
    const int aoff = lds_byte(wr * 64 + fr, fq * 8), boff = lds_byte(wc * 32 + fr, fq * 8);
    const LAS unsigned char* pA = lds + aoff; const LAS unsigned char* pB = lds + 65536 + boff;
#define PG8_SA(b, h) (((b) * 2 + (h)) * HTB)
#define PG8_SB(b, h) ((4 + (b) * 2 + (h)) * HTB)
#define PG8_STAGE(bufoff, gbase, voff) do { _Pragma("unroll") for (int _i = 0; _i < 2; ++_i) \
        __builtin_amdgcn_global_load_lds((const unsigned*)((const char*)(gbase) + (voff)[_i]), (LAS unsigned*)(lds + (bufoff) + ldsw + _i * 8192), 16, 0, 0); } while (0)
#define PG8_LD32(p, off) __builtin_shufflevector(*(const LAS v4i*)((p) + (off)), *(const LAS v4i*)((p) + (off) + 1024), 0, 1, 2, 3, 4, 5, 6, 7)
#define PG8_LDA(dst, b, h) do { _Pragma("unroll") for (int m = 0; m < 4; ++m) { if constexpr (FP8) dst[m].q = PG8_LD32(pA, PG8_SA(b, h) + m * 2048); \
        else { dst[m].bh[0] = *(const LAS bf16x8*)(pA + PG8_SA(b, h) + m * 2048); dst[m].bh[1] = *(const LAS bf16x8*)(pA + PG8_SA(b, h) + m * 2048 + 1024); } } } while (0)
#define PG8_LDB(dst, b, h) do { _Pragma("unroll") for (int n = 0; n < 2; ++n) { if constexpr (FP8) dst[n].q = PG8_LD32(pB, PG8_SB(b, h) - 65536 + n * 2048); \
        else { dst[n].bh[0] = *(const LAS bf16x8*)(pB + PG8_SB(b, h) - 65536 + n * 2048); dst[n].bh[1] = *(const LAS bf16x8*)(pB + PG8_SB(b, h) - 65536 + n * 2048 + 1024); } } } while (0)
#define PG8_MMA(ai, bj, At, Bt) do { __builtin_amdgcn_s_setprio(1); _Pragma("unroll") for (int m = 0; m < 4; ++m) _Pragma("unroll") for (int n = 0; n < 2; ++n) { \
        if constexpr (FP8) asm volatile("v_mfma_scale_f32_16x16x128_f8f6f4 %0, %1, %2, %0, %3, %4 op_sel_hi:[0,0,0]" : "+v"(acc[ai][bj][m][n]) : "v"(Bt[n].q), "v"(At[m].q), "v"(scw), "v"(sc1)); \
        else { acc[ai][bj][m][n] = __builtin_amdgcn_mfma_f32_16x16x32_bf16(Bt[n].bh[0], At[m].bh[0], acc[ai][bj][m][n], 0, 0, 0); acc[ai][bj][m][n] = __builtin_amdgcn_mfma_f32_16x16x32_bf16(Bt[n].bh[1], At[m].bh[1], acc[ai][bj][m][n], 0, 0, 0); } } \
        __builtin_amdgcn_s_setprio(0); } while (0)
#define PG8_MMAZ(ai, bj, At, Bt) do { __builtin_amdgcn_s_setprio(1); _Pragma("unroll") for (int m = 0; m < 4; ++m) _Pragma("unroll") for (int n = 0; n < 2; ++n) \
        asm volatile("v_mfma_scale_f32_16x16x128_f8f6f4 %0, %1, %2, 0, %3, %4 op_sel_hi:[0,0,0]" : "+v"(acc[ai][bj][m][n]) : "v"(Bt[n].q), "v"(At[m].q), "v"(scw), "v"(sc1)); \
        __builtin_amdgcn_s_setprio(0); } while (0)
#define PG8_WAIT_V(n) asm volatile("s_waitcnt vmcnt(" #n ")" ::: "memory")
#define PG8_WAIT_V8E(c) do { if (Epi::NST > 0 && (c)) asm volatile("s_waitcnt vmcnt(%0)" :: "n"(8 + Epi::NST) : "memory"); else PG8_WAIT_V(8); } while (0)
#define PG8_WAIT_L(n) asm volatile("s_waitcnt lgkmcnt(" #n ")" ::: "memory")
#define PG8_BAR __builtin_amdgcn_s_barrier()
#define PG8_SCHED __builtin_amdgcn_sched_barrier(0)
    Unit cur, nxt; int ui = 0;
    if (!S.next(0, cur)) return;
    f32x4 acc[2][2][4][2];
#pragma unroll
    for (int a = 0; a < 2; ++a)
#pragma unroll
        for (int b = 0; b < 2; ++b)
#pragma unroll
            for (int m = 0; m < 4; ++m)
#pragma unroll
                for (int n = 0; n < 2; ++n) acc[a][b][m][n] = (f32x4){0.f, 0.f, 0.f, 0.f};
    Frag<FP8> At[4], B0[2], B1[2];
    const char* cA = S.abase(cur); const char* cB = S.bbase(cur);
    unsigned ofA0[2], ofA1[2];
#pragma unroll
    for (int i = 0; i < 2; ++i) { ofA0[i] = (unsigned)S.arow(cur, Rr[i]) * lda2 + Cb[i]; ofA1[i] = (unsigned)S.arow(cur, HALF + Rr[i]) * lda2 + Cb[i]; }
    PG8_STAGE(PG8_SB(0, 0), cB, voffB); PG8_STAGE(PG8_SB(0, 1), cB + hstepB, voffB); PG8_STAGE(PG8_SA(0, 0), cA, ofA0); PG8_STAGE(PG8_SA(0, 1), cA, ofA1);
    if (wr == 1) PG8_BAR;
    PG8_WAIT_V(2); PG8_BAR;
    PG8_STAGE(PG8_SB(1, 0), cB + kstep, voffB); PG8_STAGE(PG8_SA(1, 0), cA + kstep, ofA0); PG8_STAGE(PG8_SB(1, 1), cB + hstepB + kstep, voffB);
    PG8_WAIT_V(6); PG8_BAR;
    for (;;) {
        const bool has_next = S.next(ui + 1, nxt);
        const char* nA = has_next ? S.abase(nxt) : cA; const char* nB = has_next ? S.bbase(nxt) : cB;
        unsigned ofN0[2], ofN1[2];
#pragma unroll
        for (int i = 0; i < 2; ++i) { ofN0[i] = has_next ? (unsigned)S.arow(nxt, Rr[i]) * lda2 + Cb[i] : ofA0[i]; ofN1[i] = has_next ? (unsigned)S.arow(nxt, HALF + Rr[i]) * lda2 + Cb[i] : ofA1[i]; }
        for (int t = 0; t < nt; t += 2) {
            const bool last = (t == nt - 2);
            const char* a1 = cA + (size_t)(t + 1) * kstep;
            const char* a2 = last ? nA : cA + (size_t)(t + 2) * kstep; const char* b2 = last ? nB : cB + (size_t)(t + 2) * kstep;
            const char* a3 = a2 + kstep; const char* b3 = b2 + kstep;
            unsigned o20[2], o21[2];
#pragma unroll
            for (int i = 0; i < 2; ++i) { o20[i] = last ? ofN0[i] : ofA0[i]; o21[i] = last ? ofN1[i] : ofA1[i]; }
            const bool after_epi = (t == 0) && (ui > 0);
            PG8_LDB(B0, 0, 0); PG8_LDB(B1, 0, 1); PG8_SCHED; PG8_LDA(At, 0, 0); PG8_STAGE(PG8_SA(1, 1), a1, ofA1);
            PG8_WAIT_V8E(after_epi); PG8_WAIT_L(0); PG8_BAR;
            if constexpr (FP8) { if (t == 0) { PG8_MMAZ(0, 0, At, B0); PG8_MMAZ(0, 1, At, B1); } else { PG8_MMA(0, 0, At, B0); PG8_MMA(0, 1, At, B1); } } else { PG8_MMA(0, 0, At, B0); PG8_MMA(0, 1, At, B1); }
            PG8_BAR; PG8_SCHED;
            PG8_LDA(At, 0, 1); PG8_STAGE(PG8_SB(0, 0), b2, voffB); PG8_STAGE(PG8_SB(0, 1), b2 + hstepB, voffB); PG8_STAGE(PG8_SA(0, 0), a2, o20);
            PG8_WAIT_V8E(after_epi); PG8_WAIT_L(0); PG8_BAR;
            if constexpr (FP8) { if (t == 0) { PG8_MMAZ(1, 0, At, B0); PG8_MMAZ(1, 1, At, B1); } else { PG8_MMA(1, 0, At, B0); PG8_MMA(1, 1, At, B1); } } else { PG8_MMA(1, 0, At, B0); PG8_MMA(1, 1, At, B1); }
            PG8_BAR; PG8_SCHED;
            PG8_LDB(B0, 1, 0); PG8_LDB(B1, 1, 1); PG8_SCHED; PG8_LDA(At, 1, 0); PG8_STAGE(PG8_SA(0, 1), a2, o21);
            PG8_WAIT_V(8); PG8_WAIT_L(0); PG8_BAR; PG8_MMA(0, 0, At, B0); PG8_MMA(0, 1, At, B1); PG8_BAR; PG8_SCHED;
            PG8_LDA(At, 1, 1); PG8_STAGE(PG8_SB(1, 0), b3, voffB); PG8_STAGE(PG8_SB(1, 1), b3 + hstepB, voffB); PG8_STAGE(PG8_SA(1, 0), a3, o20);
            PG8_WAIT_V(8); PG8_WAIT_L(0); PG8_BAR; PG8_MMA(1, 0, At, B0); PG8_MMA(1, 1, At, B1); PG8_BAR; PG8_SCHED;
        }
        if (wr == 0) PG8_BAR;
        if constexpr (FP8) asm volatile("s_nop 15\n\ts_nop 15" ::: "memory");
        E(acc, cur, wr, wc, fr, fq);
        if (!has_next) break;
        if constexpr (!FP8) {
#pragma unroll
        for (int a = 0; a < 2; ++a)
#pragma unroll
            for (int b = 0; b < 2; ++b)
#pragma unroll
                for (int m = 0; m < 4; ++m)
#pragma unroll
                    for (int n = 0; n < 2; ++n) acc[a][b][m][n] = (f32x4){0.f, 0.f, 0.f, 0.f};
        }
        cur = nxt; cA = nA; cB = nB; ++ui;
#pragma unroll
        for (int i = 0; i < 2; ++i) { ofA0[i] = ofN0[i]; ofA1[i] = ofN1[i]; }
        if (wr == 1) PG8_BAR;
    }
    PG8_WAIT_V(0);
    PG8_BAR;
#undef PG8_SA
#undef PG8_SB
#undef PG8_STAGE
#undef PG8_LDA
#undef PG8_LD32
#undef PG8_LDB
#undef PG8_MMA
#undef PG8_MMAZ
#undef PG8_WAIT_V
#undef PG8_WAIT_V8E
#undef PG8_WAIT_L
#undef PG8_BAR
#undef PG8_SCHED
}

#define EPI_LOOP_ROWS for (int ai = 0; ai < 2; ++ai) _Pragma("unroll") for (int m = 0; m < 4; ++m)
__device__ __forceinline__ u32x4 pack8(const f32x4& v0, const f32x4& v1) { u32x4 w; w.x = cvt_pk_bf16(v0[0], v0[1]); w.y = cvt_pk_bf16(v0[2], v0[3]); w.z = cvt_pk_bf16(v1[0], v1[1]); w.w = cvt_pk_bf16(v1[2], v1[3]); return w; }
__device__ __forceinline__ void unpack8(const u32x4& w, f32x4& v0, f32x4& v1) { v0 = (f32x4){bf_lo(w.x), bf_hi(w.x), bf_lo(w.y), bf_hi(w.y)}; v1 = (f32x4){bf_lo(w.z), bf_hi(w.z), bf_lo(w.w), bf_hi(w.w)}; }
__device__ __forceinline__ unsigned pack4_fp8(const f32x4& v) { int w = __builtin_amdgcn_cvt_pk_fp8_f32(v[0], v[1], 0, false); w = __builtin_amdgcn_cvt_pk_fp8_f32(v[2], v[3], w, true); return (unsigned)w; }
__device__ __forceinline__ f32x4 sig4(const f32x4& v) { return (f32x4){fast_sigmoid(v[0]), fast_sigmoid(v[1]), fast_sigmoid(v[2]), fast_sigmoid(v[3])}; }

struct EpiZ {
    static constexpr bool PERM = true; static constexpr int NST = 0;
    bf16_t *Kb, *Vb, *Ug;
    __device__ __forceinline__ void operator()(const f32x4 (&acc)[2][2][4][2], const Unit& u, int wr, int wc, int fr, int fq) const {
        const int pn = u.pn;
#pragma unroll
        EPI_LOOP_ROWS {
            const int r = u.pm * BM + ai * HALF + wr * 64 + m * 16 + fr;
            if (r < KVROWS) { const int sp = r < T_TOK ? r + NMETA : r - T_TOK;
#pragma unroll
              for (int bj = 0; bj < 2; ++bj) {
                const int cl = bj * HALF + wc * 32 + 8 * fq;
                const f32x4 v0 = acc[ai][bj][m][0], v1 = acc[ai][bj][m][1];
                if (pn == 0) *(u32x4*)(Kb + (size_t)sp * KVW + cl) = pack8(v0, v1);
                else if (pn == 1) { bf16_t* vp = Vb + (size_t)cl * KVROWS + sp;
#pragma unroll
                    for (int j = 0; j < 4; ++j) { vp[(size_t)j * KVROWS] = (bf16_t)f2bf(v0[j]); vp[(size_t)(4 + j) * KVROWS] = (bf16_t)f2bf(v1[j]); } }
                else { const int col = (pn - 2) * BM + cl;
                    *(u32x4*)(Ug + ((size_t)(col >> 4) * KVROWS + sp) * 16 + (col & 15)) = pack8(v0, v1); }
              } }
        }
    }
};
struct EpiGate {
    static constexpr bool PERM = true; static constexpr int NST = 0; static constexpr int WIDE = 2;
    bf16_t *Q, *Ga, *Gs;
    __device__ __forceinline__ void operator()(const f32x4 (&acc)[2][2][4][2], const Unit& u, int wr, int wc, int fr, int fq) const {
        const int row0 = u.pm * BM + wr * 64 + fr, cl = wc * 64 + 8 * fq;
        if (u.pn < 8) {
            bf16_t* base = Q + (size_t)row0 * AW + u.pn * BM + cl;
#pragma unroll
            EPI_LOOP_ROWS {
#pragma unroll
                for (int bj = 0; bj < 2; ++bj) *(u32x4*)(base + (size_t)(ai * HALF + m * 16) * AW + bj * 32) = pack8(acc[ai][bj][m][0] * QSCALE, acc[ai][bj][m][1] * QSCALE); }
        } else {
            bf16_t* base = (u.pn < 24 ? Ga : Gs) + (size_t)row0 * DM + ((u.pn - 8) & 15) * BM + cl;
#pragma unroll
            EPI_LOOP_ROWS {
#pragma unroll
                for (int bj = 0; bj < 2; ++bj) __builtin_nontemporal_store(pack8(sig4(acc[ai][bj][m][0]), sig4(acc[ai][bj][m][1])), (u32x4*)(base + (size_t)(ai * HALF + m * 16) * DM + bj * 32)); }
        }
    }
};
struct EpiGlu {
    static constexpr bool PERM = true; static constexpr int NST = 0;
    const bf16_t* Y1; unsigned char* Y2;
    __device__ __forceinline__ void operator()(const f32x4 (&acc)[2][2][4][2], const Unit& u, int wr, int wc, int fr, int fq) const {
#pragma unroll
        EPI_LOOP_ROWS { const size_t r = (size_t)u.pm * BM + ai * HALF + wr * 64 + m * 16 + fr;
#pragma unroll
            for (int bj = 0; bj < 2; ++bj) { const size_t off = r * SW + u.pn * BM + bj * HALF + wc * 32 + 8 * fq;
                f32x4 y0, y1; unpack8(*(const u32x4*)(Y1 + off), y0, y1);
                *(u32x2*)(Y2 + off) = (u32x2){pack4_fp8(y0 * sig4(acc[ai][bj][m][0])), pack4_fp8(y1 * sig4(acc[ai][bj][m][1]))}; } }
    }
};
template <bool ADD> struct EpiMix {
    static constexpr bool PERM = true; static constexpr int NST = 0; static constexpr int WIDE = ADD ? 1 : 2;
    const bf16_t* Gt; bf16_t* Mix; unsigned char* MixQ;
    __device__ __forceinline__ void operator()(const f32x4 (&acc)[2][2][4][2], const Unit& u, int wr, int wc, int fr, int fq) const {
#pragma unroll
        EPI_LOOP_ROWS { const size_t r = (size_t)u.pm * BM + ai * HALF + wr * 64 + m * 16 + fr;
            const size_t off0 = r * DM + u.pn * BM + wc * 64 + (ADD ? 16 : 8) * fq; unsigned q[4];
#pragma unroll
            for (int bj = 0; bj < 2; ++bj) { const size_t off = off0 + bj * (ADD ? 8 : 32);
                f32x4 g0, g1; unpack8(*(const u32x4*)(Gt + off), g0, g1);
                f32x4 o0 = g0 * acc[ai][bj][m][0], o1 = g1 * acc[ai][bj][m][1];
                if (ADD) { f32x4 p0, p1; unpack8(*(const u32x4*)(Mix + off), p0, p1); o0 += p0; o1 += p1; q[2 * bj] = pack4_fp8(o0); q[2 * bj + 1] = pack4_fp8(o1); }
                else *(u32x4*)(Mix + off) = pack8(o0, o1); }
            if (ADD) *(u32x4*)(MixQ + off0) = (u32x4){q[0], q[1], q[2], q[3]};
        }
    }
};
struct EpiWout {
    static constexpr bool PERM = true; static constexpr int NST = 0; static constexpr int WIDE = 2;
    bf16_t* Out;
    __device__ __forceinline__ void operator()(const f32x4 (&acc)[2][2][4][2], const Unit& u, int wr, int wc, int fr, int fq) const {
        const int col0 = u.pn * BM + wc * 64 + 8 * fq;
#pragma unroll
        EPI_LOOP_ROWS { const size_t r = (size_t)u.pm * BM + ai * HALF + wr * 64 + m * 16 + fr; const size_t off = r * DM + col0;
#pragma unroll
            for (int bj = 0; bj < 2; ++bj) *(u32x4*)(Out + off + bj * 32) = pack8(acc[ai][bj][m][0], acc[ai][bj][m][1]); }
    }
};
struct EpiS13R {
    static constexpr bool PERM = true; static constexpr int NST = 0;
    bf16_t* ActS; float* Logits;
    __device__ __forceinline__ void operator()(const f32x4 (&acc)[2][2][4][2], const Unit& u, int wr, int wc, int fr, int fq) const {
#pragma unroll
        EPI_LOOP_ROWS { const size_t r = (size_t)u.pm * BM + ai * HALF + wr * 64 + m * 16 + fr; const int cl = wc * 32 + 8 * fq;
            if (u.pn < 4) { const f32x4 a0 = acc[ai][0][m][0], a1 = acc[ai][0][m][1];
                *(u32x4*)(ActS + r * EDIM + u.pn * HALF + cl) = pack8(a0 * sig4(a0) * acc[ai][1][m][0], a1 * sig4(a1) * acc[ai][1][m][1]); }
            else { *(f32x4*)(Logits + r * 128 + cl) = acc[ai][0][m][0]; *(f32x4*)(Logits + r * 128 + cl + 4) = acc[ai][0][m][1]; } }
    }
};
constexpr float WQ_SCALE = 64.f, WQ_INV = 1.f / 64.f;
struct EpiAct {
    static constexpr bool PERM = true; static constexpr int NST = 0;
    unsigned char* Act;
    __device__ __forceinline__ void operator()(const f32x4 (&acc)[2][2][4][2], const Unit& u, int wr, int wc, int fr, int fq) const {
#pragma unroll
        EPI_LOOP_ROWS { const size_t r = (size_t)u.pm * BM + ai * HALF + wr * 64 + m * 16 + fr; const int cl = wc * 32 + 8 * fq;
            const f32x4 a0 = acc[ai][0][m][0], a1 = acc[ai][0][m][1];
            *(u32x2*)(Act + r * EDIM + u.pn * HALF + cl) = (u32x2){pack4_fp8(a0 * sig4(a0) * acc[ai][1][m][0]), pack4_fp8(a1 * sig4(a1) * acc[ai][1][m][1])}; }
    }
};
struct EpiS2 {
    static constexpr bool PERM = true; static constexpr int NST = 0; static constexpr int WIDE = 2;
    bf16_t* H;
    __device__ __forceinline__ void operator()(const f32x4 (&acc)[2][2][4][2], const Unit& u, int wr, int wc, int fr, int fq) const {
#pragma unroll
        EPI_LOOP_ROWS { const size_t r = (size_t)u.pm * BM + ai * HALF + wr * 64 + m * 16 + fr;
#pragma unroll
            for (int bj = 0; bj < 2; ++bj) { bf16_t* p = H + r * DM + u.pn * BM + bj * 32 + wc * 64 + 8 * fq; f32x4 h0, h1; unpack8(*(const u32x4*)p, h0, h1);
                *(u32x4*)p = pack8(h0 * ALPHA + acc[ai][bj][m][0], h1 * ALPHA + acc[ai][bj][m][1]); } }
    }
};
struct EpiY {
    static constexpr bool PERM = true; static constexpr int NST = 8; static constexpr int WIDE = 1;
    unsigned char* Y;
    __device__ __forceinline__ void operator()(const f32x4 (&acc)[2][2][4][2], const Unit& u, int wr, int wc, int fr, int fq) const {
#pragma unroll
        EPI_LOOP_ROWS { const size_t r = (size_t)u.pm * BM + ai * HALF + wr * 64 + m * 16 + fr;
            *(u32x4*)(Y + r * DM + u.pn * BM + wc * 64 + 16 * fq) = (u32x4){pack4_fp8(acc[ai][0][m][0]), pack4_fp8(acc[ai][0][m][1]), pack4_fp8(acc[ai][1][m][0]), pack4_fp8(acc[ai][1][m][1])}; }
    }
};
}

struct Frame {
    LAS unsigned char* lds; gu32* ctl; unsigned char* ws;
    int tid, lane, wave, G, c;
    const float* const* in; float* out;
};
#define WSP(T, off) ((T*)(F.ws + (off)))

struct CvtRegs { f32x4 v[16]; };
__device__ __forceinline__ void cvt_load(CvtRegs& R, const float* __restrict__ W, size_t ldw, int k0, int n0, int lane) {
    const float* src = W + (size_t)(k0 + 2 * (lane >> 4)) * ldw + n0 + 4 * (lane & 15);
#pragma unroll
    for (int ip = 0; ip < 8; ++ip) { R.v[2 * ip] = __builtin_nontemporal_load((const f32x4*)(src + (size_t)(8 * ip) * ldw)); R.v[2 * ip + 1] = __builtin_nontemporal_load((const f32x4*)(src + (size_t)(8 * ip + 1) * ldw)); }
}
template <bool LO>
__device__ __forceinline__ void cvt_store(const CvtRegs& R, int k0, bf16_t* Wt, size_t dpitch, size_t drow0, LAS unsigned* scr, int lane) {
    const int kq = lane >> 4, n4 = 4 * (lane & 15);
#pragma unroll
    for (int ip = 0; ip < 8; ++ip) { f32x4 a = R.v[2 * ip], b = R.v[2 * ip + 1];
        if (LO) {
#pragma unroll
            for (int j = 0; j < 4; ++j) { a[j] -= __builtin_bit_cast(float, f2bf(a[j]) << 16); b[j] -= __builtin_bit_cast(float, f2bf(b[j]) << 16); } }
#pragma unroll
        for (int j = 0; j < 4; ++j) scr[(n4 + j) * 33 + 4 * ip + kq] = pk2(a[j], b[j]); }
    LDS_WAIT();
    const int c = lane & 7;
#pragma unroll
    for (int j = 0; j < 8; ++j) { const int n = (lane >> 3) + 8 * j; const LAS unsigned* s = scr + n * 33 + 4 * c;
        u32x4 o; o.x = s[0]; o.y = s[1]; o.z = s[2]; o.w = s[3];
        __builtin_nontemporal_store(o, (u32x4*)(Wt + (drow0 + n) * dpitch + k0 + 8 * c)); }
    LDS_WAIT();
}
template <bool LO>
__device__ __forceinline__ void cvt_tile(const float* __restrict__ W, size_t ldw, int k0, int n0, bf16_t* Wt, size_t dpitch, size_t drow0, LAS unsigned* scr, int lane) {
    CvtRegs R; cvt_load(R, W, ldw, k0, n0, lane); cvt_store<LO>(R, k0, Wt, dpitch, drow0, scr, lane);
}
__device__ __forceinline__ void cvt_load8(CvtRegs& R, const float* __restrict__ W, size_t ldw, int k0, int n0, int lane) {
    const float* src = W + (size_t)(k0 + 4 * (lane >> 3)) * ldw + n0 + 4 * (lane & 7);
#pragma unroll
    for (int ip = 0; ip < 4; ++ip)
#pragma unroll
        for (int b = 0; b < 4; ++b) R.v[4 * ip + b] = __builtin_nontemporal_load((const f32x4*)(src + (size_t)(32 * ip + b) * ldw));
}
__device__ __forceinline__ void cvt_store8(const CvtRegs& R, int k0, unsigned char* Wt, size_t dpitch, size_t drow0, float scale, LAS unsigned* scr, int lane, bool nt = true) {
    const int kr = lane >> 3, n4 = 4 * (lane & 7);
#pragma unroll
    for (int ip = 0; ip < 4; ++ip)
#pragma unroll
        for (int j = 0; j < 4; ++j) { int w = __builtin_amdgcn_cvt_pk_fp8_f32(R.v[4 * ip][j] * scale, R.v[4 * ip + 1][j] * scale, 0, false); w = __builtin_amdgcn_cvt_pk_fp8_f32(R.v[4 * ip + 2][j] * scale, R.v[4 * ip + 3][j] * scale, w, true);
            scr[(n4 + j) * 33 + 8 * ip + kr] = (unsigned)w; }
    LDS_WAIT();
    const int c = lane & 7;
#pragma unroll
    for (int j = 0; j < 4; ++j) { const int n = (lane >> 3) + 8 * j; const LAS unsigned* sp = scr + n * 33 + 4 * c;
        u32x4 o; o.x = sp[0]; o.y = sp[1]; o.z = sp[2]; o.w = sp[3];
        if (nt) __builtin_nontemporal_store(o, (u32x4*)(Wt + (drow0 + n) * dpitch + k0 + 16 * c)); else *(u32x4*)(Wt + (drow0 + n) * dpitch + k0 + 16 * c) = o; }
    LDS_WAIT();
}
struct CvtJob { const float* W; void* Wt; int K, N, mode, nmat; size_t wstride, dstride; int fp8; int ldw; };
__device__ __forceinline__ int cvt_job_tiles(const CvtJob& j) { return j.nmat * (j.K / 64) * (j.N / 64); }
struct CvtTile { const float* W; void* Wt; size_t ldw, dpitch, drow0; int k0, n0; };
__device__ __forceinline__ CvtTile cvt_job_tile(const CvtJob& j, int it) {
    const int tn = j.fp8 ? 32 : 64, tk = j.fp8 ? 128 : 64;
    const int nnb = j.N / tn, per = (j.K / tk) * nnb, mat = it / per, r = it % per, kb = r / nnb, nb = r % nnb, n0 = nb * tn;
    const size_t drow0 = j.mode == 0 ? (size_t)n0 : (size_t)(n0 >> 7) * 256 + (j.mode - 1) * 128 + (n0 & 127);
    void* wt = j.fp8 ? (void*)((unsigned char*)j.Wt + (size_t)mat * j.dstride) : (void*)((bf16_t*)j.Wt + (size_t)mat * j.dstride);
    return CvtTile{j.W + (size_t)mat * j.wstride, wt, (size_t)(j.ldw ? j.ldw : j.N), (size_t)j.K, drow0, kb * tk, n0};
}
__device__ __forceinline__ void ln_row(const float* xrow, const LAS f32x4* g, const LAS f32x4* b, int lane, f32x4 (&v)[16], float& mean, float& rstd) {
    const f32x4* xr = (const f32x4*)xrow + lane; float s = 0.f;
#pragma unroll
    for (int j = 0; j < 16; ++j) { v[j] = __builtin_nontemporal_load(xr + 64 * j); s += (v[j][0] + v[j][1]) + (v[j][2] + v[j][3]); }
    mean = wave_sum(s) * (1.f / DM); float s2 = 0.f;
#pragma unroll
    for (int j = 0; j < 16; ++j) { v[j] = v[j] - mean; s2 += (v[j][0] * v[j][0] + v[j][1] * v[j][1]) + (v[j][2] * v[j][2] + v[j][3] * v[j][3]); }
    rstd = 1.f / sqrtf(wave_sum(s2) * (1.f / DM) + LN_EPS);
    asm volatile("" ::: "memory");
#pragma unroll
    for (int j = 0; j < 16; ++j) { const f32x4 gg = g[lane + 64 * j], bb = b[lane + 64 * j]; v[j] = v[j] * rstd * gg + bb; }
}

__device__ __forceinline__ void cvt_run(const Frame& F, int j0, int j1, int gw, int NGW, LAS unsigned* scr, int tlo = 0, int thi = 0x7fffffff) {
    int done = 0;
#pragma unroll 1
    for (int jn = j0; jn < j1; ++jn) {
        CvtJob j;
        switch (jn) {
            case 0: j = CvtJob{F.in[4] + 2048, WSP(unsigned char, WS_WING) + (size_t)10240 * DM, DM, 1536, 0, 1, 0, 0, 1, NZ}; break;
            case 11: j = CvtJob{F.in[4] + 3584, WSP(unsigned char, WS_WING) + (size_t)2048 * DM, DM, 2 * DM, 0, 1, 0, 0, 1, NZ}; break;
            case 12: j = CvtJob{F.in[4], WSP(unsigned char, WS_WING), DM, 2048, 0, 1, 0, 0, 1, NZ}; break;
            case 1: j = CvtJob{F.in[6], WSP(unsigned char, WS_WAO), AW, DM, 0, 1, 0, 0, 1, 0}; break;
            case 2: j = CvtJob{F.in[15], WSP(bf16_t, WS_WGLU), SW, SW, 0, 1, 0, 0, 0, 0}; break;
            case 3: j = CvtJob{F.in[16], WSP(unsigned char, WS_WSO), SW, DM, 0, 1, 0, 0, 1, 0}; break;
            case 4: j = CvtJob{F.in[17], WSP(unsigned char, WS_WOUT), DM, DM, 0, 1, 0, 0, 1, 0}; break;
            case 5: j = CvtJob{F.in[25], WSP(bf16_t, WS_WS13), DM, EDIM, 1, 1, 0, 0, 0, 0}; break;
            case 6: j = CvtJob{F.in[26], WSP(bf16_t, WS_WS13), DM, EDIM, 2, 1, 0, 0, 0, 0}; break;
            case 7: j = CvtJob{F.in[27], WSP(bf16_t, WS_WS2), EDIM, DM, 0, 1, 0, 0, 0, 0}; break;
            case 8: j = CvtJob{F.in[22], WSP(unsigned char, WS_WE13), DM, EDIM, 1, NE, (size_t)DM * EDIM, (size_t)1024 * DM, 1, 0}; break;
            case 9: j = CvtJob{F.in[23], WSP(unsigned char, WS_WE13), DM, EDIM, 2, NE, (size_t)DM * EDIM, (size_t)1024 * DM, 1, 0}; break;
            default: j = CvtJob{F.in[24], WSP(unsigned char, WS_WE2), EDIM, DM, 0, NE, (size_t)EDIM * DM, (size_t)DM * EDIM, 1, 0}; break;
        }
        const int nt0 = cvt_job_tiles(j);
        const int nt = (thi - done) < nt0 ? (thi - done) : nt0;
        int it = (tlo - done) > 0 ? (tlo - done) : 0;
        { const int gfirst = done + it; const int r = (gw - (gfirst - tlo) % NGW + NGW) % NGW; it += r; }
        if (it < nt) {
            CvtTile tc = cvt_job_tile(j, it); CvtRegs Ra;
            if (j.fp8) cvt_load8(Ra, tc.W, tc.ldw, tc.k0, tc.n0, F.lane); else cvt_load(Ra, tc.W, tc.ldw, tc.k0, tc.n0, F.lane);
#pragma unroll 1
            for (;;) {
                const int itn = it + NGW; const bool more = itn < nt;
                CvtTile tn = tc; CvtRegs Rb;
                if (more) { tn = cvt_job_tile(j, itn); if (j.fp8) cvt_load8(Rb, tn.W, tn.ldw, tn.k0, tn.n0, F.lane); else cvt_load(Rb, tn.W, tn.ldw, tn.k0, tn.n0, F.lane); }
                if (j.fp8) cvt_store8(Ra, tc.k0, (unsigned char*)tc.Wt, tc.dpitch, tc.drow0, pg8::WQ_SCALE, scr, F.lane, j.ldw == 0); else cvt_store<false>(Ra, tc.k0, (bf16_t*)tc.Wt, tc.dpitch, tc.drow0, scr, F.lane);
                if (!more) break;
                Ra = Rb; tc = tn; it = itn;
            }
        }
        done += nt0;
    }
}
__device__ __forceinline__ void stage_gb(Frame& F, const float* g, const float* b) {
    __syncthreads();
    for (int i = F.tid; i < DM / 4; i += 512) { ((LAS f32x4*)F.lds)[i] = ((const f32x4*)g)[i]; ((LAS f32x4*)(F.lds + 16384))[i] = ((const f32x4*)b)[i]; }
    __syncthreads();
}
__device__ __forceinline__ void p0_prologue(Frame& F) {
    LAS unsigned* scr = (LAS unsigned*)(F.lds + 32768 + F.wave * 8704);
    const int gw = F.c * 8 + F.wave, NGW = F.G * 8;
    stage_gb(F, F.in[2], F.in[3]);
    { bf16_t* H0B = WSP(bf16_t, WS_H0B); f32x2* St0 = WSP(f32x2, WS_STATS0);
      for (int r = gw; r < ROWS_Z; r += NGW) {
          u32x2* o = (u32x2*)(H0B + (size_t)r * DM) + F.lane;
          if (r < KVROWS) { const float* src = r < T_TOK ? F.in[0] + (size_t)r * DM : F.in[1] + (size_t)(r - T_TOK) * DM;
              f32x4 v[16]; float mean, rstd; ln_row(src, (const LAS f32x4*)F.lds, (const LAS f32x4*)(F.lds + 16384), F.lane, v, mean, rstd);
              if (r < T_TOK && F.lane == 0) St0[r] = (f32x2){mean, rstd};
#pragma unroll
              for (int j = 0; j < 16; ++j) __builtin_nontemporal_store((u32x2){pk2(v[j][0], v[j][1]), pk2(v[j][2], v[j][3])}, o + 64 * j);
              { unsigned* oq = (unsigned*)(WSP(unsigned char, WS_H0Q) + (size_t)r * DM) + F.lane;
#pragma unroll
                  for (int j = 0; j < 16; ++j) oq[64 * j] = pg8::pack4_fp8(v[j]); }
          } else { unsigned* oq = (unsigned*)(WSP(unsigned char, WS_H0Q) + (size_t)r * DM) + F.lane;
#pragma unroll
              for (int j = 0; j < 16; ++j) { o[64 * j] = (u32x2){0u, 0u}; oq[64 * j] = 0u; }
          } } }
    cvt_run(F, 0, 1, gw, NGW, scr); cvt_run(F, 11, 13, gw, NGW, scr);
    { bf16_t* Wr = WSP(bf16_t, WS_WS13);
      for (int kb = gw; kb < DM / 64; kb += NGW) { cvt_tile<false>(F.in[20], NE, kb * 64, 0, Wr, DM, 1024, scr, F.lane); cvt_tile<true>(F.in[20], NE, kb * 64, 0, Wr, DM, 1088, scr, F.lane); }
      u32x4* z = (u32x4*)(Wr + (size_t)1152 * DM);
      for (int i = (F.c * 512 + F.tid); i < 128 * DM * 2 / 16; i += F.G * 512) z[i] = (u32x4){0u, 0u, 0u, 0u}; }
}

typedef float f32x16 __attribute__((ext_vector_type(16)));
constexpr int ATT_KP = 144, ATT_VP = 584, ATT_V_OFF = 288 * ATT_KP;
static_assert(ATT_V_OFF + 64 * ATT_VP <= RING_BYTES, "attention LDS");
__device__ __forceinline__ int att_src_pos(int key, int n) {
    if (key < 128) return n > 0 ? NMETA + 128 * (n - 1) + key : -1;
    if (key < 256) return NMETA + 128 * n + (key - 128);
    if (key < 272) return key - 256;
    return -1;
}
__device__ __forceinline__ void attn_unit(Frame& F, int n, int kh) {
    const bf16_t* Qb = WSP(bf16_t, WS_QB); const bf16_t* Kb = WSP(bf16_t, WS_KB); const bf16_t* Vt = WSP(bf16_t, WS_VB); unsigned char* At = WSP(unsigned char, WS_ATT);
    LAS unsigned char* Ks = F.lds; LAS unsigned char* Vs = F.lds + ATT_V_OFF;
    __syncthreads();
    for (int p = F.tid; p < 288 * 8; p += 512) { const int j = p >> 3, c8 = p & 7, sp = att_src_pos(j, n);
        u32x4 v = (u32x4){0u, 0u, 0u, 0u};
        if (sp >= 0) v = *(const u32x4*)(Kb + (size_t)sp * KVW + kh * 64 + c8 * 8);
        *(LAS u32x4*)(Ks + j * ATT_KP + c8 * 16) = v; }
    for (int p = F.tid; p < 64 * 36; p += 512) { const int d = p / 36, q = p % 36, sp = att_src_pos(q * 8, n);
        u32x4 v = (u32x4){0u, 0u, 0u, 0u};
        if (sp >= 0) v = *(const u32x4*)(Vt + (size_t)(kh * 64 + d) * KVROWS + sp);
        LAS u32x2* dst = (LAS u32x2*)(Vs + d * ATT_VP + q * 16); dst[0] = (u32x2){v.x, v.y}; dst[1] = (u32x2){v.z, v.w}; }
    __syncthreads();
    const int hq = kh * 8 + F.wave, r32 = F.lane & 31, hh = F.lane >> 5;
    const float sink2 = F.in[5][hq] * LOG2E;
    const bool prevok = n > 0;
#pragma unroll 1
    for (int qt = 0; qt < 4; ++qt) {
        const bf16_t* qrow = Qb + (size_t)(128 * n + 32 * qt + r32) * AW + hq * 64 + 8 * hh;
        bf16x8 qf[4];
#pragma unroll
        for (int t = 0; t < 4; ++t) qf[t] = *(const bf16x8*)(qrow + 16 * t);
        f32x16 sacc[6];
#pragma unroll
        for (int x = 0; x < 6; ++x) {
            const int kb = x < 4 - qt ? 32 * (qt + x) : (x < 5 ? 128 + 32 * (x - (4 - qt)) : 256);
            f32x16 acc;
#pragma unroll
            for (int i = 0; i < 16; ++i) acc[i] = 0.f;
#pragma unroll
            for (int t = 0; t < 4; ++t) { const bf16x8 kf = *(const LAS bf16x8*)(Ks + (kb + r32) * ATT_KP + (16 * t + 8 * hh) * 2); acc = __builtin_amdgcn_mfma_f32_32x32x16_bf16(kf, qf[t], acc, 0, 0, 0); }
#pragma unroll
            for (int i = 0; i < 16; ++i) { const int m = (i & 3) + 8 * (i >> 2) + 4 * hh;
                bool vis;
                if (x < 4 - qt) vis = prevok && (x > 0 || m > r32);
                else if (x < 5) vis = (x < 4) || (m <= r32);
                else vis = m < 16;
                acc[i] = vis ? acc[i] : -1e30f; }
            sacc[x] = acc;
        }
        float mx = sink2;
#pragma unroll
        for (int x = 0; x < 6; ++x)
#pragma unroll
            for (int i = 0; i < 16; ++i) mx = fmaxf(mx, sacc[x][i]);
        mx = fmaxf(mx, __shfl_xor(mx, 32));
        float l = 0.f;
#pragma unroll
        for (int x = 0; x < 6; ++x)
#pragma unroll
            for (int i = 0; i < 16; ++i) { const float p = __builtin_amdgcn_exp2f(sacc[x][i] - mx); sacc[x][i] = p; l += p; }
        l += __shfl_xor(l, 32); l += __builtin_amdgcn_exp2f(sink2 - mx);
        f32x16 oacc[2];
#pragma unroll
        for (int dt = 0; dt < 2; ++dt)
#pragma unroll
            for (int i = 0; i < 16; ++i) oacc[dt][i] = 0.f;
#pragma unroll
        for (int x = 0; x < 6; ++x) {
            const int kb = x < 4 - qt ? 32 * (qt + x) : (x < 5 ? 128 + 32 * (x - (4 - qt)) : 256);
#pragma unroll
            for (int t2 = 0; t2 < 2; ++t2) {
                u32x4 pw; pw.x = pg8::cvt_pk_bf16(sacc[x][8 * t2 + 0], sacc[x][8 * t2 + 1]); pw.y = pg8::cvt_pk_bf16(sacc[x][8 * t2 + 2], sacc[x][8 * t2 + 3]);
                pw.z = pg8::cvt_pk_bf16(sacc[x][8 * t2 + 4], sacc[x][8 * t2 + 5]); pw.w = pg8::cvt_pk_bf16(sacc[x][8 * t2 + 6], sacc[x][8 * t2 + 7]);
                const bf16x8 pf = __builtin_bit_cast(bf16x8, pw);
#pragma unroll
                for (int dt = 0; dt < 2; ++dt) { const LAS u32x2* vp = (const LAS u32x2*)(Vs + (32 * dt + r32) * ATT_VP + (kb + 16 * t2 + 4 * hh) * 2);
                    const u32x2 a = vp[0], b = vp[2]; u32x4 vw; vw.x = a.x; vw.y = a.y; vw.z = b.x; vw.w = b.y;
                    oacc[dt] = __builtin_amdgcn_mfma_f32_32x32x16_bf16(__builtin_bit_cast(bf16x8, vw), pf, oacc[dt], 0, 0, 0); }
            }
        }
        const float inv = 1.f / l;
        unsigned char* orow = At + (size_t)(128 * n + 32 * qt + r32) * AW + hq * 64 + 4 * hh;
#pragma unroll
        for (int dt = 0; dt < 2; ++dt)
#pragma unroll
            for (int g = 0; g < 4; ++g) *(unsigned*)(orow + 32 * dt + 8 * g) = pg8::pack4_fp8((f32x4){oacc[dt][4 * g] * inv, oacc[dt][4 * g + 1] * inv, oacc[dt][4 * g + 2] * inv, oacc[dt][4 * g + 3] * inv});
    }
}

constexpr int SSM_NCH = KVROWS / 8, SSM_NBLK = (SSM_NCH + 63) / 64, SSM_EP = 132, SSM_SP = 272, SSM_UP = 272;
constexpr int SSM_UB = 0  , SSM_EB = 3 * 64 * SSM_UP  , SSM_SB = SSM_EB + 2 * 64 * SSM_EP * 4  ;
constexpr int SSM_APOW = SSM_EB, SSM_BBAR = SSM_APOW + 4608, SSM_KD = SSM_BBAR + 8192;
static_assert(SSM_KD + 16384 <= SSM_SB && SSM_SB + 64 * SSM_SP <= LUT_OFF, "SSM LDS");
__device__ __forceinline__ bf16x8 pack_frag(const float (&v)[8]) { u32x4 w; w.x = pk2(v[0], v[1]); w.y = pk2(v[2], v[3]); w.z = pk2(v[4], v[5]); w.w = pk2(v[6], v[7]); return __builtin_bit_cast(bf16x8, w); }
__device__ __forceinline__ f32x2 gelu_pk(f32x2 v) {
    const f32x2 av = __builtin_elementwise_abs(v), d = av * 0.2316418882f + 1.0f;
    f32x2 t; t.x = __builtin_amdgcn_rcpf(d.x); t.y = __builtin_amdgcn_rcpf(d.y);
    f32x2 q = t * 0.5307027145f + (-0.7265760135f); q = q * t + 0.7107068705f; q = q * t + (-0.142248368f); q = q * t + 0.127414796f; q = q * t;
    const f32x2 sq = (v * v) * (-0.72134752044f);
    f32x2 e; e.x = __builtin_amdgcn_exp2f(sq.x); e.y = __builtin_amdgcn_exp2f(sq.y);
    const f32x2 m = v * (q * e), r = v - m;
    f32x2 o; o.x = v.x < 0.f ? m.x : r.x; o.y = v.y < 0.f ? m.y : r.y; return o;
}
__device__ __forceinline__ void ssm_unit(Frame& F, int g, int bfull, int bend) {
    const int tid = F.tid, lane = F.lane, w = F.wave, nl = lane & 15, kg = lane >> 4;
    LAS f32x2* apow = (LAS f32x2*)(F.lds + SSM_APOW);
    LAS f32x2* bbar = (LAS f32x2*)(F.lds + SSM_BBAR);
    LAS float* Kd = (LAS float*)(F.lds + SSM_KD);
    LAS f32x2* clds = (LAS f32x2*)(F.lds + SSM_KD + 8192);
    LAS float* eb = (LAS float*)(F.lds + SSM_EB);
    LAS unsigned char* sb = F.lds + SSM_SB;
    LAS unsigned char* ub = F.lds + SSM_UB;
    const float* Cre = F.in[12] + (size_t)g * 16 * 64; const float* Cim = F.in[13] + (size_t)g * 16 * 64;
    const bf16_t* Ub = WSP(bf16_t, WS_UG) + (size_t)g * KVROWS * 16;
    const int ur0 = tid >> 4, uc0 = tid & 15;
#define SSM_ULOAD(b, r0, r1) do { r0 = *(const u32x4*)(Ub + (size_t)(64 * (b) + ur0) * 128 + uc0 * 8); r1 = *(const u32x4*)(Ub + (size_t)(64 * (b) + 32 + ur0) * 128 + uc0 * 8); } while (0)
#define SSM_USTORE(b, r0, r1) do { LAS unsigned char* u_ = ub + ((b) % 3) * 64 * SSM_UP; *(LAS u32x4*)(u_ + ur0 * SSM_UP + uc0 * 16) = r0; *(LAS u32x4*)(u_ + (32 + ur0) * SSM_UP + uc0 * 16) = r1; } while (0)
    u32x4 ua0, ua1, ub0, ub1;
    __syncthreads();
    SSM_ULOAD(0, ua0, ua1); SSM_ULOAD(1, ub0, ub1);
    { const int p = tid & 63, d = tid >> 6; const float dt = expf(F.in[9][g]), lr = F.in[7][g * 64 + p], li = F.in[8][g * 64 + p];
      { const float mg = expf(d * dt * lr); float sn, cs; sincosf(d * dt * li, &sn, &cs); apow[d * 64 + p] = (f32x2){mg * cs, mg * sn}; }
      if (d == 0) { const float mg = expf(8.f * dt * lr); float sn, cs; sincosf(8.f * dt * li, &sn, &cs); apow[8 * 64 + p] = (f32x2){mg * cs, mg * sn}; }
      if (d == 1) {
        const float em1 = expm1f(dt * lr), th = dt * li; float sn, cs; sincosf(th, &sn, &cs);
        const float ai = (em1 + 1.f) * sn, sh = sinf(0.5f * th), num_re = em1 * cs - 2.f * sh * sh;
        const float den = lr * lr + li * li, cre = (num_re * lr + ai * li) / den, cim = (ai * lr - num_re * li) / den;
        const float* br = F.in[10] + (size_t)(g * 64 + p) * 16; const float* bi = F.in[11] + (size_t)(g * 64 + p) * 16;
#pragma unroll
        for (int h = 0; h < 16; ++h) bbar[p * 16 + h] = (f32x2){cre * br[h] - cim * bi[h], cre * bi[h] + cim * br[h]};
      }
      for (int i = tid; i < 1024; i += 512) clds[i] = (f32x2){Cre[i], Cim[i]};
    }
    SSM_USTORE(0, ua0, ua1); SSM_USTORE(1, ub0, ub1);
    __syncthreads();
    { const int d = tid >> 6, ho = (tid >> 2) & 15, hq = tid & 3; float k0 = 0.f, k1 = 0.f, k2 = 0.f, k3 = 0.f;
#pragma unroll 8
      for (int p = 0; p < 64; ++p) { const f32x2 cc = clds[ho * 64 + p]; const float cr = cc.x, ci = cc.y; const f32x2 a = apow[d * 64 + p]; const float wr = cr * a.x - ci * a.y, wi = cr * a.y + ci * a.x;
          const f32x2 b0 = bbar[p * 16 + 4 * hq], b1 = bbar[p * 16 + 4 * hq + 1], b2 = bbar[p * 16 + 4 * hq + 2], b3 = bbar[p * 16 + 4 * hq + 3];
          k0 += wr * b0.x - wi * b0.y; k1 += wr * b1.x - wi * b1.y; k2 += wr * b2.x - wi * b2.y; k3 += wr * b3.x - wi * b3.y; }
      *(LAS f32x4*)(Kd + (d * 16 + ho) * 16 + 4 * hq) = (f32x4){k0, k1, k2, k3}; }
    __syncthreads();
    bf16x8 bE[4], bT[4], bC[4];
    { const int p = (16 * w + nl) & 63; const bool im = w >= 4;
#pragma unroll
      for (int t = 0; t < 4; ++t) { const int j = 2 * t + (kg >> 1); const f32x2 a = apow[(7 - j) * 64 + p]; float v[8];
#pragma unroll
          for (int jj = 0; jj < 8; ++jj) { const f32x2 b = bbar[p * 16 + 8 * (kg & 1) + jj]; v[jj] = im ? (a.x * b.y + a.y * b.x) : (a.x * b.x - a.y * b.y); }
          bE[t] = pack_frag(v); } }
#pragma unroll
    for (int t = 0; t < 4; ++t) { const int j = 2 * t + (kg >> 1); float v[8];
#pragma unroll
        for (int jj = 0; jj < 8; ++jj) v[jj] = (j <= w) ? Kd[(((w - j) & 7) * 16 + nl) * 16 + 8 * (kg & 1) + jj] : 0.f;
        bT[t] = pack_frag(v); }
#pragma unroll
    for (int t = 0; t < 4; ++t) { float v[8];
#pragma unroll
        for (int jj = 0; jj < 8; ++jj) { const int p = 16 * t + 4 * kg + (jj >> 1); const f32x2 a = apow[(w + 1) * 64 + p]; const f32x2 cc = clds[nl * 64 + p]; const float cr = cc.x, ci = cc.y;
            v[jj] = (jj & 1) == 0 ? (cr * a.x - ci * a.y) : (-cr * a.y - ci * a.x); }
        bC[t] = pack_frag(v); }
    const f32x2 a8 = apow[8 * 64 + lane];
    const int ecol = 2 * ((16 * w + nl) & 63) + (w >> 2);
    bf16_t* Y1 = WSP(bf16_t, WS_Y1); const float dsk = F.in[14][g * 16 + nl];
#define SSM_UFRAG(b, mt, t) (*(const LAS bf16x8*)(ub + ((b) % 3) * 64 * SSM_UP + (16 * (mt) + nl) * SSM_UP + (32 * (t) + 8 * kg) * 2))
#define SSM_EGEMM(b) do { LAS float* e_ = eb + ((b) & 1) * 64 * SSM_EP; _Pragma("unroll") for (int mt = 0; mt < 4; ++mt) { f32x4 c_ = (f32x4){0.f, 0.f, 0.f, 0.f}; \
        _Pragma("unroll") for (int t = 0; t < 4; ++t) c_ = __builtin_amdgcn_mfma_f32_16x16x32_bf16(SSM_UFRAG(b, mt, t), bE[t], c_, 0, 0, 0); \
        _Pragma("unroll") for (int r = 0; r < 4; ++r) e_[(16 * mt + 4 * kg + r) * SSM_EP + ecol] = c_[r]; } } while (0)
    __syncthreads();
    SSM_EGEMM(0);
    f32x2 xs = (f32x2){0.f, 0.f};
    __syncthreads();
#pragma unroll 1
    for (int b = 0; b < bend; ++b) {
        const bool full = b >= bfull;
        if (b + 2 < bend) SSM_ULOAD(b + 2, ua0, ua1);
        if (w == 0) {
            const LAS f32x2* e_ = (const LAS f32x2*)(eb + (b & 1) * 64 * SSM_EP) + lane;
            const f32x2 aa = (f32x2){a8.x, a8.x}, ab = (f32x2){-a8.y, a8.y};
#pragma unroll
            for (int hf = 0; hf < 2; ++hf) { f32x2 ev[32];
#pragma unroll
                for (int c = 0; c < 32; ++c) ev[c] = e_[(32 * hf + c) * (SSM_EP / 2)];
#pragma unroll
                for (int c = 0; c < 32; ++c) { *(LAS unsigned*)(sb + (32 * hf + c) * SSM_SP + lane * 4) = pk2(xs.x, xs.y);
                    xs = aa * xs + (ab * (f32x2){xs.y, xs.x} + ev[c]); } }
        }
        f32x4 acc[4];
        if (full) {
#pragma unroll
            for (int mt = 0; mt < 4; ++mt) { acc[mt] = (f32x4){0.f, 0.f, 0.f, 0.f};
#pragma unroll
                for (int t = 0; t < 4; ++t) acc[mt] = __builtin_amdgcn_mfma_f32_16x16x32_bf16(SSM_UFRAG(b, mt, t), bT[t], acc[mt], 0, 0, 0); }
        }
        if (b + 1 < bend) SSM_EGEMM(b + 1);
        if (b + 2 < bend) SSM_USTORE(b + 2, ua0, ua1);
        __syncthreads();
        if (full) {
#pragma unroll
            for (int mt = 0; mt < 4; ++mt) {
#pragma unroll
                for (int t = 0; t < 4; ++t) { const bf16x8 sf = *(const LAS bf16x8*)(sb + (16 * mt + nl) * SSM_SP + (32 * t + 8 * kg) * 2); acc[mt] = __builtin_amdgcn_mfma_f32_16x16x32_bf16(sf, bC[t], acc[mt], 0, 0, 0); }
            }
            { const LAS unsigned char* u_ = ub + (b % 3) * 64 * SSM_UP;
#pragma unroll
              for (int mt = 0; mt < 4; ++mt)
#pragma unroll
                for (int r2 = 0; r2 < 2; ++r2) { const int row = 16 * mt + 4 * kg + 2 * r2, ch = 64 * b + row, pos = 8 * ch + w;
                    const float u0 = bf2f(*(const LAS bf16_t*)(u_ + row * SSM_UP + (w * 16 + nl) * 2)), u1 = bf2f(*(const LAS bf16_t*)(u_ + (row + 1) * SSM_UP + (w * 16 + nl) * 2));
                    const f32x2 ge = gelu_pk((f32x2){acc[mt][2 * r2] + dsk * u0, acc[mt][2 * r2 + 1] + dsk * u1});
                    if (ch < SSM_NCH && pos >= NMETA) Y1[(size_t)(pos - NMETA) * SW + g * 16 + nl] = (bf16_t)f2bf(ge.x);
                    if (ch + 1 < SSM_NCH && pos + 8 >= NMETA) Y1[(size_t)(pos + 8 - NMETA) * SW + g * 16 + nl] = (bf16_t)f2bf(ge.y); } }
            __syncthreads();
        }
    }
#undef SSM_ULOAD
#undef SSM_USTORE
#undef SSM_UFRAG
#undef SSM_EGEMM
}

__device__ __forceinline__ void ln1_pass(Frame& F) {
    const int gw = F.c * 8 + F.wave, NGW = F.G * 8;
    const bf16_t* H = WSP(bf16_t, WS_H1F); const bf16_t* H0 = WSP(bf16_t, WS_H0B); bf16_t* Hb = WSP(bf16_t, WS_H1B); unsigned char* Hq = WSP(unsigned char, WS_H1LO);
    stage_gb(F, F.in[18], F.in[19]);
    const LAS f32x4* gl = (const LAS f32x4*)F.lds; const LAS f32x4* bl = (const LAS f32x4*)(F.lds + 16384);
#pragma unroll 1
    for (int r = gw; r < T_TOK; r += NGW) {
        const u32x2* x = (const u32x2*)(H + (size_t)r * DM) + F.lane; const u32x2* x0 = (const u32x2*)(H0 + (size_t)r * DM) + F.lane;
        u32x2* ob = (u32x2*)(Hb + (size_t)r * DM) + F.lane; unsigned* oq = (unsigned*)(Hq + (size_t)r * DM) + F.lane;
        float s = 0.f, q = 0.f;
#pragma unroll
        for (int j = 0; j < 16; ++j) { const u32x2 w = x[64 * j], w0 = x0[64 * j];
            const f32x4 v = (f32x4){bf_lo(w0.x), bf_hi(w0.x), bf_lo(w0.y), bf_hi(w0.y)} * ALPHA + (f32x4){bf_lo(w.x), bf_hi(w.x), bf_lo(w.y), bf_hi(w.y)};
            s += (v[0] + v[1]) + (v[2] + v[3]); q += (v[0] * v[0] + v[1] * v[1]) + (v[2] * v[2] + v[3] * v[3]); }
        const float mean = wave_sum(s) * (1.f / DM), var = fmaxf(wave_sum(q) * (1.f / DM) - mean * mean, 0.f), rstd = 1.f / sqrtf(var + LN_EPS);
        asm volatile("" ::: "memory");
#pragma unroll
        for (int j = 0; j < 16; ++j) { const u32x2 w = __builtin_nontemporal_load(x + 64 * j), w0 = __builtin_nontemporal_load(x0 + 64 * j);
            const f32x4 v = (f32x4){bf_lo(w0.x), bf_hi(w0.x), bf_lo(w0.y), bf_hi(w0.y)} * ALPHA + (f32x4){bf_lo(w.x), bf_hi(w.x), bf_lo(w.y), bf_hi(w.y)};
            const f32x4 y = (v - mean) * rstd * gl[F.lane + 64 * j] + bl[F.lane + 64 * j];
            ob[64 * j] = (u32x2){pk2(y[0], y[1]), pk2(y[2], y[3])}; __builtin_nontemporal_store(pg8::pack4_fp8(y), oq + 64 * j);
            if ((j & 3) == 3) asm volatile("" ::: "memory"); }
    }
}

__device__ __forceinline__ void route_pass(Frame& F) {
    const int gw = F.c * 8 + F.wave, NGW = F.G * 8, lane = F.lane;
    LAS unsigned* hist = (LAS unsigned*)F.lds;
    __syncthreads();
    if (F.tid < NE) hist[F.tid] = 0u;
    __syncthreads();
    const float* Lg = WSP(float, WS_LOGITS); int* TI = WSP(int, WS_TOPI); float* TW = WSP(float, WS_TOPW);
    const float bias = F.in[21][lane];
    constexpr int RT = 4;
    for (int t = gw; t < T_TOK; t += RT * NGW) {
        float score[RT], sel[RT], val[RT], myw[RT], wsum[RT]; int myi[RT];
#pragma unroll
        for (int q = 0; q < RT; ++q) { const int tq = (t + q * NGW < T_TOK) ? t + q * NGW : t;
            const float lg = Lg[(size_t)tq * 128 + lane] + Lg[(size_t)tq * 128 + 64 + lane];
            score[q] = 1.f / (1.f + expf(-lg)); sel[q] = score[q] + bias; }
#pragma unroll
        for (int q = 0; q < RT; ++q) {
            int rk = 0;
#pragma unroll
            for (int x = 1; x < 8; ++x) { const float o = __shfl_xor(sel[q], x); const int pl = lane ^ x; rk += (o > sel[q] || (o == sel[q] && pl < lane)) ? 1 : 0; }
            float gs = rk < 2 ? sel[q] : 0.f; gs += __shfl_xor(gs, 1); gs += __shfl_xor(gs, 2); gs += __shfl_xor(gs, 4);
            int grk = 0; const int mg = lane >> 3;
#pragma unroll
            for (int x = 1; x < 8; ++x) { const float o = __shfl_xor(gs, 8 * x); const int og = mg ^ x; grk += (o > gs || (o == gs && og < mg)) ? 1 : 0; }
            val[q] = grk < 4 ? sel[q] : -1e30f; myi[q] = 0; myw[q] = 0.f; wsum[q] = 0.f; }
#pragma unroll
        for (int k = 0; k < TOPK; ++k)
#pragma unroll
            for (int q = 0; q < RT; ++q) {
                const float mx = wave_max(val[q]); const unsigned long long bal = __ballot(val[q] == mx); const int win = __builtin_ctzll(bal);
                const float ws = __shfl(score[q], win); wsum[q] += ws;
                if (lane == k) { myi[q] = win; myw[q] = ws; }
                if (lane == win) val[q] = -3e38f; }
#pragma unroll
        for (int q = 0; q < RT; ++q) { const int tq = t + q * NGW;
            if (tq < T_TOK && lane < TOPK) { TI[tq * TOPK + lane] = myi[q]; TW[tq * TOPK + lane] = myw[q] / wsum[q] * 2.5f; __hip_atomic_fetch_add(&hist[myi[q]], 1u, __ATOMIC_RELAXED, __HIP_MEMORY_SCOPE_WORKGROUP); } }
    }
    __syncthreads();
    if (F.tid < NE && hist[F.tid]) __hip_atomic_fetch_add(F.ctl + CW_CNT + F.tid, hist[F.tid], RLX_AGENT);
    __syncthreads();
}

__device__ __forceinline__ void lists_pass(Frame& F) {
    LAS int* sh = (LAS int*)F.lds;
    const int* TI = WSP(int, WS_TOPI); int* POS = WSP(int, WS_POS); int* RT = WSP(int, WS_ROWTOK); int* TE = WSP(int, WS_TILEE); int* UT = WSP(int, WS_UTAB);
    for (int e = F.c; e < NE; e += F.G) {
        __syncthreads();
        if (F.tid < NE) sh[F.tid] = (int)__hip_atomic_load(F.ctl + CW_CNT + F.tid, RLX_AGENT);
        __syncthreads();
        int tb = 0; for (int j = 0; j < e; ++j) tb += (sh[j] + 255) >> 8;
        const int cnt = sh[e], mytiles = (cnt + 255) >> 8, base = tb * 256;
        if (e == NE - 1 && F.tid == 0) __hip_atomic_store(F.ctl + CW_NTILES, (unsigned)(tb + mytiles), RLX_AGENT);
        int kk[16]; int loc = 0;
#pragma unroll
        for (int j = 0; j < 16; ++j) { const int t = F.tid * 16 + j; const u32x4 a = *(const u32x4*)(TI + t * 8), b = *(const u32x4*)(TI + t * 8 + 4);
            int k = -1; k = (int)a.x == e ? 0 : k; k = (int)a.y == e ? 1 : k; k = (int)a.z == e ? 2 : k; k = (int)a.w == e ? 3 : k; k = (int)b.x == e ? 4 : k; k = (int)b.y == e ? 5 : k; k = (int)b.z == e ? 6 : k; k = (int)b.w == e ? 7 : k;
            kk[j] = k; loc += (k >= 0) ? 1 : 0; }
        int inc = loc;
#pragma unroll
        for (int o = 1; o < 64; o <<= 1) { const int v = __shfl_up(inc, o); if (F.lane >= o) inc += v; }
        if (F.lane == 63) sh[64 + F.wave] = inc;
        __syncthreads();
        int woff = 0; for (int w = 0; w < F.wave; ++w) woff += sh[64 + w];
        int rank = woff + inc - loc;
#pragma unroll
        for (int j = 0; j < 16; ++j) if (kk[j] >= 0) { const int t = F.tid * 16 + j; RT[base + rank] = t; POS[t * 8 + kk[j]] = base + rank; ++rank; }
        for (int i = cnt + F.tid; i < mytiles * 256; i += 512) RT[base + i] = 0;
        if (F.tid < mytiles) TE[tb + F.tid] = e;
        for (int idx = F.tid; idx < mytiles * 16; idx += 512) { const int pb = idx / (mytiles * 8), rem = idx % (mytiles * 8), t = rem >> 3, pn = pb * 8 + (rem & 7);
            UT[tb * 16 + idx] = (tb + t) | (pn << 16) | (e << 24); }
    }
}

__device__ __forceinline__ void combine_pass(Frame& F) {
    const int gw = F.c * 8 + F.wave, NGW = F.G * 8;
    const bf16_t* H = WSP(bf16_t, WS_H1B); const unsigned char* Y = WSP(unsigned char, WS_YB); const int* POS = WSP(int, WS_POS); const float* TW = WSP(float, WS_TOPW);
    stage_gb(F, F.in[28], F.in[29]);
    for (int t = gw; t < T_TOK; t += NGW) {
        f32x4 v[16]; const u32x2* hr = (const u32x2*)(H + (size_t)t * DM) + F.lane;
#pragma unroll
        for (int j = 0; j < 16; ++j) { const u32x2 h = __builtin_nontemporal_load(hr + 64 * j); v[j] = (f32x4){bf_lo(h.x), bf_hi(h.x), bf_lo(h.y), bf_hi(h.y)}; }
#pragma unroll 2
        for (int k = 0; k < TOPK; ++k) { const int row = POS[t * TOPK + k]; const float w = TW[t * TOPK + k]; const unsigned* yr = (const unsigned*)(Y + (size_t)row * DM) + F.lane;
#pragma unroll
            for (int j = 0; j < 16; ++j) { const int y = (int)__builtin_nontemporal_load(yr + 64 * j); const f32x2 lo = __builtin_amdgcn_cvt_pk_f32_fp8(y, false), hi = __builtin_amdgcn_cvt_pk_f32_fp8(y, true); v[j] += (f32x4){lo.x, lo.y, hi.x, hi.y} * w; } }
        float s = 0.f;
#pragma unroll
        for (int j = 0; j < 16; ++j) s += (v[j][0] + v[j][1]) + (v[j][2] + v[j][3]);
        const float mean = wave_sum(s) * (1.f / DM); float s2 = 0.f;
#pragma unroll
        for (int j = 0; j < 16; ++j) { v[j] = v[j] - mean; s2 += (v[j][0] * v[j][0] + v[j][1] * v[j][1]) + (v[j][2] * v[j][2] + v[j][3] * v[j][3]); }
        const float rstd = 1.f / sqrtf(wave_sum(s2) * (1.f / DM) + LN_EPS);
        f32x4* o = (f32x4*)(F.out + (size_t)t * DM) + F.lane;
        asm volatile("" ::: "memory");
#pragma unroll
        for (int j = 0; j < 16; ++j) { const f32x4 gg = ((const LAS f32x4*)F.lds)[F.lane + 64 * j], bb = ((const LAS f32x4*)(F.lds + 16384))[F.lane + 64 * j]; __builtin_nontemporal_store(v[j] * rstd * gg + bb, o + 64 * j); }
    }
}

#ifndef DUMP
#define DUMP 0
#endif
__device__ __forceinline__ void dump_f32(Frame& F, const float* src) {
    for (size_t i = (size_t)F.c * 512 + F.tid; i < (size_t)T_TOK * DM / 4; i += (size_t)F.G * 512) ((f32x4*)F.out)[i] = ((const f32x4*)src)[i];
}
__device__ __forceinline__ void dump_bf16(Frame& F, const bf16_t* src, int ld, int ncols, int colofs, size_t nrows) {
    for (size_t i = (size_t)F.c * 512 + F.tid; i < nrows * ncols; i += (size_t)F.G * 512) { const size_t r = i / ncols, c = i % ncols; if (r < T_TOK) F.out[r * DM + colofs + c] = bf2f(src[r * ld + c]); }
}
__device__ __forceinline__ void dump_zero(Frame& F) {
    for (size_t i = (size_t)F.c * 512 + F.tid; i < (size_t)T_TOK * DM / 4; i += (size_t)F.G * 512) ((f32x4*)F.out)[i] = (f32x4){0.f, 0.f, 0.f, 0.f};
}
__device__ __forceinline__ void p1_convert(Frame& F, int when) {
    int c = F.c; asm volatile("" : "+s"(c));
    LAS unsigned* scr = (LAS unsigned*)(F.lds + F.wave * 8704);
    const bool split = (F.G == 256);
    const int NT = split ? CVT_P1_TILES : 3 * NE * 64 * 8;
    if (!split) { if (when == 0) { cvt_run(F, 1, 8, c * 8 + F.wave, F.G * 8, scr); cvt_run(F, 8, 11, c * 8 + F.wave, F.G * 8, scr); } return; }
    const int nA = 58, sB = 294, sA = 354;
    const int kc = (c >> 3) & 1;
    if (kc != when) return;
    int tlo, thi;
    if (c < 256 - nA) { tlo = c * sB; thi = tlo + sB; } else { tlo = (256 - nA) * sB + (c - (256 - nA)) * sA; thi = tlo + sA; }
    if (thi > NT) thi = NT; if (tlo > NT) tlo = NT;
    cvt_run(F, 8, 11, F.wave, 8, scr, tlo, thi);
    cvt_run(F, 1, 8, c * 8 + F.wave, F.G * 8, scr);
}
struct Args { const float* in[30]; float* out; unsigned char* ws; int ph_lo, ph_hi, one, pad; };
__global__ void __launch_bounds__(512, 2) mk_fwd(Args args) {
    extern __shared__ __attribute__((aligned(16))) unsigned char lds[];
    Frame F;
    F.lds = (LAS unsigned char*)lds; F.ws = args.ws; F.ctl = (gu32*)(args.ws + WS_CTL);
    F.tid = threadIdx.x; F.lane = F.tid & 63; F.wave = __builtin_amdgcn_readfirstlane(F.tid >> 6); F.G = gridDim.x; F.c = blockIdx.x;
    F.in = args.in; F.out = args.out;
    volatile LAS unsigned* MISC = (volatile LAS unsigned*)(F.lds + MISC_OFF);
    for (int u = F.tid; u < (LDS_BYTES - RING_BYTES) / 4; u += 512) ((LAS unsigned*)(F.lds + RING_BYTES))[u] = 0u;
    __syncthreads();
    XcdBarrier bar; bar.bar = (unsigned*)(F.ctl + CW_BAR); bar.x = 0; bar.st = nullptr;
    if (args.one) bar = xcd_barrier_post((unsigned*)(F.ctl + CW_BAR), MISC + 8);
    const int lo = args.ph_lo, hi = args.ph_hi;
#ifndef PH_MASK
#define PH_MASK 0xffffffffu
#endif
#define IN(k) (((PH_MASK >> (k)) & 1u) && lo <= (k) && (k) < hi)
#define SEAM(k) do { if (IN(k) && IN((k) + 1)) xcd_barrier(bar); REFRESH(); } while (0)
#define REFRESH() do { int t_ = threadIdx.x; asm volatile("" : "+v"(t_)); F.tid = t_; F.lane = t_ & 63; F.wave = __builtin_amdgcn_readfirstlane(t_ >> 6); } while (0)
#ifndef HOT12
#define HOT12 0
#endif
#ifndef PROBE_REP
#define PROBE_REP 0u
#endif
#define RUN(k, ...) if (IN(k)) { __VA_ARGS__ if ((PROBE_REP >> (k)) & 1u) { xcd_barrier(bar); REFRESH(); __VA_ARGS__ } }
    LAS unsigned char* ring = F.lds;

    RUN(0, { p0_prologue(F);  }) SEAM(0);
    RUN(1, {
        p1_convert(F, 0); __syncthreads();
        { pg8::DenseSched S{(const char*)WSP(unsigned char, WS_H0Q), (const char*)(WSP(unsigned char, WS_WING) + (size_t)10240 * DM), DM / 2, 33, 6, F.G, F.c, 0, 0, 0};
          pg8::EpiZ E{WSP(bf16_t, WS_KB), WSP(bf16_t, WS_VB), WSP(bf16_t, WS_UG)};
          pg8::gemm_phase<pg8::EpiZ, pg8::DenseSched, true>(ring, F.tid, DM / 2, DM / 2, S, E); }
        __syncthreads(); REFRESH();
        { pg8::DenseSched S{(const char*)WSP(unsigned char, WS_H0Q), (const char*)WSP(unsigned char, WS_WING), DM / 2, 32, 40, F.G, F.c, 0, 0, 0};
          pg8::EpiGate EG{WSP(bf16_t, WS_QB), WSP(bf16_t, WS_GA), WSP(bf16_t, WS_GS)};
          pg8::gemm_phase<pg8::EpiGate, pg8::DenseSched, true>(ring, F.tid, DM / 2, DM / 2, S, EG); }
        __syncthreads(); p1_convert(F, 1);
    }) SEAM(1);
    RUN(2, {
        const bool big = F.G >= 256; const int ntask = big ? 128 : 64;
        for (int t = F.c; t < ntask; t += F.G) { const int g = big ? t >> 1 : t, hf = big ? (t & 1) : 0; ssm_unit(F, g, hf ? 11 : 0, (big && !hf) ? 11 : SSM_NBLK); }
        const int a0 = big ? F.c - 128 : F.c, astep = big ? F.G - 128 : F.G;
        if (a0 >= 0) for (int u = a0; u < 256; u += astep) attn_unit(F, u >> 2, u & 3);
    }) SEAM(2);
    RUN(3, {
        pg8::DenseSched S{(const char*)WSP(unsigned char, WS_ATT), (const char*)WSP(unsigned char, WS_WAO), AW / 2, 32, 16, F.G, F.c, 0, 0, 0};
        pg8::EpiMix<false> E{WSP(bf16_t, WS_GA), WSP(bf16_t, WS_MIX), nullptr};
        pg8::gemm_phase<pg8::EpiMix<false>, pg8::DenseSched, true>(ring, F.tid, AW / 2, AW / 2, S, E);
    }) REFRESH();
    RUN(4, {
        if (F.G == 256 && F.c >= 128) { LAS unsigned* scr = (LAS unsigned*)(F.lds + F.wave * 8704); const int t0 = CVT_P1_TILES + CVT_P11_TILES + (F.c - 128) * CVT_P4_PER; cvt_run(F, 8, 11, F.wave, 8, scr, t0, t0 + CVT_P4_PER); }
        pg8::DenseSched S{(const char*)WSP(bf16_t, WS_Y1), (const char*)WSP(bf16_t, WS_WGLU), SW, 32, 4, F.G, F.c, 0, 0, 0};
        pg8::EpiGlu E{WSP(bf16_t, WS_Y1), WSP(unsigned char, WS_Y2)};
        pg8::gemm_phase(ring, F.tid, SW, SW, S, E);
    }) SEAM(4);
    RUN(5, {
        pg8::DenseSched S{(const char*)WSP(unsigned char, WS_Y2), (const char*)WSP(unsigned char, WS_WSO), SW / 2, 32, 16, F.G, F.c, 0, 0, 0};
        pg8::EpiMix<true> E{WSP(bf16_t, WS_GS), WSP(bf16_t, WS_MIX), WSP(unsigned char, WS_H0Q)};
        pg8::gemm_phase<pg8::EpiMix<true>, pg8::DenseSched, true>(ring, F.tid, SW / 2, SW / 2, S, E);
    }) SEAM(5);
    RUN(6, {
        pg8::DenseSched S{(const char*)WSP(unsigned char, WS_H0Q), (const char*)WSP(unsigned char, WS_WOUT), DM / 2, 32, 16, F.G, F.c, 0, 0, 0};
        pg8::EpiWout E{WSP(bf16_t, WS_H1F)};
        pg8::gemm_phase<pg8::EpiWout, pg8::DenseSched, true>(ring, F.tid, DM / 2, DM / 2, S, E);
    }) SEAM(6);
    RUN(7, { ln1_pass(F);  }) SEAM(7);
    RUN(8, {
        if (F.G == 256 && F.c >= 160) { LAS unsigned* scr = (LAS unsigned*)(F.lds + F.wave * 8704); const int t0 = CVT_P1_TILES + CVT_P11_TILES + CVT_P4_TILES + (F.c - 160) * CVT_P8_PER; cvt_run(F, 8, 11, F.wave, 8, scr, t0, t0 + CVT_P8_PER); }
        pg8::DenseSched S{(const char*)WSP(bf16_t, WS_H1B), (const char*)WSP(bf16_t, WS_WS13), DM, 32, 5, F.G, F.c, 0, 0, 0};
        pg8::EpiS13R E{WSP(bf16_t, WS_ACTS), WSP(float, WS_LOGITS)};
        pg8::gemm_phase(ring, F.tid, DM, DM, S, E);
    }) SEAM(8);
    RUN(9, { route_pass(F);  }) SEAM(9);
    RUN(10, { lists_pass(F);
        if (F.G == 256 && args.one && F.c >= 64) { pg8::DenseSched S{(const char*)WSP(bf16_t, WS_ACTS), (const char*)WSP(bf16_t, WS_WS2), EDIM, 32, 16, 192, F.c - 64, 0, 0, 0}; S.i1 = 2;
            pg8::EpiS2 E{WSP(bf16_t, WS_H1B)};
            pg8::gemm_phase(ring, F.tid, EDIM, EDIM, S, E); }
    }) SEAM(10);
    RUN(11, {
        const int ntiles = __builtin_amdgcn_readfirstlane((int)__hip_atomic_load(F.ctl + CW_NTILES, RLX_AGENT));
        { pg8::MoeSched S{(const char*)WSP(unsigned char, WS_H1LO), (const char*)WSP(unsigned char, WS_WE13), DM / 2, WSP(int, WS_ROWTOK), WSP(int, WS_TILEE), 4, (size_t)1024 * DM, ntiles * 4, F.G, F.c};
          pg8::EpiAct E{WSP(unsigned char, WS_ACT)};
          pg8::gemm_phase<pg8::EpiAct, pg8::MoeSched, true>(ring, F.tid, DM / 2, DM / 2, S, E); }
        { const bool early = (F.G == 256 && args.one);
          const int rem = (ntiles * 4) % F.G, nl = F.G - rem; const bool lite = early && rem > 0 && nl >= 64;
          if (!lite || F.c >= rem) {
          pg8::DenseSched S{(const char*)WSP(bf16_t, WS_ACTS), (const char*)WSP(bf16_t, WS_WS2), EDIM, 32, 16, lite ? nl : F.G, lite ? F.c - rem : F.c, 0, 0, 0}; S.l0 = early ? 384 : 0;
          pg8::EpiS2 E{WSP(bf16_t, WS_H1B)};
          pg8::gemm_phase(ring, F.tid, EDIM, EDIM, S, E); }
          if (F.G == 256) { __syncthreads(); LAS unsigned* scr = (LAS unsigned*)(F.lds + F.wave * 8704);
              if (!lite || F.c >= rem) cvt_run(F, 8, 11, (lite ? F.c - rem : F.c) * 8 + F.wave, (lite ? nl : F.G) * 8, scr, CVT_P1_TILES, CVT_P1_TILES + CVT_P11_TILES); } }
    }) SEAM(11);
    RUN(12, {
        const int ntiles = __builtin_amdgcn_readfirstlane((int)__hip_atomic_load(F.ctl + CW_NTILES, RLX_AGENT)); const int nunits = ntiles * 16;
        LAS int* lut = (LAS int*)(F.lds + LUT_OFF);
#if HOT12
        __syncthreads();
        if (F.tid < 64) lut[F.tid] = (F.c & 3) | (((F.c >> 2) & 15) << 16);
        __syncthreads();
        { pg8::MoeTabSched S{(const char*)WSP(unsigned char, WS_ACT), (const char*)WSP(unsigned char, WS_WE2), EDIM / 2, lut, (size_t)DM * EDIM, nunits, F.G, F.c};
          pg8::EpiY E{WSP(unsigned char, WS_YB)};
          pg8::gemm_phase<pg8::EpiY, pg8::MoeTabSched, true>(ring, F.tid, EDIM / 2, EDIM / 2, S, E); }
        xcd_barrier(bar); REFRESH();
#endif
        __syncthreads();
        if (F.tid < 64) { const int L = F.tid * F.G + F.c; lut[F.tid] = L < nunits ? WSP(int, WS_UTAB)[pg8::xcd_remap(L, nunits)] : 0; }
        __syncthreads();
        pg8::MoeTabSched S{(const char*)WSP(unsigned char, WS_ACT), (const char*)WSP(unsigned char, WS_WE2), EDIM / 2, lut, (size_t)DM * EDIM, nunits, F.G, F.c};
        pg8::EpiY E{WSP(unsigned char, WS_YB)};
        pg8::gemm_phase<pg8::EpiY, pg8::MoeTabSched, true>(ring, F.tid, EDIM / 2, EDIM / 2, S, E);
    }) SEAM(12);
    RUN(13, { combine_pass(F);  })
#if DUMP
    if (lo <= 14 && 14 < hi) {
#if DUMP == 1
        dump_f32(F, WSP(float, WS_H1F));
#elif DUMP == 2
        dump_bf16(F, WSP(bf16_t, WS_MIX), DM, DM, 0, T_TOK);
#elif DUMP == 3
        dump_zero(F); __syncthreads();
        dump_bf16(F, WSP(bf16_t, WS_ATT), AW, AW, 0, T_TOK); dump_bf16(F, WSP(bf16_t, WS_Y1), SW, SW, AW, T_TOK);
#elif DUMP == 4
        dump_zero(F); __syncthreads();
        dump_bf16(F, WSP(bf16_t, WS_QB), AW, AW, 0, T_TOK); dump_bf16(F, WSP(bf16_t, WS_KB), KVW, KVW, AW, T_TOK); dump_bf16(F, WSP(bf16_t, WS_VB), KVW, KVW, AW + KVW, T_TOK);
        dump_bf16(F, WSP(bf16_t, WS_UG), 1026, 1026, AW + 2 * KVW, T_TOK);
#elif DUMP == 5
        dump_bf16(F, WSP(bf16_t, WS_GA), DM, DM, 0, T_TOK);
#elif DUMP == 7
        dump_bf16(F, WSP(bf16_t, WS_WIN) + (size_t)3584 * DM, DM, DM, 0, T_TOK);
#elif DUMP == 6
        dump_bf16(F, WSP(bf16_t, WS_H0B), DM, DM, 0, T_TOK);
#endif
    }
#endif
#undef IN
#undef SEAM
}

#ifndef PH_MASK
#define PH_MASK_HOST 0xffffffffu
#else
#define PH_MASK_HOST (PH_MASK)
#endif
extern "C" void kernel_launch(void* const* d_in, const int* in_sizes, int n_in, void* d_out, int out_size, void* d_ws, size_t ws_size, hipStream_t stream) {
    static int grid = 0;
    if (grid == 0) {
        if (n_in != 30 || in_sizes[0] != T_TOK * DM || out_size != T_TOK * DM || ws_size < WS_END) { fprintf(stderr, "kernel_launch: unexpected shapes / workspace (n_in %d, ws %zu, need %zu)\n", n_in, ws_size, (size_t)WS_END); grid = -1; return; }
        int dev = 0, cus = 0, per_cu = 0;
        if (hipGetDevice(&dev) != hipSuccess || hipDeviceGetAttribute(&cus, hipDeviceAttributeMultiprocessorCount, dev) != hipSuccess) { grid = -1; return; }
        if (hipFuncSetAttribute((const void*)mk_fwd, hipFuncAttributeMaxDynamicSharedMemorySize, LDS_BYTES) != hipSuccess) { fprintf(stderr, "kernel_launch: hipFuncSetAttribute failed\n"); grid = -1; return; }
        if (hipOccupancyMaxActiveBlocksPerMultiprocessor(&per_cu, (const void*)mk_fwd, 512, LDS_BYTES) != hipSuccess || per_cu < 1) fprintf(stderr, "kernel_launch: occupancy query reports %d\n", per_cu);
        (void)hipGetLastError();
        grid = cus;
    }
    if (grid < 0) return;
    if (hipMemsetAsync((char*)d_ws + WS_CTL, 0, CTL_ZERO_BYTES, stream) != hipSuccess) return;
    Args a{};
    for (int i = 0; i < 30; ++i) a.in[i] = (const float*)d_in[i];
    a.out = (float*)d_out; a.ws = (unsigned char*)d_ws; a.pad = 0;
#if MK_ONE_LAUNCH
    a.ph_lo = 0; a.ph_hi = NPHASE; a.one = 1;
    hipLaunchKernelGGL(mk_fwd, dim3(grid), dim3(512), LDS_BYTES, stream, a);
#else
    for (int p = 0; p < NPHASE + (DUMP ? 1 : 0); ++p) { a.ph_lo = p; a.ph_hi = p + 1; a.one = 0;
        if (!((PH_MASK_HOST >> p) & 1u)) continue;
        hipLaunchKernelGGL(mk_fwd, dim3(grid), dim3(512), LDS_BYTES, stream, a); }
#endif
}
```

```cpp
#include <hip/hip_runtime.h>
#include <cstdio>
#include <cstdint>

#define LAS __attribute__((address_space(3)))
#define GAS __attribute__((address_space(1)))
typedef unsigned short bf16_t;
typedef short bf16x8 __attribute__((ext_vector_type(8)));
typedef float f32x4 __attribute__((ext_vector_type(4)));
typedef float f32x2 __attribute__((ext_vector_type(2)));
typedef unsigned u32x4 __attribute__((ext_vector_type(4)));
typedef unsigned u32x2 __attribute__((ext_vector_type(2)));
typedef GAS unsigned gu32;

#ifndef MK_ONE_LAUNCH
#define MK_ONE_LAUNCH 1
#endif

constexpr int T_TOK = 8192, DM = 4096, NMETA = 16, ROWS_Z = 8448, KVROWS = 8208;
constexpr int NZ = 11776, AW = 2048, KVW = 256, SW = 1024;
constexpr int NE = 64, TOPK = 8, EDIM = 512;
constexpr float ALPHA = 1.189207115002721f;
constexpr float LN_EPS = 1e-5f;
constexpr float LOG2E = 1.4426950408889634f;
constexpr float QSCALE = 0.125f * LOG2E;
constexpr int MAXTILES = 320;
constexpr int NPHASE = 14;
constexpr int CVT_P11_TILES = 4608;
constexpr int CVT_P8_PER = 120, CVT_P4_PER = 28, CVT_P8_TILES = 96 * CVT_P8_PER, CVT_P4_TILES = 128 * CVT_P4_PER, CVT_P1_TILES = 3 * NE * 64 * 8 - CVT_P8_TILES - CVT_P4_TILES - CVT_P11_TILES;

constexpr size_t MiB = 1u << 20;
constexpr size_t WS_CTL = 0, CTL_ZERO_BYTES = 32768;
constexpr size_t WS_TOPI = 1 * MiB, WS_TOPW = WS_TOPI + 256 * 1024, WS_POS = WS_TOPW + 256 * 1024;
constexpr size_t WS_ROWTOK = 2 * MiB, WS_TILEE = 2 * MiB + 512 * 1024, WS_UTAB = WS_TILEE + 8192  , WS_STATS0 = 2 * MiB + 768 * 1024;
constexpr size_t WS_SSME = 3 * MiB, WS_LOGITS = 4 * MiB;
constexpr size_t WS_H1F = 8 * MiB, WS_H1B = 136 * MiB, WS_H1LO = 200 * MiB, WS_ACT = 264 * MiB, WS_ACTS = 344 * MiB;
constexpr size_t WS_WE2 = 352 * MiB, WS_WS2 = 608 * MiB, WS_WS13 = 612 * MiB;
constexpr size_t WS_WE13 = 640 * MiB, WS_WIN = 1152 * MiB, WS_WAO = 1244 * MiB, WS_WGLU = 1260 * MiB, WS_WSO = 1262 * MiB, WS_WOUT = 1270 * MiB;
constexpr size_t WS_H0B = 1302 * MiB, WS_QB = 1368 * MiB, WS_KB = 1400 * MiB, WS_VB = 1405 * MiB, WS_UG = 1410 * MiB;
constexpr size_t WS_GA = 1427 * MiB, WS_GS = 1491 * MiB, WS_ATT = 1555 * MiB, WS_Y1 = 1587 * MiB, WS_Y2 = 1603 * MiB, WS_MIX = 1619 * MiB;
constexpr size_t WS_END = 1683 * MiB;
constexpr size_t WS_WING = WS_WIN + 16 * MiB;
constexpr size_t WS_H0Q = WS_ACT + 40 * MiB;
constexpr size_t WS_YB = 640 * MiB;
static_assert(WS_YB + (size_t)MAXTILES * 256 * DM * 2 <= WS_H0B, "YB overlay");
constexpr int CW_TMO = 0, CW_CODE = 1, CW_NTILES = 64, CW_CNT = 128  , CW_BAR = 4096;

constexpr int RING_BYTES = 131072, LDS_BYTES = 147456, MISC_OFF = LDS_BYTES - 256, LUT_OFF = LDS_BYTES - 1024;

#define RLX_AGENT __ATOMIC_RELAXED, __HIP_MEMORY_SCOPE_AGENT
#define LDS_WAIT() asm volatile("s_waitcnt lgkmcnt(0)" ::: "memory")
#define VM_WAIT() asm volatile("s_waitcnt vmcnt(0)" ::: "memory")
__device__ __forceinline__ unsigned f2bf(float f) { unsigned u = __builtin_bit_cast(unsigned, f); return (u + 0x7fffu + ((u >> 16) & 1u)) >> 16; }
typedef __bf16 bf16x2_t __attribute__((ext_vector_type(2)));
__device__ __forceinline__ unsigned pk2(float lo, float hi) { f32x2 v = {lo, hi}; bf16x2_t b = __builtin_convertvector(v, bf16x2_t); return __builtin_bit_cast(unsigned, b); }
__device__ __forceinline__ float bf_lo(unsigned w) { return __builtin_bit_cast(float, w << 16); }
__device__ __forceinline__ float bf_hi(unsigned w) { return __builtin_bit_cast(float, w & 0xffff0000u); }
__device__ __forceinline__ float bf2f(bf16_t h) { return __builtin_bit_cast(float, ((unsigned)h) << 16); }
__device__ __forceinline__ float fast_sigmoid(float x) { return __builtin_amdgcn_rcpf(1.0f + __builtin_amdgcn_exp2f(-x * LOG2E)); }
__device__ __forceinline__ float wave_sum(float v) {
#pragma unroll
    for (int o = 1; o < 64; o <<= 1) v += __shfl_xor(v, o);
    return v;
}
__device__ __forceinline__ float wave_max(float v) {
#pragma unroll
    for (int o = 1; o < 64; o <<= 1) v = fmaxf(v, __shfl_xor(v, o));
    return v;
}

#define XB_TMO      128
#define XB_XCNT(j)  (256  + 64 * (j))
#define XB_XSUB(j)  (1280 + 64 * (j))
#define XB_XGEN(j)  (2304 + 64 * (j))
#define XB_TOP      3328
#define XB_TOPGEN   3392
#define XCD_BAR_WORDS 3456
#define XB_SPIN_CAP (1u << 18)
__device__ __forceinline__ unsigned xb_ld(unsigned* p)              { return __hip_atomic_load(p, __ATOMIC_RELAXED, __HIP_MEMORY_SCOPE_AGENT); }
__device__ __forceinline__ unsigned xb_add(unsigned* p, unsigned v) { return __hip_atomic_fetch_add(p, v, __ATOMIC_RELAXED, __HIP_MEMORY_SCOPE_AGENT); }
__device__ __forceinline__ unsigned xb_xcc_id() { return (unsigned)__builtin_amdgcn_s_getreg((3 << 11) | 20) & 0xFu; }
#define XB_SPIN(cond, bar) do { unsigned _sp = 0; while (cond) { __builtin_amdgcn_s_sleep(1); \
    if ((++_sp & 255u) == 0u) { if (xb_ld(&(bar)[XB_TMO])) break; if (_sp > XB_SPIN_CAP) { atomicAdd(&(bar)[XB_TMO], 1u); break; } } } } while (0)
struct XcdBarrier { unsigned* bar; unsigned x; volatile LAS unsigned* st; };
__device__ __forceinline__ XcdBarrier xcd_barrier_post(unsigned* bar, volatile LAS unsigned* st) {
    XcdBarrier b; b.bar = bar; b.x = xb_xcc_id(); b.st = st;
    if (threadIdx.x == 0) (void)xb_add(&bar[XB_XCNT(b.x)], 1u);
    return b;
}
__device__ __forceinline__ void xcd_barrier_complete(unsigned* bar, unsigned x, unsigned& nloc, unsigned& nx) {
    const unsigned G = gridDim.x * gridDim.y * gridDim.z;
    unsigned sum, cnt, mine, sp = 0u;
    for (;;) {
        sum = 0u; cnt = 0u; mine = 0u;
#pragma unroll
        for (unsigned j = 0; j < 16; ++j) { const unsigned c = xb_ld(&bar[XB_XCNT(j)]); sum += c; cnt += (c > 0u) ? 1u : 0u; mine = (j == x) ? c : mine; }
        if (sum == G) break;
        __builtin_amdgcn_s_sleep(1);
        if ((++sp & 255u) == 0u) { if (xb_ld(&bar[XB_TMO])) break; if (sp > XB_SPIN_CAP) { atomicAdd(&bar[XB_TMO], 1u); break; } }
    }
    nloc = mine > 0u ? mine : 1u; nx = cnt > 0u ? cnt : 1u;
}
__device__ __forceinline__ void xcd_barrier(const XcdBarrier& b) {
    asm volatile("s_waitcnt vmcnt(0)" ::: "memory");
    __syncthreads();
    if (threadIdx.x == 0) {
        unsigned* bar = b.bar;
        __builtin_amdgcn_s_waitcnt(0);
        unsigned nloc = b.st[0], nx = b.st[1];
        if (nloc == 0u) { xcd_barrier_complete(bar, b.x, nloc, nx); b.st[0] = nloc; b.st[1] = nx; }
        const unsigned old = xb_add(&bar[XB_XSUB(b.x)], 1u);
        const unsigned gen = old / nloc;
        if (old + 1u == (gen + 1u) * nloc) {
            __builtin_amdgcn_fence(__ATOMIC_RELEASE, "agent");
            asm volatile("s_waitcnt vmcnt(0)" ::: "memory");
            const unsigned og = xb_add(&bar[XB_TOP], 1u);
            const unsigned tg = og / nx;
            if (og + 1u == (tg + 1u) * nx) xb_add(&bar[XB_TOPGEN], 1u);
            else XB_SPIN(xb_ld(&bar[XB_TOPGEN]) == tg, bar);
            __builtin_amdgcn_fence(__ATOMIC_ACQUIRE, "agent");
            xb_add(&bar[XB_XGEN(b.x)], 1u);
            asm volatile("s_waitcnt vmcnt(0)" ::: "memory");
        } else {
            XB_SPIN(xb_ld(&bar[XB_XGEN(b.x)]) == gen, bar);
            __builtin_amdgcn_fence(__ATOMIC_ACQUIRE, "agent");
            asm volatile("s_waitcnt vmcnt(0)" ::: "memory");
        }
    }
    __syncthreads();
}

namespace pg8 {
constexpr int BM = 256, BK = 64, HALF = 128, HTB = HALF * BK * 2, NXCD = 8, WGM = 8;
__device__ __forceinline__ int lds_byte(int r, int c) { return (r >> 3) * 1024 + (r & 7) * 128 + ((((c >> 3) ^ (r & 6)) & 7) << 4) + (c & 7) * 2; }
__device__ __forceinline__ void stage_rc(int b, int& R, int& C) { const int blk = b / 1024, sb = b % 1024; R = blk * 8 + (sb >> 7); C = ((((sb >> 4) & 7) ^ (R & 6)) & 7) * 8; }
__device__ __forceinline__ int perm32(int rho) { const int n = rho >> 4, i = rho & 15; return 8 * (i >> 2) + 4 * n + (i & 3); }
struct Unit { int pm, pn, e; };
__device__ __forceinline__ unsigned cvt_pk_bf16(float lo, float hi) { f32x2 v = {lo, hi}; bf16x2_t b = __builtin_convertvector(v, bf16x2_t); return __builtin_bit_cast(unsigned, b); }

__device__ __forceinline__ void tile_of(int L, int nM, int nN, int& pm, int& pn) {
    const int nwg = nM * nN; int wgid = L;
    { const int q = nwg / NXCD, r = nwg % NXCD, xcd = wgid % NXCD, off = wgid / NXCD; wgid = (xcd < r ? xcd * (q + 1) : r * (q + 1) + (xcd - r) * q) + off; }
    const int nig = WGM * nN, gid = wgid / nig, fm = gid * WGM, gsz = (nM - fm) < WGM ? (nM - fm) : WGM;
    pm = fm + ((wgid % nig) % gsz); pn = (wgid % nig) / gsz;
}
struct DenseSched {
    const char* A; const char* Bt; int K, nM, nN, G, c, xpm, xpn0, xn, i0 = 0, i1 = 0x7fffffff, l0 = 0;
    __device__ __forceinline__ bool next(int i, Unit& u) const {
        if (i + i0 >= i1) return false;
        const int L = (i + i0) * G + c + l0, nwg = nM * nN;
        if (L >= nwg) { const int x = L - nwg; if (x < xn) { u.pm = xpm; u.pn = xpn0 + x; u.e = 0; return true; } return false; }
        tile_of(L, nM, nN, u.pm, u.pn); u.e = 0; return true;
    }
    __device__ __forceinline__ int arow(const Unit& u, int r) const { return u.pm * BM + r; }
    __device__ __forceinline__ const char* abase(const Unit&) const { return A; }
    __device__ __forceinline__ const char* bbase(const Unit& u) const { return Bt + (size_t)u.pn * BM * K * 2; }
};
struct MoeSched {
    const char* A; const char* Bt; int K; const int* rowlist; const int* tile_e; int nN; size_t bstride; int nunits, G, c;
    __device__ __forceinline__ bool next(int i, Unit& u) const {
        const int L = i * G + c; if (L >= nunits) return false;
        const int q = nunits / NXCD, r = nunits % NXCD, xcd = L % NXCD, off = L / NXCD;
        const int wgid = (xcd < r ? xcd * (q + 1) : r * (q + 1) + (xcd - r) * q) + off;
        u.pm = wgid / nN; u.pn = wgid % nN;
        u.e = __builtin_amdgcn_readfirstlane((int)__hip_atomic_load((const unsigned*)tile_e + u.pm, RLX_AGENT));
        return true;
    }
    __device__ __forceinline__ int arow(const Unit& u, int r) const { return rowlist ? rowlist[u.pm * BM + r] : u.pm * BM + r; }
    __device__ __forceinline__ const char* abase(const Unit&) const { return A; }
    __device__ __forceinline__ const char* bbase(const Unit& u) const { return Bt + (size_t)u.e * bstride + (size_t)u.pn * BM * K * 2; }
};

struct MoeTabSched {
    const char* A; const char* Bt; int K; const LAS int* lut; size_t bstride; int nunits, G, c;
    __device__ __forceinline__ bool next(int i, Unit& u) const {
        if (i * G + c >= nunits) return false;
        const int v = __builtin_amdgcn_readfirstlane(lut[i]);
        u.pm = v & 0xffff; u.pn = (v >> 16) & 0xff; u.e = (v >> 24) & 0xff; return true;
    }
    __device__ __forceinline__ int arow(const Unit& u, int r) const { return u.pm * BM + r; }
    __device__ __forceinline__ const char* abase(const Unit&) const { return A; }
    __device__ __forceinline__ const char* bbase(const Unit& u) const { return Bt + (size_t)u.e * bstride + (size_t)u.pn * BM * K * 2; }
};
__device__ __forceinline__ int xcd_remap(int L, int nunits) { const int q = nunits / NXCD, r = nunits % NXCD, xcd = L % NXCD, off = L / NXCD; return (xcd < r ? xcd * (q + 1) : r * (q + 1) + (xcd - r) * q) + off; }

typedef int v8i __attribute__((ext_vector_type(8)));
typedef int v4i __attribute__((ext_vector_type(4)));
template <class E, class = void> struct epi_wide { static constexpr int v = 0; };
template <class E> struct epi_wide<E, decltype((void)E::WIDE)> { static constexpr int v = E::WIDE; };
template <bool FP8> struct Frag;
template <> struct Frag<false> { bf16x8 bh[2]; };
template <> struct Frag<true> { v8i q; };
template <class Epi, class Sched, bool FP8 = false>
__device__ __forceinline__ void gemm_phase(LAS unsigned char* lds, const int tid, const int K, const int lda, const Sched& S, const Epi& E) {
    const int wid = __builtin_amdgcn_readfirstlane(tid >> 6), lane = tid & 63, wr = wid >> 2, wc = wid & 3, fr = lane & 15, fq = lane >> 4;
    int nt = K / BK; asm volatile("" : "+s"(nt));
    int sc1 = 0x7f7f7f7f, scw = 0x79797979; asm volatile("" : "+v"(sc1), "+v"(scw));
    int Rr[2]; unsigned Cb[2], voffB[2];
    constexpr int WIDE = epi_wide<Epi>::v;
#pragma unroll
    for (int i = 0; i < 2; ++i) { int R, C; stage_rc(tid * 16 + i * 8192, R, C);
        const int Rb = WIDE == 1 ? (64 * (R >> 5) + 16 * ((R >> 2) & 3) + 4 * ((R >> 4) & 1) + (R & 3)) : WIDE == 2 ? (64 * (R >> 5) + 8 * ((R >> 2) & 3) + 4 * ((R >> 4) & 1) + (R & 3))
                     : Epi::PERM ? ((R & ~31) + perm32(R & 31)) : R;
        Rr[i] = R; Cb[i] = (unsigned)C * 2u; voffB[i] = (unsigned)(Rb * K + C) * 2u; }
    const unsigned lda2 = (unsigned)lda * 2u;
    const size_t kstep = (size_t)(BK * 2);
    const size_t hstepB = (size_t)(WIDE == 1 ? 8 : WIDE == 2 ? 32 : HALF) * K * 2;
    const unsigned ldsw = (unsigned)wid * 1024u;
    const int aoff = lds_byte(wr * 64 + fr, fq * 8), boff = lds_byte(wc * 32 + fr, fq * 8);
    const LAS unsigned char* pA = lds + aoff; const LAS unsigned char* pB = lds + 65536 + boff;
    const LAS unsigned char* pA2 = lds + (aoff ^ 64); const LAS unsigned char* pB2 = lds + 65536 + (boff ^ 64);
#define PG8_SA(b, h) (((b) * 2 + (h)) * HTB)
#define PG8_SB(b, h) ((4 + (b) * 2 + (h)) * HTB)
#define PG8_STAGE(bufoff, gbase, voff) do { _Pragma("unroll") for (int _i = 0; _i < 2; ++_i) \
        __builtin_amdgcn_global_load_lds((const unsigned*)((const char*)(gbase) + (voff)[_i]), (LAS unsigned*)(lds + (bufoff) + ldsw + _i * 8192), 16, 0, 0); } while (0)
#define PG8_LD32(p, p2, off) __builtin_shufflevector(*(const LAS v4i*)((p) + (off)), *(const LAS v4i*)((p2) + (off)), 0, 1, 2, 3, 4, 5, 6, 7)
#define PG8_LDA(dst, b, h) do { _Pragma("unroll") for (int m = 0; m < 4; ++m) { if constexpr (FP8) dst[m].q = PG8_LD32(pA, pA2, PG8_SA(b, h) + m * 2048); \
        else { dst[m].bh[0] = *(const LAS bf16x8*)(pA + PG8_SA(b, h) + m * 2048); dst[m].bh[1] = *(const LAS bf16x8*)(pA2 + PG8_SA(b, h) + m * 2048); } } } while (0)
#define PG8_LDB(dst, b, h) do { _Pragma("unroll") for (int n = 0; n < 2; ++n) { if constexpr (FP8) dst[n].q = PG8_LD32(pB, pB2, PG8_SB(b, h) - 65536 + n * 2048); \
        else { dst[n].bh[0] = *(const LAS bf16x8*)(pB + PG8_SB(b, h) - 65536 + n * 2048); dst[n].bh[1] = *(const LAS bf16x8*)(pB2 + PG8_SB(b, h) - 65536 + n * 2048); } } } while (0)
#define PG8_MMA(ai, bj, At, Bt) do { __builtin_amdgcn_s_setprio(1); _Pragma("unroll") for (int m = 0; m < 4; ++m) _Pragma("unroll") for (int n = 0; n < 2; ++n) { \
        if constexpr (FP8) asm volatile("v_mfma_scale_f32_16x16x128_f8f6f4 %0, %1, %2, %0, %3, %4 op_sel_hi:[0,0,0]" : "+v"(acc[ai][bj][m][n]) : "v"(Bt[n].q), "v"(At[m].q), "v"(scw), "v"(sc1)); \
        else { acc[ai][bj][m][n] = __builtin_amdgcn_mfma_f32_16x16x32_bf16(Bt[n].bh[0], At[m].bh[0], acc[ai][bj][m][n], 0, 0, 0); acc[ai][bj][m][n] = __builtin_amdgcn_mfma_f32_16x16x32_bf16(Bt[n].bh[1], At[m].bh[1], acc[ai][bj][m][n], 0, 0, 0); } } \
        __builtin_amdgcn_s_setprio(0); } while (0)
#define PG8_MMAZ(ai, bj, At, Bt) do { __builtin_amdgcn_s_setprio(1); _Pragma("unroll") for (int m = 0; m < 4; ++m) _Pragma("unroll") for (int n = 0; n < 2; ++n) \
        asm volatile("v_mfma_scale_f32_16x16x128_f8f6f4 %0, %1, %2, 0, %3, %4 op_sel_hi:[0,0,0]" : "+v"(acc[ai][bj][m][n]) : "v"(Bt[n].q), "v"(At[m].q), "v"(scw), "v"(sc1)); \
        __builtin_amdgcn_s_setprio(0); } while (0)
#define PG8_WAIT_V(n) asm volatile("s_waitcnt vmcnt(" #n ")" ::: "memory")
#define PG8_WAIT_V8E(c) do { if (Epi::NST > 0 && (c)) asm volatile("s_waitcnt vmcnt(%0)" :: "n"(8 + Epi::NST) : "memory"); else PG8_WAIT_V(8); } while (0)
#define PG8_WAIT_L(n) asm volatile("s_waitcnt lgkmcnt(" #n ")" ::: "memory")
#define PG8_BAR __builtin_amdgcn_s_barrier()
#define PG8_SCHED __builtin_amdgcn_sched_barrier(0)
    Unit cur, nxt; int ui = 0;
    if (!S.next(0, cur)) return;
    f32x4 acc[2][2][4][2];
#pragma unroll
    for (int a = 0; a < 2; ++a)
#pragma unroll
        for (int b = 0; b < 2; ++b)
#pragma unroll
            for (int m = 0; m < 4; ++m)
#pragma unroll
                for (int n = 0; n < 2; ++n) acc[a][b][m][n] = (f32x4){0.f, 0.f, 0.f, 0.f};
    Frag<FP8> At[4], B0[2], B1[2];
    const char* cA = S.abase(cur); const char* cB = S.bbase(cur);
    unsigned ofA0[2], ofA1[2];
#pragma unroll
    for (int i = 0; i < 2; ++i) { ofA0[i] = (unsigned)S.arow(cur, Rr[i]) * lda2 + Cb[i]; ofA1[i] = (unsigned)S.arow(cur, HALF + Rr[i]) * lda2 + Cb[i]; }
    PG8_STAGE(PG8_SB(0, 0), cB, voffB); PG8_STAGE(PG8_SB(0, 1), cB + hstepB, voffB); PG8_STAGE(PG8_SA(0, 0), cA, ofA0); PG8_STAGE(PG8_SA(0, 1), cA, ofA1);
    if (wr == 1) PG8_BAR;
    PG8_WAIT_V(2); PG8_BAR;
    PG8_STAGE(PG8_SB(1, 0), cB + kstep, voffB); PG8_STAGE(PG8_SA(1, 0), cA + kstep, ofA0); PG8_STAGE(PG8_SB(1, 1), cB + hstepB + kstep, voffB);
    PG8_WAIT_V(6); PG8_BAR;
    for (;;) {
        const bool has_next = S.next(ui + 1, nxt);
        const char* nA = has_next ? S.abase(nxt) : cA; const char* nB = has_next ? S.bbase(nxt) : cB;
        unsigned ofN0[2], ofN1[2];
#pragma unroll
        for (int i = 0; i < 2; ++i) { ofN0[i] = has_next ? (unsigned)S.arow(nxt, Rr[i]) * lda2 + Cb[i] : ofA0[i]; ofN1[i] = has_next ? (unsigned)S.arow(nxt, HALF + Rr[i]) * lda2 + Cb[i] : ofA1[i]; }
        for (int t = 0; t < nt; t += 2) {
            const bool last = (t == nt - 2);
            const char* a1 = cA + (size_t)(t + 1) * kstep;
            const char* a2 = last ? nA : cA + (size_t)(t + 2) * kstep; const char* b2 = last ? nB : cB + (size_t)(t + 2) * kstep;
            const char* a3 = a2 + kstep; const char* b3 = b2 + kstep;
            unsigned o20[2], o21[2];
#pragma unroll
            for (int i = 0; i < 2; ++i) { o20[i] = last ? ofN0[i] : ofA0[i]; o21[i] = last ? ofN1[i] : ofA1[i]; }
            const bool after_epi = (t == 0) && (ui > 0);
            PG8_LDB(B0, 0, 0); PG8_LDB(B1, 0, 1); PG8_SCHED; PG8_LDA(At, 0, 0); PG8_STAGE(PG8_SA(1, 1), a1, ofA1);
            PG8_WAIT_V8E(after_epi); PG8_WAIT_L(0); PG8_BAR;
            if constexpr (FP8) { if (t == 0) { PG8_MMAZ(0, 0, At, B0); PG8_MMAZ(0, 1, At, B1); } else { PG8_MMA(0, 0, At, B0); PG8_MMA(0, 1, At, B1); } } else { PG8_MMA(0, 0, At, B0); PG8_MMA(0, 1, At, B1); }
            PG8_BAR; PG8_SCHED;
            PG8_LDA(At, 0, 1); PG8_STAGE(PG8_SB(0, 0), b2, voffB); PG8_STAGE(PG8_SB(0, 1), b2 + hstepB, voffB); PG8_STAGE(PG8_SA(0, 0), a2, o20);
            PG8_WAIT_V8E(after_epi); PG8_WAIT_L(0); PG8_BAR;
            if constexpr (FP8) { if (t == 0) { PG8_MMAZ(1, 0, At, B0); PG8_MMAZ(1, 1, At, B1); } else { PG8_MMA(1, 0, At, B0); PG8_MMA(1, 1, At, B1); } } else { PG8_MMA(1, 0, At, B0); PG8_MMA(1, 1, At, B1); }
            PG8_BAR; PG8_SCHED;
            PG8_LDB(B0, 1, 0); PG8_LDB(B1, 1, 1); PG8_SCHED; PG8_LDA(At, 1, 0); PG8_STAGE(PG8_SA(0, 1), a2, o21);
            PG8_WAIT_V(8); PG8_WAIT_L(0); PG8_BAR; PG8_MMA(0, 0, At, B0); PG8_MMA(0, 1, At, B1); PG8_BAR; PG8_SCHED;
            PG8_LDA(At, 1, 1); PG8_STAGE(PG8_SB(1, 0), b3, voffB); PG8_STAGE(PG8_SB(1, 1), b3 + hstepB, voffB); PG8_STAGE(PG8_SA(1, 0), a3, o20);
            PG8_WAIT_V(8); PG8_WAIT_L(0); PG8_BAR; PG8_MMA(1, 0, At, B0); PG8_MMA(1, 1, At, B1); PG8_BAR; PG8_SCHED;
        }
        if (wr == 0) PG8_BAR;
        if constexpr (FP8) asm volatile("s_nop 15\n\ts_nop 15" ::: "memory");
        E(acc, cur, wr, wc, fr, fq);
        if (!has_next) break;
        if constexpr (!FP8) {
#pragma unroll
        for (int a = 0; a < 2; ++a)
#pragma unroll
            for (int b = 0; b < 2; ++b)
#pragma unroll
                for (int m = 0; m < 4; ++m)
#pragma unroll
                    for (int n = 0; n < 2; ++n) acc[a][b][m][n] = (f32x4){0.f, 0.f, 0.f, 0.f};
        }
        cur = nxt; cA = nA; cB = nB; ++ui;
#pragma unroll
        for (int i = 0; i < 2; ++i) { ofA0[i] = ofN0[i]; ofA1[i] = ofN1[i]; }
        if (wr == 1) PG8_BAR;
    }
    PG8_WAIT_V(0);
    PG8_BAR;
#undef PG8_SA
#undef PG8_SB
#undef PG8_STAGE
#undef PG8_LDA
#undef PG8_LD32
#undef PG8_LDB
#undef PG8_MMA
#undef PG8_MMAZ
#undef PG8_WAIT_V
#undef PG8_WAIT_V8E
#undef PG8_WAIT_L
#undef PG8_BAR
#undef PG8_SCHED
}

#define EPI_LOOP_ROWS for (int ai = 0; ai < 2; ++ai) _Pragma("unroll") for (int m = 0; m < 4; ++m)
__device__ __forceinline__ u32x4 pack8(const f32x4& v0, const f32x4& v1) { u32x4 w; w.x = cvt_pk_bf16(v0[0], v0[1]); w.y = cvt_pk_bf16(v0[2], v0[3]); w.z = cvt_pk_bf16(v1[0], v1[1]); w.w = cvt_pk_bf16(v1[2], v1[3]); return w; }
__device__ __forceinline__ void unpack8(const u32x4& w, f32x4& v0, f32x4& v1) { v0 = (f32x4){bf_lo(w.x), bf_hi(w.x), bf_lo(w.y), bf_hi(w.y)}; v1 = (f32x4){bf_lo(w.z), bf_hi(w.z), bf_lo(w.w), bf_hi(w.w)}; }
__device__ __forceinline__ unsigned pack4_fp8(const f32x4& v) { int w = __builtin_amdgcn_cvt_pk_fp8_f32(v[0], v[1], 0, false); w = __builtin_amdgcn_cvt_pk_fp8_f32(v[2], v[3], w, true); return (unsigned)w; }
__device__ __forceinline__ f32x4 sig4(const f32x4& v) { return (f32x4){fast_sigmoid(v[0]), fast_sigmoid(v[1]), fast_sigmoid(v[2]), fast_sigmoid(v[3])}; }

struct EpiZ {
    static constexpr bool PERM = true; static constexpr int NST = 0;
    bf16_t *Kb, *Vb, *Ug;
    __device__ __forceinline__ void operator()(const f32x4 (&acc)[2][2][4][2], const Unit& u, int wr, int wc, int fr, int fq) const {
        const int pn = u.pn;
#pragma unroll
        EPI_LOOP_ROWS {
            const int r = u.pm * BM + ai * HALF + wr * 64 + m * 16 + fr;
            if (r < KVROWS) { const int sp = r < T_TOK ? r + NMETA : r - T_TOK;
#pragma unroll
              for (int bj = 0; bj < 2; ++bj) {
                const int cl = bj * HALF + wc * 32 + 8 * fq;
                const f32x4 v0 = acc[ai][bj][m][0], v1 = acc[ai][bj][m][1];
                if (pn == 0) *(u32x4*)(Kb + (size_t)sp * KVW + cl) = pack8(v0, v1);
                else if (pn == 1) { bf16_t* vp = Vb + (size_t)cl * KVROWS + sp;
#pragma unroll
                    for (int j = 0; j < 4; ++j) { vp[(size_t)j * KVROWS] = (bf16_t)f2bf(v0[j]); vp[(size_t)(4 + j) * KVROWS] = (bf16_t)f2bf(v1[j]); } }
                else { const int col = (pn - 2) * BM + cl;
                    *(u32x4*)(Ug + ((size_t)(col >> 4) * KVROWS + sp) * 16 + (col & 15)) = pack8(v0, v1); }
              } }
        }
    }
};
struct EpiGate {
    static constexpr bool PERM = true; static constexpr int NST = 0; static constexpr int WIDE = 2;
    bf16_t *Q, *Ga, *Gs;
    __device__ __forceinline__ void operator()(const f32x4 (&acc)[2][2][4][2], const Unit& u, int wr, int wc, int fr, int fq) const {
        const int row0 = u.pm * BM + wr * 64 + fr, cl = wc * 64 + 8 * fq;
        if (u.pn < 8) {
            bf16_t* base = Q + (size_t)row0 * AW + u.pn * BM + cl;
#pragma unroll
            EPI_LOOP_ROWS {
#pragma unroll
                for (int bj = 0; bj < 2; ++bj) *(u32x4*)(base + (size_t)(ai * HALF + m * 16) * AW + bj * 32) = pack8(acc[ai][bj][m][0] * QSCALE, acc[ai][bj][m][1] * QSCALE); }
        } else {
            bf16_t* base = (u.pn < 24 ? Ga : Gs) + (size_t)row0 * DM + ((u.pn - 8) & 15) * BM + cl;
#pragma unroll
            EPI_LOOP_ROWS {
#pragma unroll
                for (int bj = 0; bj < 2; ++bj) __builtin_nontemporal_store(pack8(sig4(acc[ai][bj][m][0]), sig4(acc[ai][bj][m][1])), (u32x4*)(base + (size_t)(ai * HALF + m * 16) * DM + bj * 32)); }
        }
    }
};
struct EpiGlu {
    static constexpr bool PERM = true; static constexpr int NST = 0;
    const bf16_t* Y1; unsigned char* Y2;
    __device__ __forceinline__ void operator()(const f32x4 (&acc)[2][2][4][2], const Unit& u, int wr, int wc, int fr, int fq) const {
#pragma unroll
        EPI_LOOP_ROWS { const size_t r = (size_t)u.pm * BM + ai * HALF + wr * 64 + m * 16 + fr;
#pragma unroll
            for (int bj = 0; bj < 2; ++bj) { const size_t off = r * SW + u.pn * BM + bj * HALF + wc * 32 + 8 * fq;
                f32x4 y0, y1; unpack8(*(const u32x4*)(Y1 + off), y0, y1);
                *(u32x2*)(Y2 + off) = (u32x2){pack4_fp8(y0 * sig4(acc[ai][bj][m][0])), pack4_fp8(y1 * sig4(acc[ai][bj][m][1]))}; } }
    }
};
template <bool ADD> struct EpiMix {
    static constexpr bool PERM = true; static constexpr int NST = 0; static constexpr int WIDE = ADD ? 1 : 2;
    const bf16_t* Gt; bf16_t* Mix; unsigned char* MixQ;
    __device__ __forceinline__ void operator()(const f32x4 (&acc)[2][2][4][2], const Unit& u, int wr, int wc, int fr, int fq) const {
#pragma unroll
        EPI_LOOP_ROWS { const size_t r = (size_t)u.pm * BM + ai * HALF + wr * 64 + m * 16 + fr;
            const size_t off0 = r * DM + u.pn * BM + wc * 64 + (ADD ? 16 : 8) * fq; unsigned q[4];
#pragma unroll
            for (int bj = 0; bj < 2; ++bj) { const size_t off = off0 + bj * (ADD ? 8 : 32);
                f32x4 g0, g1; unpack8(*(const u32x4*)(Gt + off), g0, g1);
                f32x4 o0 = g0 * acc[ai][bj][m][0], o1 = g1 * acc[ai][bj][m][1];
                if (ADD) { f32x4 p0, p1; unpack8(*(const u32x4*)(Mix + off), p0, p1); o0 += p0; o1 += p1; q[2 * bj] = pack4_fp8(o0); q[2 * bj + 1] = pack4_fp8(o1); }
                else *(u32x4*)(Mix + off) = pack8(o0, o1); }
            if (ADD) *(u32x4*)(MixQ + off0) = (u32x4){q[0], q[1], q[2], q[3]};
        }
    }
};
struct EpiWout {
    static constexpr bool PERM = true; static constexpr int NST = 0; static constexpr int WIDE = 2;
    bf16_t* Out;
    __device__ __forceinline__ void operator()(const f32x4 (&acc)[2][2][4][2], const Unit& u, int wr, int wc, int fr, int fq) const {
        const int col0 = u.pn * BM + wc * 64 + 8 * fq;
#pragma unroll
        EPI_LOOP_ROWS { const size_t r = (size_t)u.pm * BM + ai * HALF + wr * 64 + m * 16 + fr; const size_t off = r * DM + col0;
#pragma unroll
            for (int bj = 0; bj < 2; ++bj) *(u32x4*)(Out + off + bj * 32) = pack8(acc[ai][bj][m][0], acc[ai][bj][m][1]); }
    }
};
struct EpiS13R {
    static constexpr bool PERM = true; static constexpr int NST = 0;
    bf16_t* ActS; float* Logits;
    __device__ __forceinline__ void operator()(const f32x4 (&acc)[2][2][4][2], const Unit& u, int wr, int wc, int fr, int fq) const {
#pragma unroll
        EPI_LOOP_ROWS { const size_t r = (size_t)u.pm * BM + ai * HALF + wr * 64 + m * 16 + fr; const int cl = wc * 32 + 8 * fq;
            if (u.pn < 4) { const f32x4 a0 = acc[ai][0][m][0], a1 = acc[ai][0][m][1];
                *(u32x4*)(ActS + r * EDIM + u.pn * HALF + cl) = pack8(a0 * sig4(a0) * acc[ai][1][m][0], a1 * sig4(a1) * acc[ai][1][m][1]); }
            else { *(f32x4*)(Logits + r * 128 + cl) = acc[ai][0][m][0]; *(f32x4*)(Logits + r * 128 + cl + 4) = acc[ai][0][m][1]; } }
    }
};
constexpr float WQ_SCALE = 64.f, WQ_INV = 1.f / 64.f;
struct EpiAct {
    static constexpr bool PERM = true; static constexpr int NST = 0;
    unsigned char* Act;
    __device__ __forceinline__ void operator()(const f32x4 (&acc)[2][2][4][2], const Unit& u, int wr, int wc, int fr, int fq) const {
#pragma unroll
        EPI_LOOP_ROWS { const size_t r = (size_t)u.pm * BM + ai * HALF + wr * 64 + m * 16 + fr; const int cl = wc * 32 + 8 * fq;
            const f32x4 a0 = acc[ai][0][m][0], a1 = acc[ai][0][m][1];
            *(u32x2*)(Act + r * EDIM + u.pn * HALF + cl) = (u32x2){pack4_fp8(a0 * sig4(a0) * acc[ai][1][m][0]), pack4_fp8(a1 * sig4(a1) * acc[ai][1][m][1])}; }
    }
};
struct EpiS2 {
    static constexpr bool PERM = true; static constexpr int NST = 0; static constexpr int WIDE = 2;
    bf16_t* H;
    __device__ __forceinline__ void operator()(const f32x4 (&acc)[2][2][4][2], const Unit& u, int wr, int wc, int fr, int fq) const {
#pragma unroll
        EPI_LOOP_ROWS { const size_t r = (size_t)u.pm * BM + ai * HALF + wr * 64 + m * 16 + fr;
#pragma unroll
            for (int bj = 0; bj < 2; ++bj) { bf16_t* p = H + r * DM + u.pn * BM + bj * 32 + wc * 64 + 8 * fq; f32x4 h0, h1; unpack8(*(const u32x4*)p, h0, h1);
                *(u32x4*)p = pack8(h0 * ALPHA + acc[ai][bj][m][0], h1 * ALPHA + acc[ai][bj][m][1]); } }
    }
};
struct EpiY {
    static constexpr bool PERM = true; static constexpr int NST = 8; static constexpr int WIDE = 1;
    unsigned char* Y;
    __device__ __forceinline__ void operator()(const f32x4 (&acc)[2][2][4][2], const Unit& u, int wr, int wc, int fr, int fq) const {
#pragma unroll
        EPI_LOOP_ROWS { const size_t r = (size_t)u.pm * BM + ai * HALF + wr * 64 + m * 16 + fr;
            *(u32x4*)(Y + r * DM + u.pn * BM + wc * 64 + 16 * fq) = (u32x4){pack4_fp8(acc[ai][0][m][0]), pack4_fp8(acc[ai][0][m][1]), pack4_fp8(acc[ai][1][m][0]), pack4_fp8(acc[ai][1][m][1])}; }
    }
};
}

struct Frame {
    LAS unsigned char* lds; gu32* ctl; unsigned char* ws;
    int tid, lane, wave, G, c;
    const float* const* in; float* out;
};
#define WSP(T, off) ((T*)(F.ws + (off)))

struct CvtRegs { f32x4 v[16]; };
__device__ __forceinline__ void cvt_load(CvtRegs& R, const float* __restrict__ W, size_t ldw, int k0, int n0, int lane) {
    const float* src = W + (size_t)(k0 + 2 * (lane >> 4)) * ldw + n0 + 4 * (lane & 15);
#pragma unroll
    for (int ip = 0; ip < 8; ++ip) { R.v[2 * ip] = __builtin_nontemporal_load((const f32x4*)(src + (size_t)(8 * ip) * ldw)); R.v[2 * ip + 1] = __builtin_nontemporal_load((const f32x4*)(src + (size_t)(8 * ip + 1) * ldw)); }
}
template <bool LO>
__device__ __forceinline__ void cvt_store(const CvtRegs& R, int k0, bf16_t* Wt, size_t dpitch, size_t drow0, LAS unsigned* scr, int lane) {
    const int kq = lane >> 4, n4 = 4 * (lane & 15);
#pragma unroll
    for (int ip = 0; ip < 8; ++ip) { f32x4 a = R.v[2 * ip], b = R.v[2 * ip + 1];
        if (LO) {
#pragma unroll
            for (int j = 0; j < 4; ++j) { a[j] -= __builtin_bit_cast(float, f2bf(a[j]) << 16); b[j] -= __builtin_bit_cast(float, f2bf(b[j]) << 16); } }
#pragma unroll
        for (int j = 0; j < 4; ++j) scr[(n4 + j) * 33 + 4 * ip + kq] = pk2(a[j], b[j]); }
    LDS_WAIT();
    const int c = lane & 7;
#pragma unroll
    for (int j = 0; j < 8; ++j) { const int n = (lane >> 3) + 8 * j; const LAS unsigned* s = scr + n * 33 + 4 * c;
        u32x4 o; o.x = s[0]; o.y = s[1]; o.z = s[2]; o.w = s[3];
        __builtin_nontemporal_store(o, (u32x4*)(Wt + (drow0 + n) * dpitch + k0 + 8 * c)); }
    LDS_WAIT();
}
template <bool LO>
__device__ __forceinline__ void cvt_tile(const float* __restrict__ W, size_t ldw, int k0, int n0, bf16_t* Wt, size_t dpitch, size_t drow0, LAS unsigned* scr, int lane) {
    CvtRegs R; cvt_load(R, W, ldw, k0, n0, lane); cvt_store<LO>(R, k0, Wt, dpitch, drow0, scr, lane);
}
__device__ __forceinline__ void cvt_load8(CvtRegs& R, const float* __restrict__ W, size_t ldw, int k0, int n0, int lane) {
    const float* src = W + (size_t)(k0 + 4 * (lane >> 3)) * ldw + n0 + 4 * (lane & 7);
#pragma unroll
    for (int ip = 0; ip < 4; ++ip)
#pragma unroll
        for (int b = 0; b < 4; ++b) R.v[4 * ip + b] = __builtin_nontemporal_load((const f32x4*)(src + (size_t)(32 * ip + b) * ldw));
}
__device__ __forceinline__ void cvt_store8(const CvtRegs& R, int k0, unsigned char* Wt, size_t dpitch, size_t drow0, float scale, LAS unsigned* scr, int lane, bool nt = true) {
    const int kr = lane >> 3, n4 = 4 * (lane & 7);
#pragma unroll
    for (int ip = 0; ip < 4; ++ip)
#pragma unroll
        for (int j = 0; j < 4; ++j) { int w = __builtin_amdgcn_cvt_pk_fp8_f32(R.v[4 * ip][j] * scale, R.v[4 * ip + 1][j] * scale, 0, false); w = __builtin_amdgcn_cvt_pk_fp8_f32(R.v[4 * ip + 2][j] * scale, R.v[4 * ip + 3][j] * scale, w, true);
            scr[(n4 + j) * 33 + 8 * ip + kr] = (unsigned)w; }
    LDS_WAIT();
    const int c = lane & 7;
#pragma unroll
    for (int j = 0; j < 4; ++j) { const int n = (lane >> 3) + 8 * j; const LAS unsigned* sp = scr + n * 33 + 4 * c;
        u32x4 o; o.x = sp[0]; o.y = sp[1]; o.z = sp[2]; o.w = sp[3];
        if (nt) __builtin_nontemporal_store(o, (u32x4*)(Wt + (drow0 + n) * dpitch + k0 + 16 * c)); else *(u32x4*)(Wt + (drow0 + n) * dpitch + k0 + 16 * c) = o; }
    LDS_WAIT();
}
struct CvtJob { const float* W; void* Wt; int K, N, mode, nmat; size_t wstride, dstride; int fp8; int ldw; };
__device__ __forceinline__ int cvt_job_tiles(const CvtJob& j) { return j.nmat * (j.K / 64) * (j.N / 64); }
struct CvtTile { const float* W; void* Wt; size_t ldw, dpitch, drow0; int k0, n0; };
__device__ __forceinline__ CvtTile cvt_job_tile(const CvtJob& j, int it) {
    const int tn = j.fp8 ? 32 : 64, tk = j.fp8 ? 128 : 64;
    const int nnb = j.N / tn, per = (j.K / tk) * nnb, mat = it / per, r = it % per, kb = r / nnb, nb = r % nnb, n0 = nb * tn;
    const size_t drow0 = j.mode == 0 ? (size_t)n0 : (size_t)(n0 >> 7) * 256 + (j.mode - 1) * 128 + (n0 & 127);
    void* wt = j.fp8 ? (void*)((unsigned char*)j.Wt + (size_t)mat * j.dstride) : (void*)((bf16_t*)j.Wt + (size_t)mat * j.dstride);
    return CvtTile{j.W + (size_t)mat * j.wstride, wt, (size_t)(j.ldw ? j.ldw : j.N), (size_t)j.K, drow0, kb * tk, n0};
}
__device__ __forceinline__ void ln_row(const float* xrow, const LAS f32x4* g, const LAS f32x4* b, int lane, f32x4 (&v)[16], float& mean, float& rstd) {
    const f32x4* xr = (const f32x4*)xrow + lane; float s = 0.f;
#pragma unroll
    for (int j = 0; j < 16; ++j) { v[j] = __builtin_nontemporal_load(xr + 64 * j); s += (v[j][0] + v[j][1]) + (v[j][2] + v[j][3]); }
    mean = wave_sum(s) * (1.f / DM); float s2 = 0.f;
#pragma unroll
    for (int j = 0; j < 16; ++j) { v[j] = v[j] - mean; s2 += (v[j][0] * v[j][0] + v[j][1] * v[j][1]) + (v[j][2] * v[j][2] + v[j][3] * v[j][3]); }
    rstd = 1.f / sqrtf(wave_sum(s2) * (1.f / DM) + LN_EPS);
    asm volatile("" ::: "memory");
#pragma unroll
    for (int j = 0; j < 16; ++j) { const f32x4 gg = g[lane + 64 * j], bb = b[lane + 64 * j]; v[j] = v[j] * rstd * gg + bb; }
}

__device__ __forceinline__ void cvt_run(const Frame& F, int j0, int j1, int gw, int NGW, LAS unsigned* scr, int tlo = 0, int thi = 0x7fffffff) {
    int done = 0;
#pragma unroll 1
    for (int jn = j0; jn < j1; ++jn) {
        CvtJob j;
        switch (jn) {
            case 0: j = CvtJob{F.in[4] + 2048, WSP(unsigned char, WS_WING) + (size_t)10240 * DM, DM, 1536, 0, 1, 0, 0, 1, NZ}; break;
            case 11: j = CvtJob{F.in[4] + 3584, WSP(unsigned char, WS_WING) + (size_t)2048 * DM, DM, 2 * DM, 0, 1, 0, 0, 1, NZ}; break;
            case 12: j = CvtJob{F.in[4], WSP(unsigned char, WS_WING), DM, 2048, 0, 1, 0, 0, 1, NZ}; break;
            case 1: j = CvtJob{F.in[6], WSP(unsigned char, WS_WAO), AW, DM, 0, 1, 0, 0, 1, 0}; break;
            case 2: j = CvtJob{F.in[15], WSP(bf16_t, WS_WGLU), SW, SW, 0, 1, 0, 0, 0, 0}; break;
            case 3: j = CvtJob{F.in[16], WSP(unsigned char, WS_WSO), SW, DM, 0, 1, 0, 0, 1, 0}; break;
            case 4: j = CvtJob{F.in[17], WSP(unsigned char, WS_WOUT), DM, DM, 0, 1, 0, 0, 1, 0}; break;
            case 5: j = CvtJob{F.in[25], WSP(bf16_t, WS_WS13), DM, EDIM, 1, 1, 0, 0, 0, 0}; break;
            case 6: j = CvtJob{F.in[26], WSP(bf16_t, WS_WS13), DM, EDIM, 2, 1, 0, 0, 0, 0}; break;
            case 7: j = CvtJob{F.in[27], WSP(bf16_t, WS_WS2), EDIM, DM, 0, 1, 0, 0, 0, 0}; break;
            case 8: j = CvtJob{F.in[22], WSP(unsigned char, WS_WE13), DM, EDIM, 1, NE, (size_t)DM * EDIM, (size_t)1024 * DM, 1, 0}; break;
            case 9: j = CvtJob{F.in[23], WSP(unsigned char, WS_WE13), DM, EDIM, 2, NE, (size_t)DM * EDIM, (size_t)1024 * DM, 1, 0}; break;
            default: j = CvtJob{F.in[24], WSP(unsigned char, WS_WE2), EDIM, DM, 0, NE, (size_t)EDIM * DM, (size_t)DM * EDIM, 1, 0}; break;
        }
        const int nt0 = cvt_job_tiles(j);
        const int nt = (thi - done) < nt0 ? (thi - done) : nt0;
        int it = (tlo - done) > 0 ? (tlo - done) : 0;
        { const int gfirst = done + it; const int r = (gw - (gfirst - tlo) % NGW + NGW) % NGW; it += r; }
        if (it < nt) {
            CvtTile tc = cvt_job_tile(j, it); CvtRegs Ra;
            if (j.fp8) cvt_load8(Ra, tc.W, tc.ldw, tc.k0, tc.n0, F.lane); else cvt_load(Ra, tc.W, tc.ldw, tc.k0, tc.n0, F.lane);
#pragma unroll 1
            for (;;) {
                const int itn = it + NGW; const bool more = itn < nt;
                CvtTile tn = tc; CvtRegs Rb;
                if (more) { tn = cvt_job_tile(j, itn); if (j.fp8) cvt_load8(Rb, tn.W, tn.ldw, tn.k0, tn.n0, F.lane); else cvt_load(Rb, tn.W, tn.ldw, tn.k0, tn.n0, F.lane); }
                if (j.fp8) cvt_store8(Ra, tc.k0, (unsigned char*)tc.Wt, tc.dpitch, tc.drow0, pg8::WQ_SCALE, scr, F.lane, j.ldw == 0); else cvt_store<false>(Ra, tc.k0, (bf16_t*)tc.Wt, tc.dpitch, tc.drow0, scr, F.lane);
                if (!more) break;
                Ra = Rb; tc = tn; it = itn;
            }
        }
        done += nt0;
    }
}
__device__ __forceinline__ void stage_gb(Frame& F, const float* g, const float* b) {
    __syncthreads();
    for (int i = F.tid; i < DM / 4; i += 512) { ((LAS f32x4*)F.lds)[i] = ((const f32x4*)g)[i]; ((LAS f32x4*)(F.lds + 16384))[i] = ((const f32x4*)b)[i]; }
    __syncthreads();
}
__device__ __forceinline__ void p0_prologue(Frame& F) {
    LAS unsigned* scr = (LAS unsigned*)(F.lds + 32768 + F.wave * 8704);
    const int gw = F.c * 8 + F.wave, NGW = F.G * 8;
    stage_gb(F, F.in[2], F.in[3]);
    { bf16_t* H0B = WSP(bf16_t, WS_H0B); f32x2* St0 = WSP(f32x2, WS_STATS0);
      for (int r = gw; r < ROWS_Z; r += NGW) {
          u32x2* o = (u32x2*)(H0B + (size_t)r * DM) + F.lane;
          if (r < KVROWS) { const float* src = r < T_TOK ? F.in[0] + (size_t)r * DM : F.in[1] + (size_t)(r - T_TOK) * DM;
              f32x4 v[16]; float mean, rstd; ln_row(src, (const LAS f32x4*)F.lds, (const LAS f32x4*)(F.lds + 16384), F.lane, v, mean, rstd);
              if (r < T_TOK && F.lane == 0) St0[r] = (f32x2){mean, rstd};
#pragma unroll
              for (int j = 0; j < 16; ++j) __builtin_nontemporal_store((u32x2){pk2(v[j][0], v[j][1]), pk2(v[j][2], v[j][3])}, o + 64 * j);
              { unsigned* oq = (unsigned*)(WSP(unsigned char, WS_H0Q) + (size_t)r * DM) + F.lane;
#pragma unroll
                  for (int j = 0; j < 16; ++j) oq[64 * j] = pg8::pack4_fp8(v[j]); }
          } else { unsigned* oq = (unsigned*)(WSP(unsigned char, WS_H0Q) + (size_t)r * DM) + F.lane;
#pragma unroll
              for (int j = 0; j < 16; ++j) { o[64 * j] = (u32x2){0u, 0u}; oq[64 * j] = 0u; }
          } } }
    cvt_run(F, 0, 1, gw, NGW, scr); cvt_run(F, 11, 13, gw, NGW, scr);
    { bf16_t* Wr = WSP(bf16_t, WS_WS13);
      for (int kb = gw; kb < DM / 64; kb += NGW) { cvt_tile<false>(F.in[20], NE, kb * 64, 0, Wr, DM, 1024, scr, F.lane); cvt_tile<true>(F.in[20], NE, kb * 64, 0, Wr, DM, 1088, scr, F.lane); }
      u32x4* z = (u32x4*)(Wr + (size_t)1152 * DM);
      for (int i = (F.c * 512 + F.tid); i < 128 * DM * 2 / 16; i += F.G * 512) z[i] = (u32x4){0u, 0u, 0u, 0u}; }
}

typedef float f32x16 __attribute__((ext_vector_type(16)));
constexpr int ATT_KP = 144, ATT_VP = 584, ATT_V_OFF = 288 * ATT_KP;
static_assert(ATT_V_OFF + 64 * ATT_VP <= RING_BYTES, "attention LDS");
__device__ __forceinline__ int att_src_pos(int key, int n) {
    if (key < 128) return n > 0 ? NMETA + 128 * (n - 1) + key : -1;
    if (key < 256) return NMETA + 128 * n + (key - 128);
    if (key < 272) return key - 256;
    return -1;
}
__device__ __forceinline__ void attn_unit(Frame& F, int n, int kh) {
    const bf16_t* Qb = WSP(bf16_t, WS_QB); const bf16_t* Kb = WSP(bf16_t, WS_KB); const bf16_t* Vt = WSP(bf16_t, WS_VB); unsigned char* At = WSP(unsigned char, WS_ATT);
    LAS unsigned char* Ks = F.lds; LAS unsigned char* Vs = F.lds + ATT_V_OFF;
    __syncthreads();
    for (int p = F.tid; p < 288 * 8; p += 512) { const int j = p >> 3, c8 = p & 7, sp = att_src_pos(j, n);
        u32x4 v = (u32x4){0u, 0u, 0u, 0u};
        if (sp >= 0) v = *(const u32x4*)(Kb + (size_t)sp * KVW + kh * 64 + c8 * 8);
        *(LAS u32x4*)(Ks + j * ATT_KP + c8 * 16) = v; }
    for (int p = F.tid; p < 64 * 36; p += 512) { const int d = p / 36, q = p % 36, sp = att_src_pos(q * 8, n);
        u32x4 v = (u32x4){0u, 0u, 0u, 0u};
        if (sp >= 0) v = *(const u32x4*)(Vt + (size_t)(kh * 64 + d) * KVROWS + sp);
        LAS u32x2* dst = (LAS u32x2*)(Vs + d * ATT_VP + q * 16); dst[0] = (u32x2){v.x, v.y}; dst[1] = (u32x2){v.z, v.w}; }
    __syncthreads();
    const int hq = kh * 8 + F.wave, r32 = F.lane & 31, hh = F.lane >> 5;
    const float sink2 = F.in[5][hq] * LOG2E;
    const bool prevok = n > 0;
#pragma unroll 1
    for (int qt = 0; qt < 4; ++qt) {
        const bf16_t* qrow = Qb + (size_t)(128 * n + 32 * qt + r32) * AW + hq * 64 + 8 * hh;
        bf16x8 qf[4];
#pragma unroll
        for (int t = 0; t < 4; ++t) qf[t] = *(const bf16x8*)(qrow + 16 * t);
        f32x16 sacc[6];
#pragma unroll
        for (int x = 0; x < 6; ++x) {
            const int kb = x < 4 - qt ? 32 * (qt + x) : (x < 5 ? 128 + 32 * (x - (4 - qt)) : 256);
            f32x16 acc;
#pragma unroll
            for (int i = 0; i < 16; ++i) acc[i] = 0.f;
#pragma unroll
            for (int t = 0; t < 4; ++t) { const bf16x8 kf = *(const LAS bf16x8*)(Ks + (kb + r32) * ATT_KP + (16 * t + 8 * hh) * 2); acc = __builtin_amdgcn_mfma_f32_32x32x16_bf16(kf, qf[t], acc, 0, 0, 0); }
#pragma unroll
            for (int i = 0; i < 16; ++i) { const int m = (i & 3) + 8 * (i >> 2) + 4 * hh;
                bool vis;
                if (x < 4 - qt) vis = prevok && (x > 0 || m > r32);
                else if (x < 5) vis = (x < 4) || (m <= r32);
                else vis = m < 16;
                acc[i] = vis ? acc[i] : -1e30f; }
            sacc[x] = acc;
        }
        float mx = sink2;
#pragma unroll
        for (int x = 0; x < 6; ++x)
#pragma unroll
            for (int i = 0; i < 16; ++i) mx = fmaxf(mx, sacc[x][i]);
        mx = fmaxf(mx, __shfl_xor(mx, 32));
        float l = 0.f;
#pragma unroll
        for (int x = 0; x < 6; ++x)
#pragma unroll
            for (int i = 0; i < 16; ++i) { const float p = __builtin_amdgcn_exp2f(sacc[x][i] - mx); sacc[x][i] = p; l += p; }
        l += __shfl_xor(l, 32); l += __builtin_amdgcn_exp2f(sink2 - mx);
        f32x16 oacc[2];
#pragma unroll
        for (int dt = 0; dt < 2; ++dt)
#pragma unroll
            for (int i = 0; i < 16; ++i) oacc[dt][i] = 0.f;
#pragma unroll
        for (int x = 0; x < 6; ++x) {
            const int kb = x < 4 - qt ? 32 * (qt + x) : (x < 5 ? 128 + 32 * (x - (4 - qt)) : 256);
#pragma unroll
            for (int t2 = 0; t2 < 2; ++t2) {
                u32x4 pw; pw.x = pg8::cvt_pk_bf16(sacc[x][8 * t2 + 0], sacc[x][8 * t2 + 1]); pw.y = pg8::cvt_pk_bf16(sacc[x][8 * t2 + 2], sacc[x][8 * t2 + 3]);
                pw.z = pg8::cvt_pk_bf16(sacc[x][8 * t2 + 4], sacc[x][8 * t2 + 5]); pw.w = pg8::cvt_pk_bf16(sacc[x][8 * t2 + 6], sacc[x][8 * t2 + 7]);
                const bf16x8 pf = __builtin_bit_cast(bf16x8, pw);
#pragma unroll
                for (int dt = 0; dt < 2; ++dt) { const LAS u32x2* vp = (const LAS u32x2*)(Vs + (32 * dt + r32) * ATT_VP + (kb + 16 * t2 + 4 * hh) * 2);
                    const u32x2 a = vp[0], b = vp[2]; u32x4 vw; vw.x = a.x; vw.y = a.y; vw.z = b.x; vw.w = b.y;
                    oacc[dt] = __builtin_amdgcn_mfma_f32_32x32x16_bf16(__builtin_bit_cast(bf16x8, vw), pf, oacc[dt], 0, 0, 0); }
            }
        }
        const float inv = 1.f / l;
        unsigned char* orow = At + (size_t)(128 * n + 32 * qt + r32) * AW + hq * 64 + 4 * hh;
#pragma unroll
        for (int dt = 0; dt < 2; ++dt)
#pragma unroll
            for (int g = 0; g < 4; ++g) *(unsigned*)(orow + 32 * dt + 8 * g) = pg8::pack4_fp8((f32x4){oacc[dt][4 * g] * inv, oacc[dt][4 * g + 1] * inv, oacc[dt][4 * g + 2] * inv, oacc[dt][4 * g + 3] * inv});
    }
}

constexpr int SSM_NCH = KVROWS / 8, SSM_NBLK = (SSM_NCH + 63) / 64, SSM_EP = 132, SSM_SP = 272, SSM_UP = 272;
constexpr int SSM_UB = 0  , SSM_EB = 3 * 64 * SSM_UP  , SSM_SB = SSM_EB + 2 * 64 * SSM_EP * 4  ;
constexpr int SSM_APOW = SSM_EB, SSM_BBAR = SSM_APOW + 4608, SSM_KD = SSM_BBAR + 8192;
static_assert(SSM_KD + 16384 <= SSM_SB && SSM_SB + 64 * SSM_SP <= LUT_OFF, "SSM LDS");
__device__ __forceinline__ bf16x8 pack_frag(const float (&v)[8]) { u32x4 w; w.x = pk2(v[0], v[1]); w.y = pk2(v[2], v[3]); w.z = pk2(v[4], v[5]); w.w = pk2(v[6], v[7]); return __builtin_bit_cast(bf16x8, w); }
__device__ __forceinline__ f32x2 gelu_pk(f32x2 v) {
    const f32x2 av = __builtin_elementwise_abs(v), d = av * 0.2316418882f + 1.0f;
    f32x2 t; t.x = __builtin_amdgcn_rcpf(d.x); t.y = __builtin_amdgcn_rcpf(d.y);
    f32x2 q = t * 0.5307027145f + (-0.7265760135f); q = q * t + 0.7107068705f; q = q * t + (-0.142248368f); q = q * t + 0.127414796f; q = q * t;
    const f32x2 sq = (v * v) * (-0.72134752044f);
    f32x2 e; e.x = __builtin_amdgcn_exp2f(sq.x); e.y = __builtin_amdgcn_exp2f(sq.y);
    const f32x2 m = v * (q * e), r = v - m;
    f32x2 o; o.x = v.x < 0.f ? m.x : r.x; o.y = v.y < 0.f ? m.y : r.y; return o;
}
__device__ __forceinline__ void ssm_unit(Frame& F, int g, int bfull, int bend) {
    const int tid = F.tid, lane = F.lane, w = F.wave, nl = lane & 15, kg = lane >> 4;
    LAS f32x2* apow = (LAS f32x2*)(F.lds + SSM_APOW);
    LAS f32x2* bbar = (LAS f32x2*)(F.lds + SSM_BBAR);
    LAS float* Kd = (LAS float*)(F.lds + SSM_KD);
    LAS f32x2* clds = (LAS f32x2*)(F.lds + SSM_KD + 8192);
    LAS float* eb = (LAS float*)(F.lds + SSM_EB);
    LAS unsigned char* sb = F.lds + SSM_SB;
    LAS unsigned char* ub = F.lds + SSM_UB;
    const float* Cre = F.in[12] + (size_t)g * 16 * 64; const float* Cim = F.in[13] + (size_t)g * 16 * 64;
    const bf16_t* Ub = WSP(bf16_t, WS_UG) + (size_t)g * KVROWS * 16;
    const int ur0 = tid >> 4, uc0 = tid & 15;
#define SSM_ULOAD(b, r0, r1) do { r0 = *(const u32x4*)(Ub + (size_t)(64 * (b) + ur0) * 128 + uc0 * 8); r1 = *(const u32x4*)(Ub + (size_t)(64 * (b) + 32 + ur0) * 128 + uc0 * 8); } while (0)
#define SSM_USTORE(b, r0, r1) do { LAS unsigned char* u_ = ub + ((b) % 3) * 64 * SSM_UP; *(LAS u32x4*)(u_ + ur0 * SSM_UP + uc0 * 16) = r0; *(LAS u32x4*)(u_ + (32 + ur0) * SSM_UP + uc0 * 16) = r1; } while (0)
    u32x4 ua0, ua1, ub0, ub1;
    __syncthreads();
    SSM_ULOAD(0, ua0, ua1); SSM_ULOAD(1, ub0, ub1);
    { const int p = tid & 63, d = tid >> 6; const float dt = expf(F.in[9][g]), lr = F.in[7][g * 64 + p], li = F.in[8][g * 64 + p];
      { const float mg = expf(d * dt * lr); float sn, cs; sincosf(d * dt * li, &sn, &cs); apow[d * 64 + p] = (f32x2){mg * cs, mg * sn}; }
      if (d == 0) { const float mg = expf(8.f * dt * lr); float sn, cs; sincosf(8.f * dt * li, &sn, &cs); apow[8 * 64 + p] = (f32x2){mg * cs, mg * sn}; }
      if (d == 1) {
        const float em1 = expm1f(dt * lr), th = dt * li; float sn, cs; sincosf(th, &sn, &cs);
        const float ai = (em1 + 1.f) * sn, sh = sinf(0.5f * th), num_re = em1 * cs - 2.f * sh * sh;
        const float den = lr * lr + li * li, cre = (num_re * lr + ai * li) / den, cim = (ai * lr - num_re * li) / den;
        const float* br = F.in[10] + (size_t)(g * 64 + p) * 16; const float* bi = F.in[11] + (size_t)(g * 64 + p) * 16;
#pragma unroll
        for (int h = 0; h < 16; ++h) bbar[p * 16 + h] = (f32x2){cre * br[h] - cim * bi[h], cre * bi[h] + cim * br[h]};
      }
      for (int i = tid; i < 1024; i += 512) clds[i] = (f32x2){Cre[i], Cim[i]};
    }
    SSM_USTORE(0, ua0, ua1); SSM_USTORE(1, ub0, ub1);
    __syncthreads();
    { const int d = tid >> 6, ho = (tid >> 2) & 15, hq = tid & 3; float k0 = 0.f, k1 = 0.f, k2 = 0.f, k3 = 0.f;
#pragma unroll 8
      for (int p = 0; p < 64; ++p) { const f32x2 cc = clds[ho * 64 + p]; const float cr = cc.x, ci = cc.y; const f32x2 a = apow[d * 64 + p]; const float wr = cr * a.x - ci * a.y, wi = cr * a.y + ci * a.x;
          const f32x2 b0 = bbar[p * 16 + 4 * hq], b1 = bbar[p * 16 + 4 * hq + 1], b2 = bbar[p * 16 + 4 * hq + 2], b3 = bbar[p * 16 + 4 * hq + 3];
          k0 += wr * b0.x - wi * b0.y; k1 += wr * b1.x - wi * b1.y; k2 += wr * b2.x - wi * b2.y; k3 += wr * b3.x - wi * b3.y; }
      *(LAS f32x4*)(Kd + (d * 16 + ho) * 16 + 4 * hq) = (f32x4){k0, k1, k2, k3}; }
    __syncthreads();
    bf16x8 bE[4], bT[4], bC[4];
    { const int p = (16 * w + nl) & 63; const bool im = w >= 4;
#pragma unroll
      for (int t = 0; t < 4; ++t) { const int j = 2 * t + (kg >> 1); const f32x2 a = apow[(7 - j) * 64 + p]; float v[8];
#pragma unroll
          for (int jj = 0; jj < 8; ++jj) { const f32x2 b = bbar[p * 16 + 8 * (kg & 1) + jj]; v[jj] = im ? (a.x * b.y + a.y * b.x) : (a.x * b.x - a.y * b.y); }
          bE[t] = pack_frag(v); } }
#pragma unroll
    for (int t = 0; t < 4; ++t) { const int j = 2 * t + (kg >> 1); float v[8];
#pragma unroll
        for (int jj = 0; jj < 8; ++jj) v[jj] = (j <= w) ? Kd[(((w - j) & 7) * 16 + nl) * 16 + 8 * (kg & 1) + jj] : 0.f;
        bT[t] = pack_frag(v); }
#pragma unroll
    for (int t = 0; t < 4; ++t) { float v[8];
#pragma unroll
        for (int jj = 0; jj < 8; ++jj) { const int p = 16 * t + 4 * kg + (jj >> 1); const f32x2 a = apow[(w + 1) * 64 + p]; const f32x2 cc = clds[nl * 64 + p]; const float cr = cc.x, ci = cc.y;
            v[jj] = (jj & 1) == 0 ? (cr * a.x - ci * a.y) : (-cr * a.y - ci * a.x); }
        bC[t] = pack_frag(v); }
    const f32x2 a8 = apow[8 * 64 + lane];
    const int ecol = 2 * ((16 * w + nl) & 63) + (w >> 2);
    bf16_t* Y1 = WSP(bf16_t, WS_Y1); const float dsk = F.in[14][g * 16 + nl];
#define SSM_UFRAG(b, mt, t) (*(const LAS bf16x8*)(ub + ((b) % 3) * 64 * SSM_UP + (16 * (mt) + nl) * SSM_UP + (32 * (t) + 8 * kg) * 2))
#define SSM_EGEMM(b) do { LAS float* e_ = eb + ((b) & 1) * 64 * SSM_EP; _Pragma("unroll") for (int mt = 0; mt < 4; ++mt) { f32x4 c_ = (f32x4){0.f, 0.f, 0.f, 0.f}; \
        _Pragma("unroll") for (int t = 0; t < 4; ++t) c_ = __builtin_amdgcn_mfma_f32_16x16x32_bf16(SSM_UFRAG(b, mt, t), bE[t], c_, 0, 0, 0); \
        _Pragma("unroll") for (int r = 0; r < 4; ++r) e_[(16 * mt + 4 * kg + r) * SSM_EP + ecol] = c_[r]; } } while (0)
    __syncthreads();
    SSM_EGEMM(0);
    f32x2 xs = (f32x2){0.f, 0.f};
    __syncthreads();
#pragma unroll 1
    for (int b = 0; b < bend; ++b) {
        const bool full = b >= bfull;
        if (b + 2 < bend) SSM_ULOAD(b + 2, ua0, ua1);
        if (w == 0) {
            const LAS f32x2* e_ = (const LAS f32x2*)(eb + (b & 1) * 64 * SSM_EP) + lane;
            const f32x2 aa = (f32x2){a8.x, a8.x}, ab = (f32x2){-a8.y, a8.y};
#pragma unroll
            for (int hf = 0; hf < 2; ++hf) { f32x2 ev[32];
#pragma unroll
                for (int c = 0; c < 32; ++c) ev[c] = e_[(32 * hf + c) * (SSM_EP / 2)];
#pragma unroll
                for (int c = 0; c < 32; ++c) { *(LAS unsigned*)(sb + (32 * hf + c) * SSM_SP + lane * 4) = pk2(xs.x, xs.y);
                    xs = aa * xs + (ab * (f32x2){xs.y, xs.x} + ev[c]); } }
        }
        f32x4 acc[4];
        if (full) {
#pragma unroll
            for (int mt = 0; mt < 4; ++mt) { acc[mt] = (f32x4){0.f, 0.f, 0.f, 0.f};
#pragma unroll
                for (int t = 0; t < 4; ++t) acc[mt] = __builtin_amdgcn_mfma_f32_16x16x32_bf16(SSM_UFRAG(b, mt, t), bT[t], acc[mt], 0, 0, 0); }
        }
        if (b + 1 < bend) SSM_EGEMM(b + 1);
        if (b + 2 < bend) SSM_USTORE(b + 2, ua0, ua1);
        __syncthreads();
        if (full) {
#pragma unroll
            for (int mt = 0; mt < 4; ++mt) {
#pragma unroll
                for (int t = 0; t < 4; ++t) { const bf16x8 sf = *(const LAS bf16x8*)(sb + (16 * mt + nl) * SSM_SP + (32 * t + 8 * kg) * 2); acc[mt] = __builtin_amdgcn_mfma_f32_16x16x32_bf16(sf, bC[t], acc[mt], 0, 0, 0); }
            }
            { const LAS unsigned char* u_ = ub + (b % 3) * 64 * SSM_UP;
#pragma unroll
              for (int mt = 0; mt < 4; ++mt)
#pragma unroll
                for (int r2 = 0; r2 < 2; ++r2) { const int row = 16 * mt + 4 * kg + 2 * r2, ch = 64 * b + row, pos = 8 * ch + w;
                    const float u0 = bf2f(*(const LAS bf16_t*)(u_ + row * SSM_UP + (w * 16 + nl) * 2)), u1 = bf2f(*(const LAS bf16_t*)(u_ + (row + 1) * SSM_UP + (w * 16 + nl) * 2));
                    const f32x2 ge = gelu_pk((f32x2){acc[mt][2 * r2] + dsk * u0, acc[mt][2 * r2 + 1] + dsk * u1});
                    if (ch < SSM_NCH && pos >= NMETA) Y1[(size_t)(pos - NMETA) * SW + g * 16 + nl] = (bf16_t)f2bf(ge.x);
                    if (ch + 1 < SSM_NCH && pos + 8 >= NMETA) Y1[(size_t)(pos + 8 - NMETA) * SW + g * 16 + nl] = (bf16_t)f2bf(ge.y); } }
            __syncthreads();
        }
    }
#undef SSM_ULOAD
#undef SSM_USTORE
#undef SSM_UFRAG
#undef SSM_EGEMM
}

__device__ __forceinline__ void ln1_pass(Frame& F) {
    const int gw = F.c * 8 + F.wave, NGW = F.G * 8;
    const bf16_t* H = WSP(bf16_t, WS_H1F); const bf16_t* H0 = WSP(bf16_t, WS_H0B); bf16_t* Hb = WSP(bf16_t, WS_H1B); unsigned char* Hq = WSP(unsigned char, WS_H1LO);
    stage_gb(F, F.in[18], F.in[19]);
    const LAS f32x4* gl = (const LAS f32x4*)F.lds; const LAS f32x4* bl = (const LAS f32x4*)(F.lds + 16384);
#pragma unroll 1
    for (int r = gw; r < T_TOK; r += NGW) {
        const u32x2* x = (const u32x2*)(H + (size_t)r * DM) + F.lane; const u32x2* x0 = (const u32x2*)(H0 + (size_t)r * DM) + F.lane;
        u32x2* ob = (u32x2*)(Hb + (size_t)r * DM) + F.lane; unsigned* oq = (unsigned*)(Hq + (size_t)r * DM) + F.lane;
        float s = 0.f, q = 0.f;
#pragma unroll
        for (int j = 0; j < 16; ++j) { const u32x2 w = x[64 * j], w0 = x0[64 * j];
            const f32x4 v = (f32x4){bf_lo(w0.x), bf_hi(w0.x), bf_lo(w0.y), bf_hi(w0.y)} * ALPHA + (f32x4){bf_lo(w.x), bf_hi(w.x), bf_lo(w.y), bf_hi(w.y)};
            s += (v[0] + v[1]) + (v[2] + v[3]); q += (v[0] * v[0] + v[1] * v[1]) + (v[2] * v[2] + v[3] * v[3]); }
        const float mean = wave_sum(s) * (1.f / DM), var = fmaxf(wave_sum(q) * (1.f / DM) - mean * mean, 0.f), rstd = 1.f / sqrtf(var + LN_EPS);
        asm volatile("" ::: "memory");
#pragma unroll
        for (int j = 0; j < 16; ++j) { const u32x2 w = __builtin_nontemporal_load(x + 64 * j), w0 = __builtin_nontemporal_load(x0 + 64 * j);
            const f32x4 v = (f32x4){bf_lo(w0.x), bf_hi(w0.x), bf_lo(w0.y), bf_hi(w0.y)} * ALPHA + (f32x4){bf_lo(w.x), bf_hi(w.x), bf_lo(w.y), bf_hi(w.y)};
            const f32x4 y = (v - mean) * rstd * gl[F.lane + 64 * j] + bl[F.lane + 64 * j];
            ob[64 * j] = (u32x2){pk2(y[0], y[1]), pk2(y[2], y[3])}; __builtin_nontemporal_store(pg8::pack4_fp8(y), oq + 64 * j);
            if ((j & 3) == 3) asm volatile("" ::: "memory"); }
    }
}

__device__ __forceinline__ void route_pass(Frame& F) {
    const int gw = F.c * 8 + F.wave, NGW = F.G * 8, lane = F.lane;
    LAS unsigned* hist = (LAS unsigned*)F.lds;
    __syncthreads();
    if (F.tid < NE) hist[F.tid] = 0u;
    __syncthreads();
    const float* Lg = WSP(float, WS_LOGITS); int* TI = WSP(int, WS_TOPI); float* TW = WSP(float, WS_TOPW);
    const float bias = F.in[21][lane];
    constexpr int RT = 4;
    for (int t = gw; t < T_TOK; t += RT * NGW) {
        float score[RT], sel[RT], val[RT], myw[RT], wsum[RT]; int myi[RT];
#pragma unroll
        for (int q = 0; q < RT; ++q) { const int tq = (t + q * NGW < T_TOK) ? t + q * NGW : t;
            const float lg = Lg[(size_t)tq * 128 + lane] + Lg[(size_t)tq * 128 + 64 + lane];
            score[q] = 1.f / (1.f + expf(-lg)); sel[q] = score[q] + bias; }
#pragma unroll
        for (int q = 0; q < RT; ++q) {
            int rk = 0;
#pragma unroll
            for (int x = 1; x < 8; ++x) { const float o = __shfl_xor(sel[q], x); const int pl = lane ^ x; rk += (o > sel[q] || (o == sel[q] && pl < lane)) ? 1 : 0; }
            float gs = rk < 2 ? sel[q] : 0.f; gs += __shfl_xor(gs, 1); gs += __shfl_xor(gs, 2); gs += __shfl_xor(gs, 4);
            int grk = 0; const int mg = lane >> 3;
#pragma unroll
            for (int x = 1; x < 8; ++x) { const float o = __shfl_xor(gs, 8 * x); const int og = mg ^ x; grk += (o > gs || (o == gs && og < mg)) ? 1 : 0; }
            val[q] = grk < 4 ? sel[q] : -1e30f; myi[q] = 0; myw[q] = 0.f; wsum[q] = 0.f; }
#pragma unroll
        for (int k = 0; k < TOPK; ++k)
#pragma unroll
            for (int q = 0; q < RT; ++q) {
                const float mx = wave_max(val[q]); const unsigned long long bal = __ballot(val[q] == mx); const int win = __builtin_ctzll(bal);
                const float ws = __shfl(score[q], win); wsum[q] += ws;
                if (lane == k) { myi[q] = win; myw[q] = ws; }
                if (lane == win) val[q] = -3e38f; }
#pragma unroll
        for (int q = 0; q < RT; ++q) { const int tq = t + q * NGW;
            if (tq < T_TOK && lane < TOPK) { TI[tq * TOPK + lane] = myi[q]; TW[tq * TOPK + lane] = myw[q] / wsum[q] * 2.5f; __hip_atomic_fetch_add(&hist[myi[q]], 1u, __ATOMIC_RELAXED, __HIP_MEMORY_SCOPE_WORKGROUP); } }
    }
    __syncthreads();
    if (F.tid < NE && hist[F.tid]) __hip_atomic_fetch_add(F.ctl + CW_CNT + F.tid, hist[F.tid], RLX_AGENT);
    __syncthreads();
}

__device__ __forceinline__ void lists_pass(Frame& F) {
    LAS int* sh = (LAS int*)F.lds;
    const int* TI = WSP(int, WS_TOPI); int* POS = WSP(int, WS_POS); int* RT = WSP(int, WS_ROWTOK); int* TE = WSP(int, WS_TILEE); int* UT = WSP(int, WS_UTAB);
    for (int e = F.c; e < NE; e += F.G) {
        __syncthreads();
        if (F.tid < NE) sh[F.tid] = (int)__hip_atomic_load(F.ctl + CW_CNT + F.tid, RLX_AGENT);
        __syncthreads();
        int tb = 0; for (int j = 0; j < e; ++j) tb += (sh[j] + 255) >> 8;
        const int cnt = sh[e], mytiles = (cnt + 255) >> 8, base = tb * 256;
        if (e == NE - 1 && F.tid == 0) __hip_atomic_store(F.ctl + CW_NTILES, (unsigned)(tb + mytiles), RLX_AGENT);
        int kk[16]; int loc = 0;
#pragma unroll
        for (int j = 0; j < 16; ++j) { const int t = F.tid * 16 + j; const u32x4 a = *(const u32x4*)(TI + t * 8), b = *(const u32x4*)(TI + t * 8 + 4);
            int k = -1; k = (int)a.x == e ? 0 : k; k = (int)a.y == e ? 1 : k; k = (int)a.z == e ? 2 : k; k = (int)a.w == e ? 3 : k; k = (int)b.x == e ? 4 : k; k = (int)b.y == e ? 5 : k; k = (int)b.z == e ? 6 : k; k = (int)b.w == e ? 7 : k;
            kk[j] = k; loc += (k >= 0) ? 1 : 0; }
        int inc = loc;
#pragma unroll
        for (int o = 1; o < 64; o <<= 1) { const int v = __shfl_up(inc, o); if (F.lane >= o) inc += v; }
        if (F.lane == 63) sh[64 + F.wave] = inc;
        __syncthreads();
        int woff = 0; for (int w = 0; w < F.wave; ++w) woff += sh[64 + w];
        int rank = woff + inc - loc;
#pragma unroll
        for (int j = 0; j < 16; ++j) if (kk[j] >= 0) { const int t = F.tid * 16 + j; RT[base + rank] = t; POS[t * 8 + kk[j]] = base + rank; ++rank; }
        for (int i = cnt + F.tid; i < mytiles * 256; i += 512) RT[base + i] = 0;
        if (F.tid < mytiles) TE[tb + F.tid] = e;
        for (int idx = F.tid; idx < mytiles * 16; idx += 512) { const int pb = idx / (mytiles * 8), rem = idx % (mytiles * 8), t = rem >> 3, pn = pb * 8 + (rem & 7);
            UT[tb * 16 + idx] = (tb + t) | (pn << 16) | (e << 24); }
    }
}

__device__ __forceinline__ void combine_pass(Frame& F) {
    const int gw = F.c * 8 + F.wave, NGW = F.G * 8;
    const bf16_t* H = WSP(bf16_t, WS_H1B); const unsigned char* Y = WSP(unsigned char, WS_YB); const int* POS = WSP(int, WS_POS); const float* TW = WSP(float, WS_TOPW);
    stage_gb(F, F.in[28], F.in[29]);
    for (int t = gw; t < T_TOK; t += NGW) {
        f32x4 v[16]; const u32x2* hr = (const u32x2*)(H + (size_t)t * DM) + F.lane;
#pragma unroll
        for (int j = 0; j < 16; ++j) { const u32x2 h = __builtin_nontemporal_load(hr + 64 * j); v[j] = (f32x4){bf_lo(h.x), bf_hi(h.x), bf_lo(h.y), bf_hi(h.y)}; }
#pragma unroll 2
        for (int k = 0; k < TOPK; ++k) { const int row = POS[t * TOPK + k]; const float w = TW[t * TOPK + k]; const unsigned* yr = (const unsigned*)(Y + (size_t)row * DM) + F.lane;
#pragma unroll
            for (int j = 0; j < 16; ++j) { const int y = (int)__builtin_nontemporal_load(yr + 64 * j); const f32x2 lo = __builtin_amdgcn_cvt_pk_f32_fp8(y, false), hi = __builtin_amdgcn_cvt_pk_f32_fp8(y, true); v[j] += (f32x4){lo.x, lo.y, hi.x, hi.y} * w; } }
        float s = 0.f;
#pragma unroll
        for (int j = 0; j < 16; ++j) s += (v[j][0] + v[j][1]) + (v[j][2] + v[j][3]);
        const float mean = wave_sum(s) * (1.f / DM); float s2 = 0.f;
#pragma unroll
        for (int j = 0; j < 16; ++j) { v[j] = v[j] - mean; s2 += (v[j][0] * v[j][0] + v[j][1] * v[j][1]) + (v[j][2] * v[j][2] + v[j][3] * v[j][3]); }
        const float rstd = 1.f / sqrtf(wave_sum(s2) * (1.f / DM) + LN_EPS);
        f32x4* o = (f32x4*)(F.out + (size_t)t * DM) + F.lane;
        asm volatile("" ::: "memory");
#pragma unroll
        for (int j = 0; j < 16; ++j) { const f32x4 gg = ((const LAS f32x4*)F.lds)[F.lane + 64 * j], bb = ((const LAS f32x4*)(F.lds + 16384))[F.lane + 64 * j]; __builtin_nontemporal_store(v[j] * rstd * gg + bb, o + 64 * j); }
    }
}

#ifndef DUMP
#define DUMP 0
#endif
__device__ __forceinline__ void dump_f32(Frame& F, const float* src) {
    for (size_t i = (size_t)F.c * 512 + F.tid; i < (size_t)T_TOK * DM / 4; i += (size_t)F.G * 512) ((f32x4*)F.out)[i] = ((const f32x4*)src)[i];
}
__device__ __forceinline__ void dump_bf16(Frame& F, const bf16_t* src, int ld, int ncols, int colofs, size_t nrows) {
    for (size_t i = (size_t)F.c * 512 + F.tid; i < nrows * ncols; i += (size_t)F.G * 512) { const size_t r = i / ncols, c = i % ncols; if (r < T_TOK) F.out[r * DM + colofs + c] = bf2f(src[r * ld + c]); }
}
__device__ __forceinline__ void dump_zero(Frame& F) {
    for (size_t i = (size_t)F.c * 512 + F.tid; i < (size_t)T_TOK * DM / 4; i += (size_t)F.G * 512) ((f32x4*)F.out)[i] = (f32x4){0.f, 0.f, 0.f, 0.f};
}
__device__ __forceinline__ void p1_convert(Frame& F, int when) {
    int c = F.c; asm volatile("" : "+s"(c));
    LAS unsigned* scr = (LAS unsigned*)(F.lds + F.wave * 8704);
    const bool split = (F.G == 256);
    const int NT = split ? CVT_P1_TILES : 3 * NE * 64 * 8;
    if (!split) { if (when == 0) { cvt_run(F, 1, 8, c * 8 + F.wave, F.G * 8, scr); cvt_run(F, 8, 11, c * 8 + F.wave, F.G * 8, scr); } return; }
    const int nA = 58, sB = 294, sA = 354;
    const int kc = (c >> 3) & 1;
    if (kc != when) return;
    int tlo, thi;
    if (c < 256 - nA) { tlo = c * sB; thi = tlo + sB; } else { tlo = (256 - nA) * sB + (c - (256 - nA)) * sA; thi = tlo + sA; }
    if (thi > NT) thi = NT; if (tlo > NT) tlo = NT;
    cvt_run(F, 8, 11, F.wave, 8, scr, tlo, thi);
    cvt_run(F, 1, 8, c * 8 + F.wave, F.G * 8, scr);
}
struct Args { const float* in[30]; float* out; unsigned char* ws; int ph_lo, ph_hi, one, pad; };
__global__ void __launch_bounds__(512, 2) mk_fwd(Args args) {
    extern __shared__ __attribute__((aligned(16))) unsigned char lds[];
    Frame F;
    F.lds = (LAS unsigned char*)lds; F.ws = args.ws; F.ctl = (gu32*)(args.ws + WS_CTL);
    F.tid = threadIdx.x; F.lane = F.tid & 63; F.wave = __builtin_amdgcn_readfirstlane(F.tid >> 6); F.G = gridDim.x; F.c = blockIdx.x;
    F.in = args.in; F.out = args.out;
    volatile LAS unsigned* MISC = (volatile LAS unsigned*)(F.lds + MISC_OFF);
    for (int u = F.tid; u < (LDS_BYTES - RING_BYTES) / 4; u += 512) ((LAS unsigned*)(F.lds + RING_BYTES))[u] = 0u;
    __syncthreads();
    XcdBarrier bar; bar.bar = (unsigned*)(F.ctl + CW_BAR); bar.x = 0; bar.st = nullptr;
    if (args.one) bar = xcd_barrier_post((unsigned*)(F.ctl + CW_BAR), MISC + 8);
    const int lo = args.ph_lo, hi = args.ph_hi;
#ifndef PH_MASK
#define PH_MASK 0xffffffffu
#endif
#define IN(k) (((PH_MASK >> (k)) & 1u) && lo <= (k) && (k) < hi)
#define SEAM(k) do { if (IN(k) && IN((k) + 1)) xcd_barrier(bar); REFRESH(); } while (0)
#define REFRESH() do { int t_ = threadIdx.x; asm volatile("" : "+v"(t_)); F.tid = t_; F.lane = t_ & 63; F.wave = __builtin_amdgcn_readfirstlane(t_ >> 6); } while (0)
#ifndef HOT12
#define HOT12 0
#endif
#ifndef PROBE_REP
#define PROBE_REP 0u
#endif
#define RUN(k, ...) if (IN(k)) { __VA_ARGS__ if ((PROBE_REP >> (k)) & 1u) { xcd_barrier(bar); REFRESH(); __VA_ARGS__ } }
    LAS unsigned char* ring = F.lds;

    RUN(0, { p0_prologue(F);  }) SEAM(0);
    RUN(1, {
        p1_convert(F, 0); __syncthreads();
        { pg8::DenseSched S{(const char*)WSP(unsigned char, WS_H0Q), (const char*)(WSP(unsigned char, WS_WING) + (size_t)10240 * DM), DM / 2, 33, 6, F.G, F.c, 0, 0, 0};
          pg8::EpiZ E{WSP(bf16_t, WS_KB), WSP(bf16_t, WS_VB), WSP(bf16_t, WS_UG)};
          pg8::gemm_phase<pg8::EpiZ, pg8::DenseSched, true>(ring, F.tid, DM / 2, DM / 2, S, E); }
        __syncthreads(); REFRESH();
        { pg8::DenseSched S{(const char*)WSP(unsigned char, WS_H0Q), (const char*)WSP(unsigned char, WS_WING), DM / 2, 32, 40, F.G, F.c, 0, 0, 0};
          pg8::EpiGate EG{WSP(bf16_t, WS_QB), WSP(bf16_t, WS_GA), WSP(bf16_t, WS_GS)};
          pg8::gemm_phase<pg8::EpiGate, pg8::DenseSched, true>(ring, F.tid, DM / 2, DM / 2, S, EG); }
        __syncthreads(); p1_convert(F, 1);
    }) SEAM(1);
    RUN(2, {
        const bool big = F.G >= 256; const int ntask = big ? 128 : 64;
        for (int t = F.c; t < ntask; t += F.G) { const int g = big ? t >> 1 : t, hf = big ? (t & 1) : 0; ssm_unit(F, g, hf ? 11 : 0, (big && !hf) ? 11 : SSM_NBLK); }
        const int a0 = big ? F.c - 128 : F.c, astep = big ? F.G - 128 : F.G;
        if (a0 >= 0) for (int u = a0; u < 256; u += astep) attn_unit(F, u >> 2, u & 3);
    }) SEAM(2);
    RUN(3, {
        pg8::DenseSched S{(const char*)WSP(unsigned char, WS_ATT), (const char*)WSP(unsigned char, WS_WAO), AW / 2, 32, 16, F.G, F.c, 0, 0, 0};
        pg8::EpiMix<false> E{WSP(bf16_t, WS_GA), WSP(bf16_t, WS_MIX), nullptr};
        pg8::gemm_phase<pg8::EpiMix<false>, pg8::DenseSched, true>(ring, F.tid, AW / 2, AW / 2, S, E);
    }) REFRESH();
    RUN(4, {
        if (F.G == 256 && F.c >= 128) { LAS unsigned* scr = (LAS unsigned*)(F.lds + F.wave * 8704); const int t0 = CVT_P1_TILES + CVT_P11_TILES + (F.c - 128) * CVT_P4_PER; cvt_run(F, 8, 11, F.wave, 8, scr, t0, t0 + CVT_P4_PER); }
        pg8::DenseSched S{(const char*)WSP(bf16_t, WS_Y1), (const char*)WSP(bf16_t, WS_WGLU), SW, 32, 4, F.G, F.c, 0, 0, 0};
        pg8::EpiGlu E{WSP(bf16_t, WS_Y1), WSP(unsigned char, WS_Y2)};
        pg8::gemm_phase(ring, F.tid, SW, SW, S, E);
    }) SEAM(4);
    RUN(5, {
        pg8::DenseSched S{(const char*)WSP(unsigned char, WS_Y2), (const char*)WSP(unsigned char, WS_WSO), SW / 2, 32, 16, F.G, F.c, 0, 0, 0};
        pg8::EpiMix<true> E{WSP(bf16_t, WS_GS), WSP(bf16_t, WS_MIX), WSP(unsigned char, WS_H0Q)};
        pg8::gemm_phase<pg8::EpiMix<true>, pg8::DenseSched, true>(ring, F.tid, SW / 2, SW / 2, S, E);
    }) SEAM(5);
    RUN(6, {
        pg8::DenseSched S{(const char*)WSP(unsigned char, WS_H0Q), (const char*)WSP(unsigned char, WS_WOUT), DM / 2, 32, 16, F.G, F.c, 0, 0, 0};
        pg8::EpiWout E{WSP(bf16_t, WS_H1F)};
        pg8::gemm_phase<pg8::EpiWout, pg8::DenseSched, true>(ring, F.tid, DM / 2, DM / 2, S, E);
    }) SEAM(6);
    RUN(7, { ln1_pass(F);  }) SEAM(7);
    RUN(8, {
        if (F.G == 256 && F.c >= 160) { LAS unsigned* scr = (LAS unsigned*)(F.lds + F.wave * 8704); const int t0 = CVT_P1_TILES + CVT_P11_TILES + CVT_P4_TILES + (F.c - 160) * CVT_P8_PER; cvt_run(F, 8, 11, F.wave, 8, scr, t0, t0 + CVT_P8_PER); }
        pg8::DenseSched S{(const char*)WSP(bf16_t, WS_H1B), (const char*)WSP(bf16_t, WS_WS13), DM, 32, 5, F.G, F.c, 0, 0, 0};
        pg8::EpiS13R E{WSP(bf16_t, WS_ACTS), WSP(float, WS_LOGITS)};
        pg8::gemm_phase(ring, F.tid, DM, DM, S, E);
    }) SEAM(8);
    RUN(9, { route_pass(F);  }) SEAM(9);
    RUN(10, { lists_pass(F);
        if (F.G == 256 && args.one && F.c >= 64) { pg8::DenseSched S{(const char*)WSP(bf16_t, WS_ACTS), (const char*)WSP(bf16_t, WS_WS2), EDIM, 32, 16, 192, F.c - 64, 0, 0, 0}; S.i1 = 2;
            pg8::EpiS2 E{WSP(bf16_t, WS_H1B)};
            pg8::gemm_phase(ring, F.tid, EDIM, EDIM, S, E); }
    }) SEAM(10);
    RUN(11, {
        const int ntiles = __builtin_amdgcn_readfirstlane((int)__hip_atomic_load(F.ctl + CW_NTILES, RLX_AGENT));
        { pg8::MoeSched S{(const char*)WSP(unsigned char, WS_H1LO), (const char*)WSP(unsigned char, WS_WE13), DM / 2, WSP(int, WS_ROWTOK), WSP(int, WS_TILEE), 4, (size_t)1024 * DM, ntiles * 4, F.G, F.c};
          pg8::EpiAct E{WSP(unsigned char, WS_ACT)};
          pg8::gemm_phase<pg8::EpiAct, pg8::MoeSched, true>(ring, F.tid, DM / 2, DM / 2, S, E); }
        { const bool early = (F.G == 256 && args.one);
          const int rem = (ntiles * 4) % F.G, nl = F.G - rem; const bool lite = early && rem > 0 && nl >= 64;
          if (!lite || F.c >= rem) {
          pg8::DenseSched S{(const char*)WSP(bf16_t, WS_ACTS), (const char*)WSP(bf16_t, WS_WS2), EDIM, 32, 16, lite ? nl : F.G, lite ? F.c - rem : F.c, 0, 0, 0}; S.l0 = early ? 384 : 0;
          pg8::EpiS2 E{WSP(bf16_t, WS_H1B)};
          pg8::gemm_phase(ring, F.tid, EDIM, EDIM, S, E); }
          if (F.G == 256) { __syncthreads(); LAS unsigned* scr = (LAS unsigned*)(F.lds + F.wave * 8704);
              if (!lite || F.c >= rem) cvt_run(F, 8, 11, (lite ? F.c - rem : F.c) * 8 + F.wave, (lite ? nl : F.G) * 8, scr, CVT_P1_TILES, CVT_P1_TILES + CVT_P11_TILES); } }
    }) SEAM(11);
    RUN(12, {
        const int ntiles = __builtin_amdgcn_readfirstlane((int)__hip_atomic_load(F.ctl + CW_NTILES, RLX_AGENT)); const int nunits = ntiles * 16;
        LAS int* lut = (LAS int*)(F.lds + LUT_OFF);
#if HOT12
        __syncthreads();
        if (F.tid < 64) lut[F.tid] = (F.c & 3) | (((F.c >> 2) & 15) << 16);
        __syncthreads();
        { pg8::MoeTabSched S{(const char*)WSP(unsigned char, WS_ACT), (const char*)WSP(unsigned char, WS_WE2), EDIM / 2, lut, (size_t)DM * EDIM, nunits, F.G, F.c};
          pg8::EpiY E{WSP(unsigned char, WS_YB)};
          pg8::gemm_phase<pg8::EpiY, pg8::MoeTabSched, true>(ring, F.tid, EDIM / 2, EDIM / 2, S, E); }
        xcd_barrier(bar); REFRESH();
#endif
        __syncthreads();
        if (F.tid < 64) { const int L = F.tid * F.G + F.c; lut[F.tid] = L < nunits ? WSP(int, WS_UTAB)[pg8::xcd_remap(L, nunits)] : 0; }
        __syncthreads();
        pg8::MoeTabSched S{(const char*)WSP(unsigned char, WS_ACT), (const char*)WSP(unsigned char, WS_WE2), EDIM / 2, lut, (size_t)DM * EDIM, nunits, F.G, F.c};
        pg8::EpiY E{WSP(unsigned char, WS_YB)};
        pg8::gemm_phase<pg8::EpiY, pg8::MoeTabSched, true>(ring, F.tid, EDIM / 2, EDIM / 2, S, E);
    }) SEAM(12);
    RUN(13, { combine_pass(F);  })
#if DUMP
    if (lo <= 14 && 14 < hi) {
#if DUMP == 1
        dump_f32(F, WSP(float, WS_H1F));
#elif DUMP == 2
        dump_bf16(F, WSP(bf16_t, WS_MIX), DM, DM, 0, T_TOK);
#elif DUMP == 3
        dump_zero(F); __syncthreads();
        dump_bf16(F, WSP(bf16_t, WS_ATT), AW, AW, 0, T_TOK); dump_bf16(F, WSP(bf16_t, WS_Y1), SW, SW, AW, T_TOK);
#elif DUMP == 4
        dump_zero(F); __syncthreads();
        dump_bf16(F, WSP(bf16_t, WS_QB), AW, AW, 0, T_TOK); dump_bf16(F, WSP(bf16_t, WS_KB), KVW, KVW, AW, T_TOK); dump_bf16(F, WSP(bf16_t, WS_VB), KVW, KVW, AW + KVW, T_TOK);
        dump_bf16(F, WSP(bf16_t, WS_UG), 1026, 1026, AW + 2 * KVW, T_TOK);
#elif DUMP == 5
        dump_bf16(F, WSP(bf16_t, WS_GA), DM, DM, 0, T_TOK);
#elif DUMP == 7
        dump_bf16(F, WSP(bf16_t, WS_WIN) + (size_t)3584 * DM, DM, DM, 0, T_TOK);
#elif DUMP == 6
        dump_bf16(F, WSP(bf16_t, WS_H0B), DM, DM, 0, T_TOK);
#endif
    }
#endif
#undef IN
#undef SEAM
}

#ifndef PH_MASK
#define PH_MASK_HOST 0xffffffffu
#else
#define PH_MASK_HOST (PH_MASK)
#endif
extern "C" void kernel_launch(void* const* d_in, const int* in_sizes, int n_in, void* d_out, int out_size, void* d_ws, size_t ws_size, hipStream_t stream) {
    static int grid = 0;
    if (grid == 0) {
        if (n_in != 30 || in_sizes[0] != T_TOK * DM || out_size != T_TOK * DM || ws_size < WS_END) { fprintf(stderr, "kernel_launch: unexpected shapes / workspace (n_in %d, ws %zu, need %zu)\n", n_in, ws_size, (size_t)WS_END); grid = -1; return; }
        int dev = 0, cus = 0, per_cu = 0;
        if (hipGetDevice(&dev) != hipSuccess || hipDeviceGetAttribute(&cus, hipDeviceAttributeMultiprocessorCount, dev) != hipSuccess) { grid = -1; return; }
        if (hipFuncSetAttribute((const void*)mk_fwd, hipFuncAttributeMaxDynamicSharedMemorySize, LDS_BYTES) != hipSuccess) { fprintf(stderr, "kernel_launch: hipFuncSetAttribute failed\n"); grid = -1; return; }
        if (hipOccupancyMaxActiveBlocksPerMultiprocessor(&per_cu, (const void*)mk_fwd, 512, LDS_BYTES) != hipSuccess || per_cu < 1) fprintf(stderr, "kernel_launch: occupancy query reports %d\n", per_cu);
        (void)hipGetLastError();
        grid = cus;
    }
    if (grid < 0) return;
    if (hipMemsetAsync((char*)d_ws + WS_CTL, 0, CTL_ZERO_BYTES, stream) != hipSuccess) return;
    Args a{};
    for (int i = 0; i < 30; ++i) a.in[i] = (const float*)d_in[i];
    a.out = (float*)d_out; a.ws = (unsigned char*)d_ws; a.pad = 0;
#if MK_ONE_LAUNCH
    a.ph_lo = 0; a.ph_hi = NPHASE; a.one = 1;
    hipLaunchKernelGGL(mk_fwd, dim3(grid), dim3(512), LDS_BYTES, stream, a);
#else
    for (int p = 0; p < NPHASE + (DUMP ? 1 : 0); ++p) { a.ph_lo = p; a.ph_hi = p + 1; a.one = 0;
        if (!((PH_MASK_HOST >> p) & 1u)) continue;
        hipLaunchKernelGGL(mk_fwd, dim3(grid), dim3(512), LDS_BYTES, stream, a); }
#endif
}
```
